# Optimizing an MI355X kernel written in HIP

```python
import jax, jax.numpy as jnp
from jax import lax
import numpy as np

D_MODEL = 2048
BATCH = 2
SEQ = 4096
DEPTH = 2

N_A_LAYERS = DEPTH // 2
N_B_LAYERS = DEPTH - N_A_LAYERS
ALPHA = (2.0 * DEPTH) ** 0.25
BETA = (8.0 * DEPTH) ** -0.25
POOL_WINDOWS = (2, 4, 8, 16)
N_POOL_GROUPS = 4
POOL_GROUP_DIM = D_MODEL // N_POOL_GROUPS
N_HEADS = 16
QK_NOPE_DIM = 128
QK_ROPE_DIM = 64
QK_DIM = QK_NOPE_DIM + QK_ROPE_DIM
V_DIM = 128
Q_LORA_RANK = D_MODEL // 4
KV_LORA_RANK = D_MODEL // 4
ROPE_THETA = 10000.0
Q_BLOCK = 128
N_EXPERTS = 64
TOP_K = 8
N_EXPERT_GROUPS = 8
TOPK_GROUPS = 4
EXPERT_DIM = D_MODEL // 4
SHARED_DIM = EXPERT_DIM
ROUTED_SCALE = 2.5
ROW_BLOCK = 128
LN_EPS = 1e-5
RMS_EPS = 1e-6

kernel_name = 'yoco_pool_mla_moe_deepnorm'


def layer_norm(x, g, b):
    xf = x.astype(jnp.float32)
    mu = jnp.mean(xf, axis=-1, keepdims=True)
    var = jnp.mean(jnp.square(xf - mu), axis=-1, keepdims=True)
    return ((xf - mu) * lax.rsqrt(var + LN_EPS) * g + b).astype(x.dtype)


def rms_norm(x, g):
    xf = x.astype(jnp.float32)
    ms = jnp.mean(jnp.square(xf), axis=-1, keepdims=True)
    return (xf * lax.rsqrt(ms + RMS_EPS) * g).astype(x.dtype)


def apply_rope(x):
    S = x.shape[1]
    half = QK_ROPE_DIM // 2
    inv_freq = 1.0 / (ROPE_THETA ** (jnp.arange(0, QK_ROPE_DIM, 2, dtype=jnp.float32) / QK_ROPE_DIM))
    ang = jnp.arange(S, dtype=jnp.float32)[:, None] * inv_freq[None, :]
    bshape = (S,) + (1,) * (x.ndim - 3) + (half,)
    cos = jnp.cos(ang).reshape(bshape)
    sin = jnp.sin(ang).reshape(bshape)
    xf = x.astype(jnp.float32)
    x1, x2 = xf[..., :half], xf[..., half:]
    return jnp.concatenate([x1 * cos - x2 * sin, x2 * cos + x1 * sin], axis=-1).astype(x.dtype)


def pool_mixer(x, w_in, w_grp, scale, w_out):
    B, S, _ = x.shape
    h = (x @ w_in).reshape(B, S, N_POOL_GROUPS, POOL_GROUP_DIM)
    hf = h.astype(jnp.float32)
    csum = jnp.concatenate([jnp.zeros((B, 1, N_POOL_GROUPS, POOL_GROUP_DIM), jnp.float32),
                            jnp.cumsum(hf, axis=1)], axis=1)
    t = jnp.arange(S, dtype=jnp.float32)
    outs = []
    for g, w in enumerate(POOL_WINDOWS):
        c = csum[:, :, g]
        lo = jnp.concatenate([jnp.zeros((B, w - 1, POOL_GROUP_DIM), jnp.float32), c[:, :S - w + 1]], axis=1)
        count = jnp.minimum(t + 1.0, float(w))[None, :, None]
        outs.append((c[:, 1:] - lo) / count - hf[:, :, g])
    pooled = jnp.stack(outs, axis=2).astype(x.dtype)
    mixed = jnp.einsum('bsgc,gcd->bsgd', pooled, w_grp).reshape(B, S, D_MODEL)
    return (mixed * scale) @ w_out


def shared_kv(x, w_down, norm_g, w_uk, w_uv):
    B, S, _ = x.shape
    ckr = x @ w_down
    c = rms_norm(ckr[..., :KV_LORA_RANK], norm_g)
    k_rope = apply_rope(ckr[..., KV_LORA_RANK:])
    k_nope = jnp.einsum('bsr,rhd->bshd', c, w_uk)
    v = jnp.einsum('bsr,rhd->bshd', c, w_uv)
    k = jnp.concatenate([k_nope, jnp.broadcast_to(k_rope[:, :, None, :], (B, S, N_HEADS, QK_ROPE_DIM))], axis=-1)
    return k, v


def causal_block_attention(q, k, v):
    B, S, H, Dq = q.shape
    nb = S // Q_BLOCK
    qb = jnp.moveaxis(q.reshape(B, nb, Q_BLOCK, H, Dq), 1, 0)
    key_pos = jnp.arange(S)
    sm_scale = QK_DIM ** -0.5

    def one_block(args):
        i, qi = args
        s = jnp.einsum('bqhd,bkhd->bhqk', qi, k, preferred_element_type=jnp.float32) * sm_scale
        q_pos = i * Q_BLOCK + jnp.arange(Q_BLOCK)
        s = jnp.where(key_pos[None, :] <= q_pos[:, None], s, -jnp.inf)
        p = jax.nn.softmax(s, axis=-1).astype(v.dtype)
        return jnp.einsum('bhqk,bkhd->bqhd', p, v)

    out = lax.map(one_block, (jnp.arange(nb), qb))
    return jnp.moveaxis(out, 0, 1).reshape(B, S, H * V_DIM)


def mla_mixer(x, k, v, w_dq, q_norm, w_uq, w_out):
    cq = rms_norm(x @ w_dq, q_norm)
    q = jnp.einsum('bsr,rhd->bshd', cq, w_uq)
    q = jnp.concatenate([q[..., :QK_NOPE_DIM], apply_rope(q[..., QK_NOPE_DIM:])], axis=-1)
    return causal_block_attention(q, k, v) @ w_out


def swiglu(x, w_gate, w_up, w_down):
    return (jax.nn.silu(x @ w_gate) * (x @ w_up)) @ w_down


def moe_ffn(x, router_w, router_bias, w_gate, w_up, w_down, s_gate, s_up, s_down):
    B, S, D = x.shape
    T = B * S
    xf = x.reshape(T, D)
    scores = jax.nn.sigmoid((xf @ router_w).astype(jnp.float32))
    choice = scores + router_bias.astype(jnp.float32)
    grp = choice.reshape(T, N_EXPERT_GROUPS, N_EXPERTS // N_EXPERT_GROUPS)
    grp_score = jnp.sum(lax.top_k(grp, 2)[0], axis=-1)
    _, gidx = lax.top_k(grp_score, TOPK_GROUPS)
    gmask = jnp.any(gidx[:, :, None] == jnp.arange(N_EXPERT_GROUPS)[None, None, :], axis=1)
    emask = jnp.repeat(gmask, N_EXPERTS // N_EXPERT_GROUPS, axis=1)
    _, eidx = lax.top_k(jnp.where(emask, choice, -jnp.inf), TOP_K)
    gate = jnp.take_along_axis(scores, eidx, axis=1)
    gate = gate / jnp.sum(gate, axis=-1, keepdims=True) * ROUTED_SCALE

    A = T * TOP_K
    e_flat = eidx.reshape(-1)
    g_flat = gate.reshape(-1).astype(x.dtype)
    tok_flat = jnp.repeat(jnp.arange(T, dtype=jnp.int32), TOP_K)
    order = jnp.argsort(e_flat, stable=True)
    e_sorted, tok_sorted, g_sorted = e_flat[order], tok_flat[order], g_flat[order]
    counts = jnp.bincount(e_flat, length=N_EXPERTS)
    start = jnp.cumsum(counts) - counts
    padded = (counts + ROW_BLOCK - 1) // ROW_BLOCK * ROW_BLOCK
    pad_end = jnp.cumsum(padded)
    pad_start = pad_end - padded
    dest = pad_start[e_sorted] + (jnp.arange(A) - start[e_sorted])
    n_blocks = (A + ROW_BLOCK - 1) // ROW_BLOCK + N_EXPERTS
    P = n_blocks * ROW_BLOCK
    tok_pad = jnp.full((P,), T, dtype=jnp.int32).at[dest].set(tok_sorted)
    g_pad = jnp.zeros((P,), x.dtype).at[dest].set(g_sorted)
    blk_expert = jnp.minimum(jnp.searchsorted(pad_end, jnp.arange(n_blocks) * ROW_BLOCK, side='right'),
                             N_EXPERTS - 1)
    x_pad = jnp.concatenate([xf, jnp.zeros((1, D), x.dtype)], axis=0)

    def expert_block(args):
        tok_b, g_b, e = args
        xi = x_pad[tok_b]
        return swiglu(xi, w_gate[e], w_up[e], w_down[e]) * g_b[:, None]

    yb = lax.map(expert_block, (tok_pad.reshape(n_blocks, ROW_BLOCK), g_pad.reshape(n_blocks, ROW_BLOCK), blk_expert))
    routed = jnp.zeros((T + 1, D), x.dtype).at[tok_pad].add(yb.reshape(P, D))[:T]
    shared = swiglu(xf, s_gate, s_up, s_down)
    return (routed + shared).reshape(B, S, D)


def setup_inputs(seed: int = 0) -> dict:
    key = jax.random.key(seed)
    ks = jax.random.split(key, 24)
    f32 = jnp.float32

    def nrm(k, shape, fan_in, scale=1.0):
        return jax.random.normal(k, shape, f32) * (scale * fan_in ** -0.5)

    def gain(k, shape):
        return 1.0 + 0.02 * jax.random.normal(k, shape, f32)

    def bias(k, shape):
        return 0.02 * jax.random.normal(k, shape, f32)

    return {
        'x': jax.random.normal(ks[0], (BATCH, SEQ, D_MODEL), f32),
        'a_w_in': nrm(ks[1], (N_A_LAYERS, D_MODEL, D_MODEL), D_MODEL),
        'a_w_grp': nrm(ks[2], (N_A_LAYERS, N_POOL_GROUPS, POOL_GROUP_DIM, POOL_GROUP_DIM), POOL_GROUP_DIM),
        'a_scale': gain(ks[3], (N_A_LAYERS, D_MODEL)),
        'a_w_out': nrm(ks[4], (N_A_LAYERS, D_MODEL, D_MODEL), D_MODEL, BETA),
        'kv_w_down': nrm(ks[5], (D_MODEL, KV_LORA_RANK + QK_ROPE_DIM), D_MODEL),
        'kv_norm': gain(ks[6], (KV_LORA_RANK,)),
        'kv_w_uk': nrm(ks[7], (KV_LORA_RANK, N_HEADS, QK_NOPE_DIM), KV_LORA_RANK),
        'kv_w_uv': nrm(ks[8], (KV_LORA_RANK, N_HEADS, V_DIM), KV_LORA_RANK),
        'b_w_dq': nrm(ks[9], (N_B_LAYERS, D_MODEL, Q_LORA_RANK), D_MODEL),
        'b_q_norm': gain(ks[10], (N_B_LAYERS, Q_LORA_RANK)),
        'b_w_uq': nrm(ks[11], (N_B_LAYERS, Q_LORA_RANK, N_HEADS, QK_DIM), Q_LORA_RANK),
        'b_w_out': nrm(ks[12], (N_B_LAYERS, N_HEADS * V_DIM, D_MODEL), N_HEADS * V_DIM, BETA),
        'ln1_g': gain(ks[13], (DEPTH, D_MODEL)),
        'ln1_b': bias(ks[14], (DEPTH, D_MODEL)),
        'ln2_g': gain(ks[15], (DEPTH, D_MODEL)),
        'ln2_b': bias(ks[16], (DEPTH, D_MODEL)),
        'router_w': nrm(ks[17], (DEPTH, D_MODEL, N_EXPERTS), D_MODEL),
        'router_bias': 0.01 * jax.random.normal(ks[18], (DEPTH, N_EXPERTS), f32),
        'exp_w_gate': nrm(ks[19], (DEPTH, N_EXPERTS, D_MODEL, EXPERT_DIM), D_MODEL),
        'exp_w_up': nrm(ks[20], (DEPTH, N_EXPERTS, D_MODEL, EXPERT_DIM), D_MODEL),
        'exp_w_down': nrm(ks[21], (DEPTH, N_EXPERTS, EXPERT_DIM, D_MODEL), EXPERT_DIM, BETA),
        'sh_w_gate': nrm(ks[22], (DEPTH, D_MODEL, SHARED_DIM), D_MODEL),
        'sh_w_up': nrm(jax.random.fold_in(ks[22], 1), (DEPTH, D_MODEL, SHARED_DIM), D_MODEL),
        'sh_w_down': nrm(ks[23], (DEPTH, SHARED_DIM, D_MODEL), SHARED_DIM, BETA),
    }


def reference(x, a_w_in, a_w_grp, a_scale, a_w_out, kv_w_down, kv_norm, kv_w_uk, kv_w_uv,
              b_w_dq, b_q_norm, b_w_uq, b_w_out, ln1_g, ln1_b, ln2_g, ln2_b,
              router_w, router_bias, exp_w_gate, exp_w_up, exp_w_down,
              sh_w_gate, sh_w_up, sh_w_down):
    k_sh, v_sh = None, None
    for l in range(DEPTH):
        if l < N_A_LAYERS:
            y = pool_mixer(x, a_w_in[l], a_w_grp[l], a_scale[l], a_w_out[l])
        else:
            if l == N_A_LAYERS:
                k_sh, v_sh = shared_kv(x, kv_w_down, kv_norm, kv_w_uk, kv_w_uv)
            j = l - N_A_LAYERS
            y = mla_mixer(x, k_sh, v_sh, b_w_dq[j], b_q_norm[j], b_w_uq[j], b_w_out[j])
        x = layer_norm(ALPHA * x + y, ln1_g[l], ln1_b[l])
        f = moe_ffn(x, router_w[l], router_bias[l], exp_w_gate[l], exp_w_up[l], exp_w_down[l],
                    sh_w_gate[l], sh_w_up[l], sh_w_down[l])
        x = layer_norm(ALPHA * x + f, ln2_g[l], ln2_b[l])
    return x
```

```cpp
#include <hip/hip_runtime.h>
#include <cstdio>
#include <cstdint>

#ifndef MK_N_LAUNCHES
#define MK_N_LAUNCHES 1
#endif

#ifndef L0F8
#define L0F8 2
#endif
#if L0F8 == 2
#define P_G4SEL P_G4F
#define P_G5SEL P_G5F
#elif L0F8 == 1
#define P_G4SEL P_G4H
#define P_G5SEL P_G5F
#else
#define P_G4SEL P_G4
#define P_G5SEL P_G5
#endif
#define LAS __attribute__((address_space(3)))
#define GAS __attribute__((address_space(1)))
typedef unsigned short bf16_t;
typedef short bf16x8 __attribute__((ext_vector_type(8)));
typedef short s16x4 __attribute__((ext_vector_type(4)));
typedef float f32x2 __attribute__((ext_vector_type(2)));
typedef float f32x4 __attribute__((ext_vector_type(4)));
typedef float f32x16 __attribute__((ext_vector_type(16)));
typedef unsigned u32x2 __attribute__((ext_vector_type(2)));
typedef unsigned u32x4 __attribute__((ext_vector_type(4)));

constexpr int T = 8192, DM = 2048, SEQ = 4096, NBATCH = 2, NH = 16, NE = 64, TOPK = 8, ED = 512;
constexpr int DQK = 192, DV = 128, NCKQ = 1280;
constexpr float ALPHA = 1.4142135623730951f;
constexpr float LN_EPS = 1e-5f, RMS_EPS = 1e-6f;
constexpr int NSLOT_ROWS = 8192 + 65536 + 64 * 256;
constexpr int NCHUNK = T / 32;

constexpr size_t MiB = 1u << 20, KiB = 1u << 10;
constexpr size_t WS_CTL = 0, CTL_ZERO_BYTES = 1 * MiB;
constexpr size_t WS_ROPE = 1 * MiB;
constexpr size_t WS_RWHI = 2 * MiB;
constexpr size_t WS_RWLO = 2 * MiB + 512 * KiB;
constexpr size_t WS_RC = 3 * MiB;
constexpr size_t WS_CNT = 3 * MiB + 64 * KiB;
constexpr size_t WS_TOKE = 3 * MiB + 256 * KiB;
constexpr size_t WS_TOKG = 3 * MiB + 512 * KiB;
constexpr size_t WS_TOKS = 3 * MiB + 768 * KiB;
constexpr size_t WS_ROWIDX = 4 * MiB;
constexpr size_t WS_MTE = 4 * MiB + 512 * KiB;
constexpr size_t WS_NMT = 4 * MiB + 516 * KiB;
constexpr size_t WS_RSTAT = 5 * MiB;
constexpr size_t WS_WIN = 8 * MiB, WS_WGRP = 16 * MiB, WS_WOUT = 18 * MiB, WS_WKVQ = 26 * MiB, WS_WUP = 31 * MiB, WS_WBO = 38 * MiB;
constexpr size_t WS_WGU = 48 * MiB;
constexpr size_t WS_WD = 568 * MiB;
constexpr size_t WS_XP = 828 * MiB;
constexpr size_t WS_Q = 828 * MiB, WS_K = 876 * MiB, WS_V = 924 * MiB;
constexpr size_t WS_POOLED = 956 * MiB;
constexpr size_t WS_ATT = 956 * MiB;
constexpr size_t WS_X1Q = 956 * MiB;
constexpr size_t WS_MIXED = 988 * MiB;
constexpr size_t WS_CKQ = 988 * MiB;
constexpr size_t WS_Z = 1020 * MiB;
constexpr size_t WS_X1F = 1084 * MiB, WS_X1B = 1148 * MiB;
constexpr size_t WS_X2F = 1180 * MiB, WS_X2B = 1244 * MiB;
constexpr size_t WS_H = 1276 * MiB;
constexpr size_t WS_Y = 1364 * MiB;
constexpr size_t WS_END = 1716 * MiB;

constexpr int CW_BAR = 4096;

constexpr int RING_BYTES = 131072;
constexpr int MISC_OFF = RING_BYTES + 320;
constexpr int LDS_BYTES = 147456;

#define LDS_WAIT() asm volatile("s_waitcnt lgkmcnt(0)" ::: "memory")
#define VM_WAIT() asm volatile("s_waitcnt vmcnt(0)" ::: "memory")
__device__ __forceinline__ unsigned cvt_pk_bf16(float lo, float hi) { unsigned r; asm volatile("v_cvt_pk_bf16_f32 %0, %1, %2" : "=v"(r) : "v"(lo), "v"(hi)); return r; }
__device__ __forceinline__ float bf_lo(unsigned w) { return __uint_as_float(w << 16); }
__device__ __forceinline__ float bf_hi(unsigned w) { return __uint_as_float(w & 0xffff0000u); }
__device__ __forceinline__ float wave_sum(float v) {
#pragma unroll
    for (int o = 1; o < 64; o <<= 1) v += __shfl_xor(v, o);
    return v;
}

#define XB_TMO      128
#define XB_XCNT(j)  (256  + 64 * (j))
#define XB_XSUB(j)  (1280 + 64 * (j))
#define XB_XGEN(j)  (2304 + 64 * (j))
#define XB_TOP      3328
#define XB_TOPGEN   3392
#define XCD_BAR_WORDS 3456
#define XB_SPIN_CAP (1u << 18)
__device__ __forceinline__ unsigned xb_ld(unsigned* p)              { return __hip_atomic_load(p, __ATOMIC_RELAXED, __HIP_MEMORY_SCOPE_AGENT); }
__device__ __forceinline__ unsigned xb_add(unsigned* p, unsigned v) { return __hip_atomic_fetch_add(p, v, __ATOMIC_RELAXED, __HIP_MEMORY_SCOPE_AGENT); }
__device__ __forceinline__ unsigned xb_xcc_id() { return (unsigned)__builtin_amdgcn_s_getreg((3 << 11) | 20) & 0xFu; }
#define XB_SPIN(cond, bar) do { unsigned _sp = 0; while (cond) { __builtin_amdgcn_s_sleep(1); \
    if ((++_sp & 255u) == 0u) { if (xb_ld(&(bar)[XB_TMO])) break; if (_sp > XB_SPIN_CAP) { atomicAdd(&(bar)[XB_TMO], 1u); break; } } } } while (0)
struct XcdBarrier { unsigned* bar; unsigned x; volatile LAS unsigned* st; };
__device__ __forceinline__ XcdBarrier xcd_barrier_post(unsigned* bar, volatile LAS unsigned* st) {
    XcdBarrier b; b.bar = bar; b.x = xb_xcc_id(); b.st = st;
    if (threadIdx.x == 0) { const unsigned rank = xb_add(&bar[XB_XCNT(b.x)], 1u); st[8] = rank; st[9] = b.x; }
    return b;
}
__device__ __forceinline__ void xcd_barrier_complete(unsigned* bar, unsigned x, unsigned& nloc, unsigned& nx) {
    const unsigned G = gridDim.x * gridDim.y * gridDim.z;
    unsigned sum, cnt, mine, sp = 0u;
    for (;;) {
        sum = 0u; cnt = 0u; mine = 0u;
#pragma unroll
        for (unsigned j = 0; j < 16; ++j) { const unsigned c = xb_ld(&bar[XB_XCNT(j)]); sum += c; cnt += (c > 0u) ? 1u : 0u; mine = (j == x) ? c : mine; }
        if (sum == G) break;
        __builtin_amdgcn_s_sleep(1);
        if ((++sp & 255u) == 0u) { if (xb_ld(&bar[XB_TMO])) break; if (sp > XB_SPIN_CAP) { atomicAdd(&bar[XB_TMO], 1u); break; } }
    }
    nloc = mine > 0u ? mine : 1u; nx = cnt > 0u ? cnt : 1u;
}
__device__ __forceinline__ void xcd_barrier(const XcdBarrier& b) {
    asm volatile("s_waitcnt vmcnt(0)" ::: "memory");
    __syncthreads();
    if (threadIdx.x == 0) {
        unsigned* bar = b.bar;
        __builtin_amdgcn_s_waitcnt(0);
        unsigned nloc = b.st[0], nx = b.st[1];
        if (nloc == 0u) { xcd_barrier_complete(bar, b.x, nloc, nx); b.st[0] = nloc; b.st[1] = nx; }
        const unsigned old = xb_add(&bar[XB_XSUB(b.x)], 1u);
        const unsigned gen = old / nloc;
        if (old + 1u == (gen + 1u) * nloc) {
            __builtin_amdgcn_fence(__ATOMIC_RELEASE, "agent");
            asm volatile("s_waitcnt vmcnt(0)" ::: "memory");
            const unsigned og = xb_add(&bar[XB_TOP], 1u);
            const unsigned tg = og / nx;
            if (og + 1u == (tg + 1u) * nx) xb_add(&bar[XB_TOPGEN], 1u);
            else XB_SPIN(xb_ld(&bar[XB_TOPGEN]) == tg, bar);
            __builtin_amdgcn_fence(__ATOMIC_ACQUIRE, "agent");
            xb_add(&bar[XB_XGEN(b.x)], 1u);
            asm volatile("s_waitcnt vmcnt(0)" ::: "memory");
        } else {
            XB_SPIN(xb_ld(&bar[XB_XGEN(b.x)]) == gen, bar);
            __builtin_amdgcn_fence(__ATOMIC_ACQUIRE, "agent");
            asm volatile("s_waitcnt vmcnt(0)" ::: "memory");
        }
    }
    __syncthreads();
}

namespace pg8 {
constexpr int BM = 256, BK = 64, HALF = 128, HTB = HALF * BK * 2, STAGE_BYTES = 8 * HTB, NXCD = 8, WGM = 8;
__host__ __device__ __forceinline__ int lds_byte(int r, int c) { const int st = (r >> 4) * 2 + (c >> 5), rr = r & 15, cc = c & 31, ob = rr * 64 + cc * 2; return st * 1024 + (ob ^ (((ob >> 9) & 1) << 5)); }
__host__ __device__ __forceinline__ void stage_rc(int b, int& R, int& C) { const int st = b / 1024, sb = b % 1024, swz = sb ^ (((sb >> 9) & 1) << 5); R = (st >> 1) * 16 + swz / 64; C = (st & 1) * 32 + (swz % 64) / 2; }
__host__ __device__ __forceinline__ int perm32(int rho) { const int n = rho >> 4, i = rho & 15; return 8 * (i >> 2) + 4 * n + (i & 3); }

typedef int v8i32 __attribute__((ext_vector_type(8)));
typedef int v4i32 __attribute__((ext_vector_type(4)));
template <bool F8> struct FragT { typedef bf16x8 type; };
template <> struct FragT<true> { typedef v8i32 type; };
__device__ __forceinline__ void ldfrag(bf16x8& d, const LAS unsigned char* p) { d = *(const LAS bf16x8*)p; }
__device__ __forceinline__ void ldfrag(v8i32& d, const LAS unsigned char* p) { const v4i32 x = *(const LAS v4i32*)p, y = *(const LAS v4i32*)(p + 16); d = __builtin_shufflevector(x, y, 0, 1, 2, 3, 4, 5, 6, 7); }
__device__ __forceinline__ f32x4 mma(v8i32 b, v8i32 a, f32x4 c, int sc) {
    asm volatile("v_mfma_scale_f32_16x16x128_f8f6f4 %0, %1, %2, %0, %3, %3 op_sel_hi:[0,0,0]" : "+v"(c) : "v"(b), "v"(a), "v"(sc)); return c; }
__device__ __forceinline__ f32x4 mma(bf16x8 b, bf16x8 a, f32x4 c, int) { return __builtin_amdgcn_mfma_f32_16x16x32_bf16(b, a, c, 0, 0, 0); }
struct Unit { const char* A; const char* B; const int* rows; int m0, pn, aux; };

struct TileOrder {
    int nM, nN, nwg, G, c;
    __device__ __forceinline__ void init(int nM_, int nN_, int G_, int c_) { nM = nM_; nN = nN_; nwg = nM * nN; G = G_; c = c_; }
    __device__ __forceinline__ bool next(int i, int& pm, int& pn) const {
        const long L = (long)i * G + c; if (L >= nwg) return false;
        int wgid = (int)L; { const int q = nwg / NXCD, r = nwg % NXCD, xcd = wgid % NXCD, off = wgid / NXCD; wgid = (xcd < r ? xcd * (q + 1) : r * (q + 1) + (xcd - r) * q) + off; }
        const int nig = WGM * nN, gid = wgid / nig, fm = gid * WGM, gsz = (nM - fm) < WGM ? (nM - fm) : WGM;
        pm = fm + ((wgid % nig) % gsz); pn = (wgid % nig) / gsz; return true;
    }
};

template <class Epi, class Sched>
__device__ __forceinline__ void gemm_phase(LAS unsigned char* lds, const int lda_b, const int K, const Sched& S, const Epi& E) {
    const int tid = threadIdx.x, wid = __builtin_amdgcn_readfirstlane(tid >> 6), lane = tid & 63, wr = wid >> 2, wc = wid & 3, fr = lane & 15, fq = lane >> 4;
    const int nt = K / BK;
    int Rs[2]; unsigned Cb[2], voffB[2];
#pragma unroll
    for (int i = 0; i < 2; ++i) { int R, C; stage_rc(tid * 16 + i * 8192, R, C); const int Rb = Epi::PERM ? ((R & ~31) + perm32(R & 31)) : R;
        Rs[i] = R; Cb[i] = (unsigned)C * 2u; voffB[i] = (unsigned)(Rb * K + C) * 2u; }
    const size_t kstep = (size_t)(BK * 2);
    const size_t hstepB = (size_t)HALF * K * 2;
    const unsigned ldsw = (unsigned)wid * 1024u;
    int sc1 = 0x7f7f7f7f; asm volatile("" : "+v"(sc1));
    constexpr bool F8 = Sched::FP8;
    const int aoff = lds_byte(wr * 64 + fr, fq * (F8 ? 16 : 8)), boff = lds_byte(wc * 32 + fr, fq * (F8 ? 16 : 8));
#define PG8_SA(b, h) (((b) * 2 + (h)) * HTB)
#define PG8_SB(b, h) ((4 + (b) * 2 + (h)) * HTB)
#define PG8_STAGE(bufoff, gbase, voff) do { _Pragma("unroll") for (int _i = 0; _i < 2; ++_i) \
        __builtin_amdgcn_global_load_lds((const unsigned*)((const char*)(gbase) + (voff)[_i]), (LAS unsigned*)(lds + (bufoff) + ldsw + _i * 8192), 16, 0, 0); } while (0)
#define PG8_LDA(dst, b, h) do { _Pragma("unroll") for (int m = 0; m < 4; ++m) _Pragma("unroll") for (int k = 0; k < NK; ++k) pg8::ldfrag(dst[m][k], lds + PG8_SA(b, h) + aoff + m * 2048 + k * 1024); } while (0)
#define PG8_LDB(dst, b, h) do { _Pragma("unroll") for (int n = 0; n < 2; ++n) _Pragma("unroll") for (int k = 0; k < NK; ++k) pg8::ldfrag(dst[n][k], lds + PG8_SB(b, h) + boff + n * 2048 + k * 1024); } while (0)
#define PG8_MMA(ai, bj, At, Bt) do { __builtin_amdgcn_s_setprio(1); _Pragma("unroll") for (int m = 0; m < 4; ++m) _Pragma("unroll") for (int n = 0; n < 2; ++n) _Pragma("unroll") for (int k = 0; k < NK; ++k) \
        acc[ai][bj][m][n] = pg8::mma(Bt[n][k], At[m][k], acc[ai][bj][m][n], sc1); __builtin_amdgcn_s_setprio(0); } while (0)
#define PG8_WAIT_V(n) asm volatile("s_waitcnt vmcnt(" #n ")" ::: "memory")
#define PG8_WAIT_L(n) asm volatile("s_waitcnt lgkmcnt(" #n ")" ::: "memory")
#define PG8_BAR __builtin_amdgcn_s_barrier()
#define PG8_SCHED __builtin_amdgcn_sched_barrier(0)
#define PG8_MKOFF(u, vo) do { _Pragma("unroll") for (int _h = 0; _h < 2; ++_h) _Pragma("unroll") for (int _i = 0; _i < 2; ++_i) { const int _R = _h * HALF + Rs[_i]; \
        const int _row = (u).rows ? (u).rows[_R] : _R; vo[_h][_i] = (unsigned)_row * (unsigned)lda_b + Cb[_i]; } } while (0)
    Unit cur, nxt; int ui = 0;
    if (!S.next(0, cur)) return;
    f32x4 acc[2][2][4][2];
#pragma unroll
    for (int a = 0; a < 2; ++a)
#pragma unroll
        for (int b = 0; b < 2; ++b)
#pragma unroll
            for (int m = 0; m < 4; ++m)
#pragma unroll
                for (int n = 0; n < 2; ++n) acc[a][b][m][n] = (f32x4){0.f, 0.f, 0.f, 0.f};
    typedef typename pg8::FragT<F8>::type frag_t; constexpr int NK = F8 ? 1 : 2;
    frag_t At[4][NK], B0[2][NK], B1[2][NK];
    unsigned voC[2][2], voN[2][2];
    PG8_MKOFF(cur, voC);
    const char* cA = cur.A; const char* cB = cur.B;
    PG8_STAGE(PG8_SB(0, 0), cB, voffB); PG8_STAGE(PG8_SA(0, 0), cA, voC[0]); PG8_STAGE(PG8_SB(0, 1), cB + hstepB, voffB); PG8_STAGE(PG8_SA(0, 1), cA, voC[1]);
    if (wr == 1) PG8_BAR;
    PG8_WAIT_V(4); PG8_BAR;
    PG8_STAGE(PG8_SB(1, 0), cB + kstep, voffB); PG8_STAGE(PG8_SA(1, 0), cA + kstep, voC[0]); PG8_STAGE(PG8_SB(1, 1), cB + hstepB + kstep, voffB);
    PG8_WAIT_V(6); PG8_BAR;
    for (;;) {
        const bool has_next = S.next(ui + 1, nxt);
        const char* nA = has_next ? nxt.A : cA; const char* nB = has_next ? nxt.B : cB;
        if (has_next) { PG8_MKOFF(nxt, voN); }
        else {
#pragma unroll
            for (int h = 0; h < 2; ++h)
#pragma unroll
                for (int i = 0; i < 2; ++i) voN[h][i] = voC[h][i]; }
        for (int t = 0; t < nt; t += 2) {
            const bool last = (t == nt - 2);
            const char* a1 = cA + (size_t)(t + 1) * kstep;
            const char* a2 = last ? nA : cA + (size_t)(t + 2) * kstep; const char* b2 = last ? nB : cB + (size_t)(t + 2) * kstep;
            const char* a3 = a2 + kstep; const char* b3 = b2 + kstep;
            unsigned v2[2][2];
#pragma unroll
            for (int h = 0; h < 2; ++h)
#pragma unroll
                for (int i = 0; i < 2; ++i) v2[h][i] = last ? voN[h][i] : voC[h][i];
            PG8_LDB(B0, 0, 0); PG8_SCHED; PG8_LDA(At, 0, 0); PG8_STAGE(PG8_SA(1, 1), a1, voC[1]);
            PG8_WAIT_L(8); PG8_BAR; PG8_WAIT_L(0); PG8_MMA(0, 0, At, B0); PG8_BAR; PG8_SCHED;
            PG8_LDB(B1, 0, 1); PG8_STAGE(PG8_SB(0, 0), b2, voffB);
            PG8_BAR; PG8_WAIT_L(0); PG8_MMA(0, 1, At, B1); PG8_BAR;
            PG8_LDA(At, 0, 1); PG8_STAGE(PG8_SA(0, 0), a2, v2[0]);
            PG8_BAR; PG8_WAIT_L(0); PG8_MMA(1, 0, At, B0); PG8_BAR; PG8_SCHED;
            PG8_STAGE(PG8_SB(0, 1), b2 + hstepB, voffB);
            PG8_WAIT_V(6); PG8_BAR; PG8_MMA(1, 1, At, B1); PG8_BAR;
            PG8_LDB(B0, 1, 0); PG8_SCHED; PG8_LDA(At, 1, 0); PG8_STAGE(PG8_SA(0, 1), a2, v2[1]);
            PG8_WAIT_L(8); PG8_BAR; PG8_WAIT_L(0); PG8_MMA(0, 0, At, B0); PG8_BAR; PG8_SCHED;
            PG8_LDB(B1, 1, 1); PG8_STAGE(PG8_SB(1, 0), b3, voffB);
            PG8_BAR; PG8_WAIT_L(0); PG8_MMA(0, 1, At, B1); PG8_BAR;
            PG8_LDA(At, 1, 1); PG8_STAGE(PG8_SA(1, 0), a3, v2[0]);
            PG8_BAR; PG8_WAIT_L(0); PG8_MMA(1, 0, At, B0); PG8_BAR; PG8_SCHED;
            PG8_STAGE(PG8_SB(1, 1), b3 + hstepB, voffB);
            PG8_WAIT_V(6); PG8_BAR; PG8_MMA(1, 1, At, B1); PG8_BAR;
        }
        if constexpr (F8) asm volatile("s_nop 15\n\ts_nop 15\n\ts_nop 7" ::: "memory");
        E(acc, cur, wr, wc, fr, fq);
        if (!has_next) break;
#pragma unroll
        for (int a = 0; a < 2; ++a)
#pragma unroll
            for (int b = 0; b < 2; ++b)
#pragma unroll
                for (int m = 0; m < 4; ++m)
#pragma unroll
                    for (int n = 0; n < 2; ++n) acc[a][b][m][n] = (f32x4){0.f, 0.f, 0.f, 0.f};
        cur = nxt; cA = nA; cB = nB; ++ui;
#pragma unroll
        for (int h = 0; h < 2; ++h)
#pragma unroll
            for (int i = 0; i < 2; ++i) voC[h][i] = voN[h][i];
    }
    PG8_WAIT_V(0);
    if (wr == 0) PG8_BAR;
    PG8_BAR;
#undef PG8_SA
#undef PG8_SB
#undef PG8_STAGE
#undef PG8_LDA
#undef PG8_LDB
#undef PG8_MMA
#undef PG8_WAIT_V
#undef PG8_WAIT_L
#undef PG8_BAR
#undef PG8_SCHED
#undef PG8_MKOFF
}
}

__device__ __forceinline__ unsigned pk4_fp8(float a, float b, float c, float d) { int w = 0; w = __builtin_amdgcn_cvt_pk_fp8_f32(a, b, w, false); w = __builtin_amdgcn_cvt_pk_fp8_f32(c, d, w, true); return (unsigned)w; }
constexpr float W8_SCALE = 32.f;
struct EpiBf16 {
    static constexpr bool PERM = true;
    bf16_t* O; int ldc; const float* colscale; int nt; float sc;
    __device__ __forceinline__ void operator()(const f32x4 (&acc)[2][2][4][2], const pg8::Unit& u, int wr, int wc, int fr, int fq) const {
        const int col0 = u.pn * 256 + wc * 32 + 8 * fq;
        f32x4 scv[2][2];
#pragma unroll
        for (int bj = 0; bj < 2; ++bj) { scv[bj][0] = colscale ? *(const f32x4*)(colscale + col0 + bj * 128) : (f32x4){1.f, 1.f, 1.f, 1.f}; scv[bj][1] = colscale ? *(const f32x4*)(colscale + col0 + bj * 128 + 4) : (f32x4){1.f, 1.f, 1.f, 1.f}; scv[bj][0] *= sc; scv[bj][1] *= sc; }
#pragma unroll
        for (int ai = 0; ai < 2; ++ai)
#pragma unroll
            for (int m = 0; m < 4; ++m) { bf16_t* rowp = O + (size_t)(u.m0 + ai * 128 + wr * 64 + m * 16 + fr) * ldc + col0;
#pragma unroll
                for (int bj = 0; bj < 2; ++bj) { const f32x4 v0 = acc[ai][bj][m][0] * scv[bj][0], v1 = acc[ai][bj][m][1] * scv[bj][1];
                    u32x4 w; w.x = cvt_pk_bf16(v0[0], v0[1]); w.y = cvt_pk_bf16(v0[2], v0[3]); w.z = cvt_pk_bf16(v1[0], v1[1]); w.w = cvt_pk_bf16(v1[2], v1[3]);
                    if (nt) __builtin_nontemporal_store(w, (u32x4*)(rowp + bj * 128)); else *(u32x4*)(rowp + bj * 128) = w; } }
    }
};
struct EpiZ {
    static constexpr bool PERM = true;
    const float* resf; const bf16_t* resb; bf16_t* out;
    __device__ __forceinline__ void operator()(const f32x4 (&acc)[2][2][4][2], const pg8::Unit& u, int wr, int wc, int fr, int fq) const {
        const int col0 = u.pn * 256 + wc * 32 + 8 * fq;
#pragma unroll
        for (int ai = 0; ai < 2; ++ai)
#pragma unroll
            for (int mp = 0; mp < 2; ++mp) { f32x4 r[2][2][2];
#pragma unroll
                for (int mm = 0; mm < 2; ++mm) { const size_t off = (size_t)(u.m0 + ai * 128 + wr * 64 + (mp * 2 + mm) * 16 + fr) * DM + col0;
#pragma unroll
                    for (int bj = 0; bj < 2; ++bj) {
                        if (resf) { r[mm][bj][0] = *(const f32x4*)(resf + off + bj * 128); r[mm][bj][1] = *(const f32x4*)(resf + off + bj * 128 + 4); }
                        else { const u32x4 w = *(const u32x4*)(resb + off + bj * 128); r[mm][bj][0] = (f32x4){bf_lo(w.x), bf_hi(w.x), bf_lo(w.y), bf_hi(w.y)}; r[mm][bj][1] = (f32x4){bf_lo(w.z), bf_hi(w.z), bf_lo(w.w), bf_hi(w.w)}; } } }
#pragma unroll
                for (int mm = 0; mm < 2; ++mm) { const size_t off = (size_t)(u.m0 + ai * 128 + wr * 64 + (mp * 2 + mm) * 16 + fr) * DM + col0;
#pragma unroll
                    for (int bj = 0; bj < 2; ++bj) { const f32x4 z0 = r[mm][bj][0] * ALPHA + acc[ai][bj][mp * 2 + mm][0], z1 = r[mm][bj][1] * ALPHA + acc[ai][bj][mp * 2 + mm][1];
                        *(u32x4*)(out + off + bj * 128) = (u32x4){cvt_pk_bf16(z0[0], z0[1]), cvt_pk_bf16(z0[2], z0[3]), cvt_pk_bf16(z1[0], z1[1]), cvt_pk_bf16(z1[2], z1[3])}; } }
                asm volatile("" ::: "memory"); }
    }
};
struct EpiSwiGLU {
    static constexpr bool PERM = true;
    bf16_t* H; float sc; int f8;
    __device__ __forceinline__ void operator()(const f32x4 (&acc)[2][2][4][2], const pg8::Unit& u, int wr, int wc, int fr, int fq) const {
        const int col0 = u.pn * 128 + wc * 32 + 8 * fq;
#pragma unroll
        for (int ai = 0; ai < 2; ++ai)
#pragma unroll
            for (int m = 0; m < 4; ++m) { bf16_t* rowp = H + (size_t)(u.m0 + ai * 128 + wr * 64 + m * 16 + fr) * ED + col0;
                float h[8];
#pragma unroll
                for (int n = 0; n < 2; ++n)
#pragma unroll
                    for (int j = 0; j < 4; ++j) { const float g = acc[ai][0][m][n][j] * sc, up = acc[ai][1][m][n][j] * sc;
                        h[n * 4 + j] = g * __builtin_amdgcn_rcpf(1.f + __expf(-g)) * up; }
                if (f8) { *(u32x2*)((unsigned char*)H + (size_t)(u.m0 + ai * 128 + wr * 64 + m * 16 + fr) * ED + col0) = (u32x2){pk4_fp8(h[0], h[1], h[2], h[3]), pk4_fp8(h[4], h[5], h[6], h[7])}; }
                else { u32x4 w; w.x = cvt_pk_bf16(h[0], h[1]); w.y = cvt_pk_bf16(h[2], h[3]); w.z = cvt_pk_bf16(h[4], h[5]); w.w = cvt_pk_bf16(h[6], h[7]);
                *(u32x4*)rowp = w; } }
    }
};
struct EpiUp {
    static constexpr bool PERM = true;
    bf16_t* Q; bf16_t* Kb; bf16_t* V; const float* rstat; const f32x2* rope;
    __device__ __forceinline__ void operator()(const f32x4 (&acc)[2][2][4][2], const pg8::Unit& u, int wr, int wc, int fr, int fq) const {
        const int pn = u.pn;
        const float* rs = rstat + (pn < 16 ? 0 : T);
        float rsc[2][4];
#pragma unroll
        for (int ai = 0; ai < 2; ++ai)
#pragma unroll
            for (int m = 0; m < 4; ++m) rsc[ai][m] = rs[u.m0 + ai * 128 + wr * 64 + m * 16 + fr];
#pragma unroll
        for (int ai = 0; ai < 2; ++ai)
#pragma unroll
            for (int m = 0; m < 4; ++m) { const int row = u.m0 + ai * 128 + wr * 64 + m * 16 + fr; const float r = rsc[ai][m];
                if (pn < 24) {
#pragma unroll
                    for (int bj = 0; bj < 2; ++bj) { const f32x4 v0 = acc[ai][bj][m][0] * r, v1 = acc[ai][bj][m][1] * r;
                        u32x4 w; w.x = cvt_pk_bf16(v0[0], v0[1]); w.y = cvt_pk_bf16(v0[2], v0[3]); w.z = cvt_pk_bf16(v1[0], v1[1]); w.w = cvt_pk_bf16(v1[2], v1[3]);
                        const int d = wc * 32 + 8 * fq;
                        bf16_t* p;
                        if (pn < 8) p = Kb + (size_t)row * (NH * DQK) + (2 * pn + bj) * DQK + d;
                        else if (pn < 16) p = V + (size_t)row * DM + (pn - 8) * 256 + bj * 128 + d;
                        else p = Q + (size_t)row * (NH * DQK) + (2 * (pn - 16) + bj) * DQK + d;
                        *(u32x4*)p = w; }
                } else {
                    const int head = 4 * (pn - 24) + wc, i0 = 8 * fq, s = row & (SEQ - 1);
                    const f32x4* cs = (const f32x4*)(rope + (size_t)s * 32 + i0);
                    float o1[8], o2[8];
#pragma unroll
                    for (int q = 0; q < 4; ++q) { const f32x4 c2 = cs[q];
                        const int n = q >> 1, j = (q & 1) * 2;
                        const float x1a = acc[ai][0][m][n][j] * r, x2a = acc[ai][1][m][n][j] * r, x1b = acc[ai][0][m][n][j + 1] * r, x2b = acc[ai][1][m][n][j + 1] * r;
                        o1[2 * q] = x1a * c2[0] - x2a * c2[1]; o2[2 * q] = x2a * c2[0] + x1a * c2[1];
                        o1[2 * q + 1] = x1b * c2[2] - x2b * c2[3]; o2[2 * q + 1] = x2b * c2[2] + x1b * c2[3]; }
                    bf16_t* p = Q + (size_t)row * (NH * DQK) + head * DQK + 128 + i0;
                    u32x4 w; w.x = cvt_pk_bf16(o1[0], o1[1]); w.y = cvt_pk_bf16(o1[2], o1[3]); w.z = cvt_pk_bf16(o1[4], o1[5]); w.w = cvt_pk_bf16(o1[6], o1[7]);
                    *(u32x4*)p = w;
                    w.x = cvt_pk_bf16(o2[0], o2[1]); w.y = cvt_pk_bf16(o2[2], o2[3]); w.z = cvt_pk_bf16(o2[4], o2[5]); w.w = cvt_pk_bf16(o2[6], o2[7]);
                    *(u32x4*)(p + 32) = w;
                } }
    }
};

struct DenseSched {
    static constexpr bool FP8 = false;
    pg8::TileOrder ord; const char* A; const char* B; int lda_b, K; int mode;
    size_t agrp;
    __device__ __forceinline__ bool next(int i, pg8::Unit& u) const {
        int pm, pn; if (!ord.next(i, pm, pn)) return false;
        size_t ao = 0;
        if (mode == 1) ao = (size_t)(pn >> 1) * agrp; else if (mode == 2) ao = pn >= 16 ? 1024 : 0;
        u.A = A + ao + (size_t)pm * 256 * lda_b; u.B = B + (size_t)pn * 256 * K * 2; u.rows = nullptr; u.m0 = pm * 256; u.pn = pn; u.aux = 0;
        return true;
    }
};
template <bool F8_> struct MoeSchedT {
    static constexpr bool FP8 = F8_;
    const int* mte; const int* rowidx; const char* A; const char* W; int nunits, npn, G, c, gather; size_t wexp, wtile, atile; int i0, i1;
    __device__ __forceinline__ bool next(int i, pg8::Unit& u) const {
        if (i + i0 >= i1) return false;
        const int L = (i + i0) * G + c; if (L >= nunits) return false;
        const int mt = L / npn, pn = L - mt * npn; const int e = __builtin_amdgcn_readfirstlane(mte[mt]);
        u.A = gather ? A : A + (size_t)mt * atile; u.rows = gather ? rowidx + mt * 256 : nullptr;
        u.B = W + (size_t)e * wexp + (size_t)pn * wtile; u.m0 = mt * 256; u.pn = pn; u.aux = e;
        return true;
    }
};

typedef MoeSchedT<false> MoeSched;

namespace att {
constexpr int NW = 8, QBLK = 32, KVBLK = 64, QB = NW * QBLK;
constexpr int QS = NH * DQK, KS = NH * DQK, VS = DM, OS = DM;
constexpr int SHM_V = KVBLK * DV * 2, SHM_K = KVBLK * DQK * 2;
constexpr int ATT_LDS = 2 * SHM_V + 2 * SHM_K + NW * 64 * 4;
constexpr float SCALE = 0.07216878364870322f;
constexpr float THR = 8.f;
typedef LAS char* lptr;
#define KSWZ(row, colB) ((row) * 384 + ((colB) ^ ((((row) >> 1) & 7) << 4)))
#define SBAR() __builtin_amdgcn_sched_barrier(0)
__device__ __forceinline__ int v_st(int k, int c) { const int kk = (k & ~0xC) | ((k & 4) << 1) | ((k & 8) >> 1); return ((kk >> 3) * 4 + (c >> 5)) * 512 + ((kk & 7) * 32 + (c & 31)) * 2; }
__device__ __forceinline__ int v_rd_base(int lane) { return ((lane & 3) << 3) | (((lane >> 2) & 3) << 6) | (((lane >> 4) & 1) << 5) | (((lane >> 5) & 1) << 8); }
constexpr int v_rd_off(int d0, int ks, int half) { return d0 * 512 + ks * 4096 + half * 2048; }
__device__ __forceinline__ int crow(int r, int hi) { return (r & 3) + 8 * (r >> 2) + 4 * hi; }
__device__ __forceinline__ bf16x8 ld8(const bf16_t* p) { return *reinterpret_cast<const bf16x8*>(p); }
__device__ __forceinline__ void mask_tile(f32x16& p0, f32x16& p1, int dq) {
    const float NEG = -__builtin_inff();
#pragma unroll
    for (int r = 0; r < 16; ++r) {
        const int c = (r & 3) + 8 * (r >> 2);
        if (dq - c < 0) p0[r] = NEG;
        if (dq - c - 32 < 0) p1[r] = NEG;
    }
}
__device__ __forceinline__ void partialSM(f32x16& p0, f32x16& p1, float& m_reg, float& mn, float& alpha) {
    float pmax = p0[0];
#pragma unroll
    for (int r = 1; r < 16; ++r) pmax = fmaxf(pmax, p0[r]);
#pragma unroll
    for (int r = 0; r < 16; ++r) pmax = fmaxf(pmax, p1[r]);
    { auto rr = __builtin_amdgcn_permlane32_swap(__float_as_uint(pmax), __float_as_uint(pmax), false, false);
      pmax = fmaxf(__uint_as_float(rr[0]), __uint_as_float(rr[1])); }
    constexpr float C2 = 1.4426950408889634f * SCALE;
    if (__builtin_expect(__all((pmax - m_reg) * SCALE <= THR), 1)) { mn = m_reg; alpha = 1.f; }
    else { mn = fmaxf(m_reg, pmax); alpha = __builtin_amdgcn_exp2f((m_reg - mn) * C2); m_reg = mn; }
    const float mnL = -mn * C2;
#pragma unroll
    for (int r = 0; r < 16; ++r) p0[r] = fmaf(p0[r], C2, mnL);
#pragma unroll
    for (int r = 0; r < 16; ++r) p1[r] = fmaf(p1[r], C2, mnL);
#pragma unroll
    for (int r = 0; r < 16; ++r) p0[r] = __builtin_amdgcn_exp2f(p0[r]);
}
__device__ __forceinline__ void finishSM(f32x16& p0, f32x16& p1, float alpha, float& l_reg, bf16x8& pa0, bf16x8& pa1, bf16x8& pa2, bf16x8& pa3) {
#pragma unroll
    for (int r = 0; r < 16; ++r) p1[r] = __builtin_amdgcn_exp2f(p1[r]);
    float ps = 0;
#pragma unroll
    for (int r = 0; r < 16; ++r) ps += p0[r];
#pragma unroll
    for (int r = 0; r < 16; ++r) ps += p1[r];
    { auto rr = __builtin_amdgcn_permlane32_swap(__float_as_uint(ps), __float_as_uint(ps), false, false);
      ps = __uint_as_float(rr[0]) + __uint_as_float(rr[1]); }
    l_reg = l_reg * alpha + ps;
#define PK4(P, B_, OUT) do { unsigned a0 = cvt_pk_bf16(P[B_+0], P[B_+1]), a1 = cvt_pk_bf16(P[B_+2], P[B_+3]);                          \
        unsigned b0 = cvt_pk_bf16(P[B_+4], P[B_+5]), b1 = cvt_pk_bf16(P[B_+6], P[B_+7]);                                             \
        auto r0 = __builtin_amdgcn_permlane32_swap(a0, b0, false, false); auto r1 = __builtin_amdgcn_permlane32_swap(a1, b1, false, false); \
        u32x4 w = {r0[0], r1[0], r0[1], r1[1]}; OUT = *reinterpret_cast<bf16x8*>(&w); } while (0)
    PK4(p0, 0, pa0); PK4(p0, 8, pa1); PK4(p1, 0, pa2); PK4(p1, 8, pa3);
#undef PK4
}
template <int KB>
__device__ __forceinline__ void qkt(f32x16& p0, f32x16& p1, lptr K_lds, int r32, int hi, const bf16x8* qr) {
    p0 = f32x16{}; p1 = f32x16{};
    lptr kb[4];
#pragma unroll
    for (int dd = 0; dd < 4; ++dd) kb[dd] = K_lds + KB * SHM_K + KSWZ(r32, (dd * 16 + hi * 8) * 2);
#pragma unroll
    for (int d0 = 0; d0 < 12; ++d0) { lptr a = kb[d0 & 3] + (d0 >> 2) * 128;
        bf16x8 b0 = *reinterpret_cast<const LAS bf16x8*>(a);
        bf16x8 b1 = *reinterpret_cast<const LAS bf16x8*>(a + 32 * 384);
        p0 = __builtin_amdgcn_mfma_f32_32x32x16_bf16(b0, qr[d0], p0, 0, 0, 0);
        p1 = __builtin_amdgcn_mfma_f32_32x32x16_bf16(b1, qr[d0], p1, 0, 0, 0); }
}
template <int VB>
__device__ __forceinline__ void pv_tile(f32x16* o, int vb0, bf16x8 pa0, bf16x8 pa1, bf16x8 pa2, bf16x8 pa3) {
#define TRRD(dst, off) asm volatile("ds_read_b64_tr_b16 %0, %1 offset:%2" : "=&v"(dst) : "v"(vb0), "i"(off) : "memory")
#define PV_D0(d0) do { s16x4 l0, l1, l2, l3, h0, h1, h2, h3; constexpr int b_ = VB * SHM_V + v_rd_off(d0, 0, 0); \
        TRRD(l0, b_); TRRD(h0, b_ + 2048); TRRD(l1, b_ + 4096); TRRD(h1, b_ + 6144); TRRD(l2, b_ + 8192); TRRD(h2, b_ + 10240); TRRD(l3, b_ + 12288); TRRD(h3, b_ + 14336); \
        asm volatile("s_waitcnt lgkmcnt(0)" ::: "memory"); SBAR();   \
        o[d0] = __builtin_amdgcn_mfma_f32_32x32x16_bf16(pa0, (bf16x8){l0[0], l0[1], l0[2], l0[3], h0[0], h0[1], h0[2], h0[3]}, o[d0], 0, 0, 0);   \
        o[d0] = __builtin_amdgcn_mfma_f32_32x32x16_bf16(pa1, (bf16x8){l1[0], l1[1], l1[2], l1[3], h1[0], h1[1], h1[2], h1[3]}, o[d0], 0, 0, 0);   \
        o[d0] = __builtin_amdgcn_mfma_f32_32x32x16_bf16(pa2, (bf16x8){l2[0], l2[1], l2[2], l2[3], h2[0], h2[1], h2[2], h2[3]}, o[d0], 0, 0, 0);   \
        o[d0] = __builtin_amdgcn_mfma_f32_32x32x16_bf16(pa3, (bf16x8){l3[0], l3[1], l3[2], l3[3], h3[0], h3[1], h3[2], h3[3]}, o[d0], 0, 0, 0); } while (0)
    PV_D0(0); PV_D0(1); PV_D0(2); PV_D0(3);
#undef PV_D0
#undef TRRD
}
struct BlockRef { const bf16_t* Q; const bf16_t* K; const bf16_t* V; bf16_t* O; int P0; };
struct Seam { bf16x8 qr[12]; };
#define VMW() asm volatile("s_waitcnt vmcnt(0)" ::: "memory")
#define VMWN(n) asm volatile("s_waitcnt vmcnt(%0)" :: "i"(n) : "memory")
#define SLOAD_H(Kp, Vp, k0) do { st_v0 = ld8((Vp) + (size_t)((k0) + sr) * VS + sc); st_v1 = ld8((Vp) + (size_t)((k0) + 32 + sr) * VS + sc); \
        const bf16_t* kp_ = (Kp) + (size_t)((k0) + krow) * KS + kc8; st_k0 = ld8(kp_); st_k1 = ld8(kp_ + 64); st_k2 = ld8(kp_ + 128); } while (0)
#define SWRITE_H(bf) do { lptr kd_ = K_lds + (bf) * SHM_K + kws; *(LAS bf16x8*)kd_ = st_k0; *(LAS bf16x8*)(kd_ + 128) = st_k1; *(LAS bf16x8*)(kd_ + 256) = st_k2; \
        *(LAS bf16x8*)(V_lds + (bf) * SHM_V + vst0) = st_v0; *(LAS bf16x8*)(V_lds + (bf) * SHM_V + vst1) = st_v1; } while (0)
__device__ __forceinline__ void attn_prime(const BlockRef& cur, lptr lds, Seam& S) {
    const int tid = threadIdx.x, wid = __builtin_amdgcn_readfirstlane(tid >> 6), lane = tid & 63, r32 = lane & 31, hi = lane >> 5;
    const int sr = tid >> 4, sc = (tid & 15) * 8, vst0 = v_st(sr, sc), vst1 = v_st(32 + sr, sc), krow = tid >> 3, kc8 = (tid & 7) * 8, kws = KSWZ(krow, (tid & 7) * 16);
    lptr V_lds = lds; lptr K_lds = lds + 2 * SHM_V;
    bf16x8 st_v0, st_v1, st_k0, st_k1, st_k2;
#pragma unroll
    for (int d0 = 0; d0 < 12; ++d0) S.qr[d0] = ld8(cur.Q + (size_t)(wid * QBLK + r32) * QS + d0 * 16 + hi * 8);
    SLOAD_H(cur.K, cur.V, 0); VMW(); SWRITE_H(0);
    __syncthreads();
}
__device__ __forceinline__ void attn_block(const BlockRef& cur, const BlockRef& nxt, lptr lds, Seam& S) {
    const int tid = threadIdx.x, wid = __builtin_amdgcn_readfirstlane(tid >> 6), lane = tid & 63, r32 = lane & 31, hi = lane >> 5;
    const int NT = cur.P0 / KVBLK + QB / KVBLK;
    const int qlo = cur.P0 + wid * QBLK, qm = qlo + r32 - 4 * hi;
    lptr V_lds = lds; lptr K_lds = lds + 2 * SHM_V;
    LAS float* ws = (LAS float*)(lds + 2 * SHM_V + 2 * SHM_K) + wid * 64; LAS float* li_l = ws; LAS float* al_l = ws + 32;
    float m_reg = -1e30f, l_reg = 0; f32x16 o[4] = {};
    const int sr = tid >> 4, sc = (tid & 15) * 8, vst0 = v_st(sr, sc), vst1 = v_st(32 + sr, sc);
    const int krow = tid >> 3, kc8 = (tid & 7) * 8, kws = KSWZ(krow, (tid & 7) * 16);
    const int vb0 = (int)(unsigned)(uintptr_t)V_lds + v_rd_base(lane);
    const bf16_t* Kh = cur.K; const bf16_t* Vh = cur.V;
    bf16x8 st_v0, st_v1, st_k0, st_k1, st_k2;
#define RESC(a) do { if (__any((a) < 1.f)) { if (hi == 0) al_l[r32] = (a); asm volatile("s_waitcnt lgkmcnt(0)" ::: "memory");              \
                     _Pragma("unroll") for (int d_ = 0; d_ < 4; ++d_) _Pragma("unroll") for (int r = 0; r < 16; ++r) o[d_][r] *= al_l[crow(r, hi)]; } } while (0)
#define MASKT(P0_, P1_, t) do { const int kb_ = (t) * KVBLK; if (kb_ + KVBLK - 1 > qlo) mask_tile(P0_, P1_, qm - kb_); } while (0)
#define STEP(t, BF) do { f32x16 p0, p1; float mn, al; bf16x8 pa0, pa1, pa2, pa3;                                     \
        const bool lastt = (t) + 1 == NT;                                                                               \
        if (!lastt) { SLOAD_H(Kh, Vh, ((t) + 1) * KVBLK); } else { SLOAD_H(nxt.K, nxt.V, 0); }                          \
        SBAR(); qkt<BF>(p0, p1, K_lds, r32, hi, S.qr); SBAR();                                                         \
        if (lastt) { _Pragma("unroll") for (int d0 = 0; d0 < 12; ++d0) S.qr[d0] = ld8(nxt.Q + (size_t)(wid * QBLK + r32) * QS + d0 * 16 + hi * 8); SBAR(); } \
        MASKT(p0, p1, (t)); partialSM(p0, p1, m_reg, mn, al); RESC(al);                                                \
        finishSM(p0, p1, al, l_reg, pa0, pa1, pa2, pa3); SBAR();                                                       \
        pv_tile<BF>(o, vb0, pa0, pa1, pa2, pa3); SBAR();                                                               \
        if (lastt) { VMWN(12); SWRITE_H(0); } else { VMW(); SWRITE_H(1 - (BF)); }                                       \
        if (!lastt) __syncthreads(); } while (0)
    for (int t = 0; t < NT; t += 2) { STEP(t, 0); STEP(t + 1, 1); }
    if (hi == 0) li_l[r32] = l_reg; asm volatile("s_waitcnt lgkmcnt(0)" ::: "memory");
    float rli[16];
#pragma unroll
    for (int r = 0; r < 16; ++r) rli[r] = __builtin_amdgcn_rcpf(li_l[crow(r, hi)]);
    bf16_t* Ow = cur.O + (size_t)(wid * QBLK) * OS;
#pragma unroll
    for (int r = 0; r < 16; ++r) { const int orow = crow(r, hi);
#pragma unroll
        for (int d0 = 0; d0 < 4; ++d0) { const float v = o[d0][r] * rli[r];
            const float vn = __shfl_xor(v, 1);
            if ((r32 & 1) == 0) *(unsigned*)(Ow + (size_t)orow * OS + d0 * 32 + r32) = cvt_pk_bf16(v, vn); } }
    __syncthreads();
#undef RESC
#undef MASKT
#undef STEP
}
#undef VMW
#undef VMWN
#undef SLOAD_H
#undef SWRITE_H
#undef KSWZ
#undef SBAR
__device__ __forceinline__ BlockRef make_ref(int L, int pass, const bf16_t* Q, const bf16_t* K, const bf16_t* V, bf16_t* O) {
    const int bh = L >> 3, x = L & 7, qb = pass ? 15 - x : x, b = bh >> 4, h = bh & 15;
    BlockRef r; const size_t row0 = (size_t)b * SEQ;
    r.Q = Q + (row0 + (size_t)qb * QB) * QS + h * DQK; r.O = O + (row0 + (size_t)qb * QB) * OS + h * DV;
    r.K = K + row0 * KS + h * DQK; r.V = V + row0 * VS + h * DV; r.P0 = qb * QB;
    return r;
}
template <class Hook>
__device__ __forceinline__ void attn_phase(lptr lds, const bf16_t* Q, const bf16_t* K, const bf16_t* V, bf16_t* O, int vcu, int G, const Hook& hook) {
    constexpr int TOTAL = NBATCH * NH * 8;
    const int slot = (vcu >> 5) % 3;
    int L = vcu; if (L >= TOTAL) { hook(); return; }
    if (slot == 0) hook();
    int pass = 0, nblk = 0;
    BlockRef cur = make_ref(L, 0, Q, K, V, O);
    Seam S;
    attn_prime(cur, lds, S);
    for (;;) {
        const bool more_pass = pass == 0, more_item = L + G < TOTAL, last = !more_pass && !more_item;
        int passn = pass + 1, Ln = L;
        if (!more_pass) { passn = 0; Ln = more_item ? L + G : L; }
        const BlockRef nxt = last ? cur : make_ref(Ln, passn, Q, K, V, O);
        attn_block(cur, nxt, lds, S);
        ++nblk;
        if (nblk == 1 && slot == 1) hook();
        if (last) break;
        cur = nxt; pass = passn; L = Ln;
    }
    if (slot == 2 || (slot == 1 && nblk < 1)) hook();
}
}

struct KArgs { const float* in[25]; float* out; unsigned char* ws; int ph_lo, ph_hi; };
enum { I_X = 0, I_AWIN, I_AWGRP, I_ASCALE, I_AWOUT, I_KVWD, I_KVNORM, I_KVWUK, I_KVWUV, I_BWDQ, I_BQNORM, I_BWUQ, I_BWOUT, I_LN1G, I_LN1B, I_LN2G, I_LN2B,
       I_RW, I_RB, I_EWG, I_EWU, I_EWD, I_SWG, I_SWU, I_SWD };

__device__ __forceinline__ void tr_item(const float* W, int ldw, int k0, int n0, bf16_t* WT, int K, int drow0, const float* kscale, LAS float* scr, int lane) {
    const int c = lane & 7;
    f32x4 sa = {1.f, 1.f, 1.f, 1.f}, sb = sa;
    if (kscale) { sa = *(const f32x4*)(kscale + k0 + 8 * c); sb = *(const f32x4*)(kscale + k0 + 8 * c + 4); }
#pragma unroll 8
    for (int i = 0; i < 32; ++i) { const int kk = 2 * i + (lane >> 5); scr[kk * 33 + (lane & 31)] = W[(size_t)(k0 + kk) * ldw + n0 + (lane & 31)]; }
    LDS_WAIT(); asm volatile("" ::: "memory");
#pragma unroll
    for (int j = 0; j < 4; ++j) { const int n = (lane >> 3) + 8 * j; const LAS float* sp = scr + (8 * c) * 33 + n;
        u32x4 o; o.x = cvt_pk_bf16(sp[0 * 33] * sa[0], sp[1 * 33] * sa[1]); o.y = cvt_pk_bf16(sp[2 * 33] * sa[2], sp[3 * 33] * sa[3]); o.z = cvt_pk_bf16(sp[4 * 33] * sb[0], sp[5 * 33] * sb[1]); o.w = cvt_pk_bf16(sp[6 * 33] * sb[2], sp[7 * 33] * sb[3]);
        *(u32x4*)(WT + (size_t)(drow0 + n) * K + k0 + 8 * c) = o; }
    LDS_WAIT(); asm volatile("" ::: "memory");
}
constexpr int G6_ITEMS = 96 * 60;
constexpr int D4_FIRST = G6_ITEMS;
struct TrItem { const float* src; bf16_t* dst; int ldw, Kd, k0, n0, gu, p; };
__device__ __forceinline__ void bg_decode(const KArgs& a, int kind  , int l, int it, TrItem& I) {
    unsigned char* ws = a.ws;
    if (kind == 4) { if (it < 65 * 512) kind = 2; else { kind = 3; it = it - 65 * 512 + D4_FIRST; } }
    if (kind == 0 || kind == 2) { const int e = it >> 9, q = it & 511, up = q >> 8, qq = q & 255;
        I.src = e < 64 ? a.in[up ? I_EWU : I_EWG] + (size_t)(l * 64 + e) * 2048 * 512 : a.in[up ? I_SWU : I_SWG] + (size_t)l * 2048 * 512;
        I.ldw = 512; I.k0 = (qq >> 3) * 64; I.n0 = (qq & 7) * 64; I.dst = (bf16_t*)(ws + WS_WGU + (size_t)l * 65 * 1024 * 2048 * 2 + (size_t)e * 1024 * 2048 * (kind == 2 ? 1 : 2)); I.Kd = 2048; I.gu = 1; I.p = up ? 128 : 0;
    } else { const int e = it >> 8, qq = it & 255;
        I.src = e < 64 ? a.in[I_EWD] + (size_t)(l * 64 + e) * 512 * 2048 : a.in[I_SWD] + (size_t)l * 512 * 2048;
        I.ldw = 2048; I.k0 = (qq >> 5) * 64; I.n0 = (qq & 31) * 64; I.dst = (bf16_t*)(ws + WS_WD + (size_t)l * 65 * 2048 * 512 * 2 + (size_t)e * 2048 * 512 * (kind == 3 ? 1 : 2)); I.Kd = 512; I.gu = 0; I.p = 0; }
}
__device__ __forceinline__ void bg_load(const TrItem& I, f32x4 (&v)[16], int lane) {
    const float* p = I.src + (size_t)(I.k0 + 16 * (lane >> 4)) * I.ldw + I.n0 + 4 * (lane & 15);
#pragma unroll
    for (int i = 0; i < 16; ++i) v[i] = __builtin_nontemporal_load((const f32x4*)(p + (size_t)i * I.ldw));
}
__device__ __forceinline__ void bg_emit(const TrItem& I, const f32x4 (&v)[16], LAS unsigned* scr, int lane) {
    const int n4 = lane & 15, kq = lane >> 4;
#pragma unroll
    for (int q = 0; q < 4; ++q)
#pragma unroll
        for (int h = 0; h < 2; ++h) { u32x4 o; o.x = cvt_pk_bf16(v[8 * h + 0][q], v[8 * h + 1][q]); o.y = cvt_pk_bf16(v[8 * h + 2][q], v[8 * h + 3][q]); o.z = cvt_pk_bf16(v[8 * h + 4][q], v[8 * h + 5][q]); o.w = cvt_pk_bf16(v[8 * h + 6][q], v[8 * h + 7][q]);
            *(LAS u32x4*)(scr + (4 * n4 + q) * 36 + 8 * kq + 4 * h) = o; }
    LDS_WAIT(); asm volatile("" ::: "memory");
    const int c = lane & 7;
#pragma unroll
    for (int jj = 0; jj < 8; ++jj) { const int r = (lane >> 3) + 8 * jj, n = I.n0 + r; const u32x4 o = *(const LAS u32x4*)(scr + r * 36 + 4 * c);
        const int drow = I.gu ? (n >> 7) * 256 + I.p + (n & 127) : n;
        *(u32x4*)(I.dst + (size_t)drow * I.Kd + I.k0 + 8 * c) = o; }
    LDS_WAIT(); asm volatile("" ::: "memory");
}
__device__ __forceinline__ void bg_emit8(const TrItem& I, const f32x4 (&v)[16], LAS unsigned* scr, int lane) {
    const int n4 = lane & 15, kq = lane >> 4;
#pragma unroll
    for (int q = 0; q < 4; ++q) { u32x4 o;
        o.x = pk4_fp8(v[0][q] * W8_SCALE, v[1][q] * W8_SCALE, v[2][q] * W8_SCALE, v[3][q] * W8_SCALE); o.y = pk4_fp8(v[4][q] * W8_SCALE, v[5][q] * W8_SCALE, v[6][q] * W8_SCALE, v[7][q] * W8_SCALE);
        o.z = pk4_fp8(v[8][q] * W8_SCALE, v[9][q] * W8_SCALE, v[10][q] * W8_SCALE, v[11][q] * W8_SCALE); o.w = pk4_fp8(v[12][q] * W8_SCALE, v[13][q] * W8_SCALE, v[14][q] * W8_SCALE, v[15][q] * W8_SCALE);
        *(LAS u32x4*)(scr + (4 * n4 + q) * 20 + 4 * kq) = o; }
    LDS_WAIT(); asm volatile("" ::: "memory");
    const int c = lane & 3;
#pragma unroll
    for (int jj = 0; jj < 4; ++jj) { const int r = (lane >> 2) + 16 * jj, n = I.n0 + r; const u32x4 o = *(const LAS u32x4*)(scr + r * 20 + 4 * c);
        const int drow = I.gu ? (n >> 7) * 256 + I.p + (n & 127) : n;
        *(u32x4*)((unsigned char*)I.dst + (size_t)drow * I.Kd + I.k0 + 16 * c) = o; }
    LDS_WAIT(); asm volatile("" ::: "memory");
}
__device__ __forceinline__ void bg_convert_range(const KArgs& a, LAS unsigned char* lds, int kind, int l, int lo, int hi, int wave, int lane, int scr_off = 0, int scr_stride = 16384) {
    LAS unsigned* scr = (LAS unsigned*)(lds + scr_off + wave * scr_stride);
    TrItem A, B; f32x4 va[16], vb[16];
    int it = lo + wave;
    if (it < hi) { bg_decode(a, kind, l, it, A); bg_load(A, va, lane); }
#pragma unroll 1
    while (it < hi) {
        const int i1 = it + 8, i2 = it + 16;
        if (i1 < hi) { bg_decode(a, kind, l, i1, B); bg_load(B, vb, lane); }
        if (kind >= 2) bg_emit8(A, va, scr, lane); else bg_emit(A, va, scr, lane);
        if (i1 >= hi) break;
        if (i2 < hi) { bg_decode(a, kind, l, i2, A); bg_load(A, va, lane); }
        if (kind >= 2) bg_emit8(B, vb, scr, lane); else bg_emit(B, vb, scr, lane);
        it = i2;
    }
    VM_WAIT(); __syncthreads();
}
__device__ __forceinline__ void bg_share(int first, int last, int c, int G, int n_extra, int U, int& lo, int& hi) {
    const int N = last - first; int n_lo = (N + n_extra * U + G - 1) / G, n_hi = n_lo - U;
    if (n_hi < 0) { n_hi = 0; n_lo = (N + (G - n_extra) - 1) / (G - n_extra); }
    lo = first + (c < n_extra ? c * n_hi : n_extra * n_hi + (c - n_extra) * n_lo); hi = lo + (c < n_extra ? n_hi : n_lo);
    if (lo > last) lo = last; if (hi > last) hi = last;
}
__device__ __forceinline__ void bg_convert(const KArgs& a, LAS unsigned char* lds, int kind, int l, int vcu, int G, int wave, int lane) {
    const int NIT = (kind == 0 || kind == 2) ? 65 * 512 : 65 * 256, per = (NIT + G - 1) / G; const int lo = vcu * per, hi = lo + per < NIT ? lo + per : NIT;
    bg_convert_range(a, lds, kind, l, lo < NIT ? lo : NIT, hi, wave, lane);
}
__device__ __forceinline__ void phase_prologue(const KArgs& a, LAS unsigned char* lds, int vcu, int G, int wave, int lane) {
    unsigned char* ws = a.ws;
    LAS float* scr = (LAS float*)(lds + wave * 16384);
    const int gw = vcu * 8 + wave, NGW = G * 8;
    constexpr int C_IN = 2048, C_GRP = 512, C_OUT = 2048, C_KVD = 576, C_DQ = 512, C_UK = 512, C_UV = 512, C_UQ = 768, C_BO = 2048;
    constexpr int C_SMALL = C_IN + C_GRP + C_OUT + C_KVD + C_DQ + C_UK + C_UV + C_UQ + C_BO;
    constexpr int NITEMS = C_SMALL;
    for (int it = gw; it < NITEMS; it += NGW) {
        int r = it;
        if (r < C_IN) { tr_item(a.in[I_AWIN], 2048, (r / 64) * 64, (r % 64) * 32, (bf16_t*)(ws + WS_WIN), 2048, (r % 64) * 32, nullptr, scr, lane); continue; } r -= C_IN;
        if (r < C_GRP) { const int g = r / 128, q = r % 128; tr_item(a.in[I_AWGRP] + (size_t)g * 512 * 512, 512, (q / 16) * 64, (q % 16) * 32, (bf16_t*)(ws + WS_WGRP), 512, g * 512 + (q % 16) * 32, nullptr, scr, lane); continue; } r -= C_GRP;
        if (r < C_OUT) { tr_item(a.in[I_AWOUT], 2048, (r / 64) * 64, (r % 64) * 32, (bf16_t*)(ws + WS_WOUT), 2048, (r % 64) * 32, nullptr, scr, lane); continue; } r -= C_OUT;
        if (r < C_KVD) { const int n0 = (r % 18) * 32; tr_item(a.in[I_KVWD], 576, (r / 18) * 64, n0, (bf16_t*)(ws + WS_WKVQ), 2048, n0 < 512 ? n0 : 1024 + (n0 - 512), nullptr, scr, lane); continue; } r -= C_KVD;
        if (r < C_DQ) { const int n0 = (r % 16) * 32; tr_item(a.in[I_BWDQ], 512, (r / 16) * 64, n0, (bf16_t*)(ws + WS_WKVQ), 2048, 512 + n0, nullptr, scr, lane); continue; } r -= C_DQ;
        if (r < C_UK) { const int n0 = (r % 64) * 32; tr_item(a.in[I_KVWUK], 2048, (r / 64) * 64, n0, (bf16_t*)(ws + WS_WUP), 512, n0, a.in[I_KVNORM], scr, lane); continue; } r -= C_UK;
        if (r < C_UV) { const int n0 = (r % 64) * 32; tr_item(a.in[I_KVWUV], 2048, (r / 64) * 64, n0, (bf16_t*)(ws + WS_WUP), 512, 2048 + n0, a.in[I_KVNORM], scr, lane); continue; } r -= C_UV;
        if (r < C_UQ) { const int n0 = (r % 96) * 32, h = n0 / 192, d0 = n0 % 192;
            const int drow = d0 < 128 ? 4096 + h * 128 + d0 : 6144 + (h >> 2) * 256 + (d0 >= 160 ? 128 : 0) + (h & 3) * 32;
            tr_item(a.in[I_BWUQ], 3072, (r / 96) * 64, n0, (bf16_t*)(ws + WS_WUP), 512, drow, a.in[I_BQNORM], scr, lane); continue; } r -= C_UQ;
        tr_item(a.in[I_BWOUT], 2048, (r / 64) * 64, (r % 64) * 32, (bf16_t*)(ws + WS_WBO), 2048, (r % 64) * 32, nullptr, scr, lane);
    }
    bg_convert(a, lds, L0F8 == 2 ? 2 : 0, 0, vcu, G, wave, lane);
    const int gtid = gw * 64 + lane, NGT = NGW * 64;
    for (int i = gtid; i < 192 * 2048 * 2 / 16; i += NGT) ((u32x4*)(ws + WS_WKVQ + (size_t)1088 * 2048 * 2))[i] = (u32x4){0u, 0u, 0u, 0u};
    for (int i = gtid; i < SEQ * 32; i += NGT) { const int s = i >> 5, j = i & 31;
        const float inv = 1.0f / powf(10000.0f, (float)(2 * j) / 64.0f); const float ang = (float)s * inv;
        double rev = (double)ang * 0.15915494309189535; rev -= floor(rev); const float fr = (float)rev;
        ((f32x2*)(ws + WS_ROPE))[i] = (f32x2){__builtin_amdgcn_cosf(fr), __builtin_amdgcn_sinf(fr)}; }
    for (int i = gtid; i < 2 * DM * 64; i += NGT) { const int l = i / (DM * 64), rem = i - l * (DM * 64), d = rem >> 6, e = rem & 63;
        const float w = a.in[I_RW][i] * a.in[I_LN1G][l * DM + d]; const unsigned h = cvt_pk_bf16(w, 0.f) & 0xffffu; const float wl = w - __uint_as_float(h << 16);
        ((bf16_t*)(ws + WS_RWHI))[((size_t)l * 64 + e) * DM + d] = (bf16_t)h; ((bf16_t*)(ws + WS_RWLO))[((size_t)l * 64 + e) * DM + d] = (bf16_t)(cvt_pk_bf16(wl, 0.f) & 0xffffu); }
    for (int i = gw; i < 2 * 64; i += NGW) { const int l = i / 64, e = i % 64; float c1 = 0.f, c2 = 0.f;
#pragma unroll 16
        for (int d = lane; d < DM; d += 64) { const float w = a.in[I_RW][((size_t)l * DM + d) * 64 + e]; c1 += a.in[I_LN1G][l * DM + d] * w; c2 += a.in[I_LN1B][l * DM + d] * w; }
        c1 = wave_sum(c1); c2 = wave_sum(c2);
        if (lane == 0) { ((float*)(ws + WS_RC))[l * 64 + e] = c1; ((float*)(ws + WS_RC))[128 + l * 64 + e] = c2; } }
    const float* x = a.in[I_X];
    for (int task = gtid; task < NCHUNK * 512; task += NGT) {
        const int c4 = task & 511, t0 = (task >> 9) * 32, s0 = t0 & (SEQ - 1);
        const float* xc = x + c4 * 4;
        f32x4 w[32];
#pragma unroll
        for (int j = 0; j < 16; ++j) w[j] = s0 > 0 ? *(const f32x4*)(xc + (size_t)(t0 - 16 + j) * DM) : (f32x4){0.f, 0.f, 0.f, 0.f};
        f32x4 S2 = w[14] + w[15], S4 = (w[12] + w[13]) + S2, S8 = ((w[8] + w[9]) + (w[10] + w[11])) + S4, S16 = (((w[0] + w[1]) + (w[2] + w[3])) + ((w[4] + w[5]) + (w[6] + w[7]))) + S8;
#pragma unroll 1
        for (int hb = 0; hb < 2; ++hb) { const int tb = t0 + 16 * hb, sb0 = s0 + 16 * hb;
#pragma unroll
            for (int j = 0; j < 16; ++j) w[16 + j] = *(const f32x4*)(xc + (size_t)(tb + j) * DM);
#pragma unroll
            for (int j = 0; j < 16; ++j) { const int sq = sb0 + j; const f32x4 v = w[16 + j];
                S2 += v - w[16 + j - 2]; S4 += v - w[16 + j - 4]; S8 += v - w[16 + j - 8]; S16 += v - w[j];
                const float n2 = 1.f / (float)(sq + 1 < 2 ? sq + 1 : 2), n4 = 1.f / (float)(sq + 1 < 4 ? sq + 1 : 4), n8 = 1.f / (float)(sq + 1 < 8 ? sq + 1 : 8), n16 = 1.f / (float)(sq + 1 < 16 ? sq + 1 : 16);
                const f32x4 o2 = S2 * n2 - v, o4 = S4 * n4 - v, o8 = S8 * n8 - v, o16 = S16 * n16 - v;
                bf16_t* xp = (bf16_t*)(ws + WS_XP) + (size_t)(tb + j) * DM + c4 * 4;
                *(u32x2*)(xp) = (u32x2){cvt_pk_bf16(o2[0], o2[1]), cvt_pk_bf16(o2[2], o2[3])};
                *(u32x2*)(xp + (size_t)T * DM) = (u32x2){cvt_pk_bf16(o4[0], o4[1]), cvt_pk_bf16(o4[2], o4[3])};
                *(u32x2*)(xp + (size_t)2 * T * DM) = (u32x2){cvt_pk_bf16(o8[0], o8[1]), cvt_pk_bf16(o8[2], o8[3])};
                *(u32x2*)(xp + (size_t)3 * T * DM) = (u32x2){cvt_pk_bf16(o16[0], o16[1]), cvt_pk_bf16(o16[2], o16[3])}; }
#pragma unroll
            for (int j = 0; j < 16; ++j) w[j] = w[16 + j]; }
    }
}

__device__ __forceinline__ void route_token(float score, float choice, int lane, bool& sel, float& gate) {
    int cnt = 0;
#pragma unroll
    for (int o = 1; o < 8; ++o) { const float oc = __shfl_xor(choice, o); const int j = lane ^ o; cnt += (oc > choice || (oc == choice && j < lane)) ? 1 : 0; }
    float gs = cnt < 2 ? choice : 0.f;
    gs += __shfl_xor(gs, 1); gs += __shfl_xor(gs, 2); gs += __shfl_xor(gs, 4);
    int gcnt = 0;
#pragma unroll
    for (int o = 8; o < 64; o += 8) { const float og = __shfl_xor(gs, o); const int gj = (lane ^ o) >> 3; gcnt += (og > gs || (og == gs && gj < (lane >> 3))) ? 1 : 0; }
    const bool gsel = gcnt < 4;
    float cur = gsel ? choice : -__builtin_inff();
    unsigned long long selmask = 0ull;
#pragma unroll 1
    for (int it = 0; it < 8; ++it) { float m = cur;
#pragma unroll
        for (int o = 1; o < 64; o <<= 1) m = fmaxf(m, __shfl_xor(m, o));
        const unsigned long long b = __ballot(cur == m); const int w = __ffsll((long long)b) - 1;
        selmask |= 1ull << w; if (lane == w) cur = -__builtin_inff(); }
    sel = ((selmask >> lane) & 1ull) != 0ull;
    const float ssum = wave_sum(sel ? score : 0.f);
    gate = score / ssum * 2.5f;
}
__device__ __forceinline__ void phase_r1(const KArgs& a, LAS unsigned char* lds, int l, int G, int wave, int lane) {
    unsigned char* ws = a.ws;
    const bf16_t* z = (const bf16_t*)(ws + WS_Z);
    LAS float* P = (LAS float*)lds;
    LAS float* SX = (LAS float*)(lds + 65536);
    LAS unsigned long long* MK = (LAS unsigned long long*)(lds + 65536 + 2048);
    LAS float* ST = (LAS float*)(lds + 65536 + 2048 + 256);
    const int r32 = lane & 31, hi = lane >> 5;
    const float* c1 = (const float*)(ws + WS_RC) + l * 64; const float* c2 = (const float*)(ws + WS_RC) + 128 + l * 64;
    const float* rbias = a.in[I_RB] + l * 64;
    const float* g1 = a.in[I_LN1G] + l * DM; const float* b1 = a.in[I_LN1B] + l * DM;
    int* toke = (int*)(ws + WS_TOKE); float* tokg = (float*)(ws + WS_TOKG); int* cntp = (int*)(ws + WS_CNT);
    bf16_t* x1h = (bf16_t*)(ws + WS_X1F); bf16_t* x1b = (bf16_t*)(ws + WS_X1B);
    for (int ch = blockIdx.x; ch < NCHUNK; ch += G) {
        const int row0 = ch * 32;
        {
            f32x16 acc0 = {}, acc1 = {}; float s1 = 0.f, s2 = 0.f;
            const bf16_t* zr = z + (size_t)(row0 + r32) * DM + 256 * wave + 8 * hi;
            const bf16_t* bh = (const bf16_t*)(ws + WS_RWHI) + ((size_t)l * 64 + r32) * DM + 256 * wave + 8 * hi;
            const bf16_t* bl = (const bf16_t*)(ws + WS_RWLO) + ((size_t)l * 64 + r32) * DM + 256 * wave + 8 * hi;
#pragma unroll 4
            for (int kk = 0; kk < 16; ++kk) {
                const u32x4 zw = *(const u32x4*)(zr + 16 * kk);
                const f32x4 va = {bf_lo(zw.x), bf_hi(zw.x), bf_lo(zw.y), bf_hi(zw.y)}, vb = {bf_lo(zw.z), bf_hi(zw.z), bf_lo(zw.w), bf_hi(zw.w)};
                s1 += (va[0] + va[1]) + (va[2] + va[3]) + (vb[0] + vb[1]) + (vb[2] + vb[3]);
                s2 += (va[0] * va[0] + va[1] * va[1]) + (va[2] * va[2] + va[3] * va[3]) + (vb[0] * vb[0] + vb[1] * vb[1]) + (vb[2] * vb[2] + vb[3] * vb[3]);
                const bf16x8 ah = __builtin_bit_cast(bf16x8, zw);
                const bf16x8 bh0 = *(const bf16x8*)(bh + 16 * kk), bh1 = *(const bf16x8*)(bh + (size_t)32 * DM + 16 * kk);
                const bf16x8 bl0 = *(const bf16x8*)(bl + 16 * kk), bl1 = *(const bf16x8*)(bl + (size_t)32 * DM + 16 * kk);
                acc0 = __builtin_amdgcn_mfma_f32_32x32x16_bf16(ah, bh0, acc0, 0, 0, 0); acc0 = __builtin_amdgcn_mfma_f32_32x32x16_bf16(ah, bl0, acc0, 0, 0, 0);
                acc1 = __builtin_amdgcn_mfma_f32_32x32x16_bf16(ah, bh1, acc1, 0, 0, 0); acc1 = __builtin_amdgcn_mfma_f32_32x32x16_bf16(ah, bl1, acc1, 0, 0, 0);
            }
#pragma unroll
            for (int r = 0; r < 16; ++r) { const int tk = (r & 3) + 8 * (r >> 2) + 4 * hi; P[(wave * 32 + tk) * 64 + r32] = acc0[r]; P[(wave * 32 + tk) * 64 + 32 + r32] = acc1[r]; }
            s1 += __shfl_xor(s1, 32); s2 += __shfl_xor(s2, 32);
            if (hi == 0) { SX[(wave * 32 + r32) * 2] = s1; SX[(wave * 32 + r32) * 2 + 1] = s2; }
        }
        __syncthreads();
#pragma unroll 1
        for (int j = 0; j < 4; ++j) { const int i = 4 * wave + j, t = row0 + i;
            float dot = 0.f, S1 = 0.f, S2 = 0.f;
#pragma unroll
            for (int w = 0; w < 8; ++w) { dot += P[(w * 32 + i) * 64 + lane]; S1 += SX[(w * 32 + i) * 2]; S2 += SX[(w * 32 + i) * 2 + 1]; }
            const float mu = S1 * (1.f / DM), var = S2 * (1.f / DM) - mu * mu, rstd = 1.f / sqrtf(var + LN_EPS);
            const float logit = rstd * (dot - mu * c1[lane]) + c2[lane];
            const float score = 1.f / (1.f + __expf(-logit));
            const float choice = score + rbias[lane];
            bool sel; float gate; route_token(score, choice, lane, sel, gate);
            const unsigned long long mask = __ballot(sel);
            if (lane == 0) { MK[i] = mask; ST[2 * i] = mu; ST[2 * i + 1] = rstd; }
            if (sel) { const int rk8 = __popcll(mask & ((1ull << lane) - 1ull)); tokg[t * 8 + rk8] = gate; }
        }
        __syncthreads();
#pragma unroll 1
        for (int j = 0; j < 4; ++j) { const int i = 4 * wave + j, t = row0 + i; const unsigned long long mask = MK[i];
            int lr = 0; for (int q = 0; q < i; ++q) lr += (int)((MK[q] >> lane) & 1ull);
            if ((mask >> lane) & 1ull) { const int rk8 = __popcll(mask & ((1ull << lane) - 1ull)); toke[t * 8 + rk8] = (lane << 16) | lr; } }
        if (wave == 0) { int c = 0; for (int q = 0; q < 32; ++q) c += (int)((MK[q] >> lane) & 1ull); cntp[ch * 64 + lane] = c; }
#pragma unroll 1
        for (int j = 0; j < 4; ++j) { const int i = 4 * wave + j, t = row0 + i; const float mu = ST[2 * i], rstd = ST[2 * i + 1];
            f32x4 xo[8];
#pragma unroll
            for (int jj = 0; jj < 8; ++jj) { const int col = 4 * lane + 256 * jj; const u32x2 zw = *(const u32x2*)(z + (size_t)t * DM + col); const f32x4 zv = {bf_lo(zw.x), bf_hi(zw.x), bf_lo(zw.y), bf_hi(zw.y)}, g = *(const f32x4*)(g1 + col), b = *(const f32x4*)(b1 + col);
                xo[jj] = (zv - mu) * rstd * g + b; }
#pragma unroll
            for (int jj = 0; jj < 8; ++jj) { const int col = 4 * lane + 256 * jj;
                const u32x2 xb = {cvt_pk_bf16(xo[jj][0], xo[jj][1]), cvt_pk_bf16(xo[jj][2], xo[jj][3])};
                *(u32x2*)(x1h + (size_t)t * DM + col) = xb;
                if (l == 0 && L0F8 != 2) *(u32x2*)(x1b + (size_t)t * DM + col) = xb;
                if (l == 1 || L0F8 == 2) *(unsigned*)(ws + WS_X1Q + (size_t)t * DM + col) = pk4_fp8(xo[jj][0], xo[jj][1], xo[jj][2], xo[jj][3]); } }
        __syncthreads();
    }
}

__device__ __forceinline__ void phase_r2(const KArgs& a, LAS unsigned char* lds, int G, int tid, int wave, int lane) {
    unsigned char* ws = a.ws;
    LAS int* PA = (LAS int*)lds; LAS int* PB = PA + 512; LAS int* SB = PA + 1024; LAS int* TOT = PA + 1088; LAS int* TB = PA + 1152;
    const int* cntp = (const int*)(ws + WS_CNT); const int* toke = (const int*)(ws + WS_TOKE);
    int* toks = (int*)(ws + WS_TOKS); int* rowidx = (int*)(ws + WS_ROWIDX); int* mte = (int*)(ws + WS_MTE); int* nmtp = (int*)(ws + WS_NMT);
    for (int ch = blockIdx.x; ch < NCHUNK; ch += G) {
        { int sa = 0, sb = 0; for (int c = 32 * wave; c < 32 * wave + 32; ++c) { const int v = cntp[c * 64 + lane]; sa += v; if (c < ch) sb += v; } PA[wave * 64 + lane] = sa; PB[wave * 64 + lane] = sb; }
        __syncthreads();
        if (wave == 0) { int tot = 0, off = 0;
#pragma unroll
            for (int w = 0; w < 8; ++w) { tot += PA[w * 64 + lane]; off += PB[w * 64 + lane]; }
            const int nt = (tot + 255) >> 8; int incl = nt;
#pragma unroll
            for (int o = 1; o < 64; o <<= 1) { const int v = __shfl_up(incl, o); if (lane >= o) incl += v; }
            const int tb = incl - nt;
            SB[lane] = 8192 + 256 * tb + off; TOT[lane] = tot; TB[lane] = tb;
            if (ch == 0) { for (int q = 0; q < nt; ++q) mte[32 + tb + q] = lane; if (lane < 32) mte[lane] = 64; if (lane == 63) *nmtp = 32 + incl; } }
        __syncthreads();
        if (tid < 256) { const int t = ch * 32 + (tid >> 3), k = tid & 7; const int pk = toke[t * 8 + k]; const int e = pk >> 16, lr = pk & 0xffff; const int slot = SB[e] + lr; rowidx[slot] = t; toks[t * 8 + k] = slot; }
        else if (tid < 288) { const int t = ch * 32 + (tid - 256); rowidx[t] = t; }
        if (ch < 64 && tid < 256) { const int tot = TOT[ch], tb = TB[ch], nt = (tot + 255) >> 8; const int p = tot + tid; if (p < 256 * nt) rowidx[8192 + 256 * tb + p] = 0; }
        __syncthreads();
    }
}

__device__ __forceinline__ void phase_ln2(const KArgs& a, int l, int vcu, int G, int wave, int lane) {
    unsigned char* ws = a.ws;
    const bf16_t* x1h = (const bf16_t*)(ws + WS_X1F); const bf16_t* Y = (const bf16_t*)(ws + WS_Y);
    const int* toks = (const int*)(ws + WS_TOKS); const float* tokg = (const float*)(ws + WS_TOKG);
    const float* g2 = a.in[I_LN2G] + l * DM; const float* b2 = a.in[I_LN2B] + l * DM;
    float* outf = a.out; bf16_t* outb = (bf16_t*)(ws + WS_X2B);
    const int gw = vcu * 8 + wave, NGW = G * 8;
    for (int t = gw; t < T; t += NGW) {
        const int slot_l = lane < 8 ? toks[t * 8 + lane] : 0; const float g_l = lane < 8 ? tokg[t * 8 + lane] : 0.f;
        float v[4][8];
#pragma unroll
        for (int j = 0; j < 4; ++j) { const int col = 8 * lane + 512 * j; const u32x4 xw = *(const u32x4*)(x1h + (size_t)t * DM + col);
            const u32x4 yw = __builtin_nontemporal_load((const u32x4*)(Y + (size_t)t * DM + col));
            v[j][0] = ALPHA * bf_lo(xw.x) + bf_lo(yw.x); v[j][1] = ALPHA * bf_hi(xw.x) + bf_hi(yw.x); v[j][2] = ALPHA * bf_lo(xw.y) + bf_lo(yw.y); v[j][3] = ALPHA * bf_hi(xw.y) + bf_hi(yw.y);
            v[j][4] = ALPHA * bf_lo(xw.z) + bf_lo(yw.z); v[j][5] = ALPHA * bf_hi(xw.z) + bf_hi(yw.z); v[j][6] = ALPHA * bf_lo(xw.w) + bf_lo(yw.w); v[j][7] = ALPHA * bf_hi(xw.w) + bf_hi(yw.w); }
#pragma unroll
        for (int k = 0; k < 8; ++k) { const int slot = __builtin_amdgcn_readlane(slot_l, k); const float g = __uint_as_float((unsigned)__builtin_amdgcn_readlane((int)__float_as_uint(g_l), k));
            const bf16_t* yr = Y + (size_t)slot * DM + 8 * lane;
#pragma unroll
            for (int j = 0; j < 4; ++j) { const u32x4 yw = __builtin_nontemporal_load((const u32x4*)(yr + 512 * j));
                v[j][0] += g * bf_lo(yw.x); v[j][1] += g * bf_hi(yw.x); v[j][2] += g * bf_lo(yw.y); v[j][3] += g * bf_hi(yw.y);
                v[j][4] += g * bf_lo(yw.z); v[j][5] += g * bf_hi(yw.z); v[j][6] += g * bf_lo(yw.w); v[j][7] += g * bf_hi(yw.w); } }
        float s = 0.f;
#pragma unroll
        for (int j = 0; j < 4; ++j)
#pragma unroll
            for (int q = 0; q < 8; ++q) s += v[j][q];
        const float mean = wave_sum(s) * (1.f / DM); float s2 = 0.f;
#pragma unroll
        for (int j = 0; j < 4; ++j)
#pragma unroll
            for (int q = 0; q < 8; ++q) { v[j][q] -= mean; s2 += v[j][q] * v[j][q]; }
        const float rstd = 1.f / sqrtf(wave_sum(s2) * (1.f / DM) + LN_EPS);
#pragma unroll
        for (int j = 0; j < 4; ++j) { const int col = 8 * lane + 512 * j; const f32x4 ga = *(const f32x4*)(g2 + col), gb = *(const f32x4*)(g2 + col + 4), ba = *(const f32x4*)(b2 + col), bb = *(const f32x4*)(b2 + col + 4);
#pragma unroll
            for (int q = 0; q < 4; ++q) { v[j][q] = v[j][q] * rstd * ga[q] + ba[q]; v[j][4 + q] = v[j][4 + q] * rstd * gb[q] + bb[q]; } }
#pragma unroll
        for (int j = 0; j < 4; ++j) { const int col = 8 * lane + 512 * j;
            if (l == 1) { *(f32x4*)(outf + (size_t)t * DM + col) = (f32x4){v[j][0], v[j][1], v[j][2], v[j][3]}; *(f32x4*)(outf + (size_t)t * DM + col + 4) = (f32x4){v[j][4], v[j][5], v[j][6], v[j][7]}; }
            if (l == 0) *(u32x4*)(outb + (size_t)t * DM + col) = (u32x4){cvt_pk_bf16(v[j][0], v[j][1]), cvt_pk_bf16(v[j][2], v[j][3]), cvt_pk_bf16(v[j][4], v[j][5]), cvt_pk_bf16(v[j][6], v[j][7])}; }
    }
}

__device__ __forceinline__ void phase_stats(const KArgs& a, int vcu, int G, int wave, int lane) {
    unsigned char* ws = a.ws;
    const bf16_t* ckq = (const bf16_t*)(ws + WS_CKQ); float* rstat = (float*)(ws + WS_RSTAT); bf16_t* Kb = (bf16_t*)(ws + WS_K); const f32x2* rope = (const f32x2*)(ws + WS_ROPE);
    const int gw = vcu * 8 + wave, NGW = G * 8;
    for (int t = gw; t < T; t += NGW) { const bf16_t* row = ckq + (size_t)t * NCKQ;
        const u32x4 c = *(const u32x4*)(row + 8 * lane), q = *(const u32x4*)(row + 512 + 8 * lane);
        float sc = bf_lo(c.x) * bf_lo(c.x) + bf_hi(c.x) * bf_hi(c.x) + bf_lo(c.y) * bf_lo(c.y) + bf_hi(c.y) * bf_hi(c.y) + bf_lo(c.z) * bf_lo(c.z) + bf_hi(c.z) * bf_hi(c.z) + bf_lo(c.w) * bf_lo(c.w) + bf_hi(c.w) * bf_hi(c.w);
        float sq = bf_lo(q.x) * bf_lo(q.x) + bf_hi(q.x) * bf_hi(q.x) + bf_lo(q.y) * bf_lo(q.y) + bf_hi(q.y) * bf_hi(q.y) + bf_lo(q.z) * bf_lo(q.z) + bf_hi(q.z) * bf_hi(q.z) + bf_lo(q.w) * bf_lo(q.w) + bf_hi(q.w) * bf_hi(q.w);
        sc = wave_sum(sc); sq = wave_sum(sq);
        if (lane == 0) { rstat[t] = 1.f / sqrtf(sc * (1.f / 512.f) + RMS_EPS); rstat[T + t] = 1.f / sqrtf(sq * (1.f / 512.f) + RMS_EPS); }
        const int i = lane & 31, s = t & (SEQ - 1);
        const float x1 = __uint_as_float((unsigned)row[1024 + i] << 16), x2 = __uint_as_float((unsigned)row[1056 + i] << 16);
        const f32x2 cs = rope[s * 32 + i];
        const float o = lane < 32 ? x1 * cs[0] - x2 * cs[1] : x2 * cs[0] + x1 * cs[1];
        const bf16_t ob = (bf16_t)(cvt_pk_bf16(o, 0.f) & 0xffffu);
        bf16_t* kr = Kb + (size_t)t * (NH * DQK) + 128 + lane;
#pragma unroll
        for (int h = 0; h < NH; ++h) kr[h * DQK] = ob;
    }
}

struct AttHook { const KArgs* a; LAS unsigned char* lds; int vcu, G, wave, lane;
    __device__ __forceinline__ void operator()() const { const int NIT = 65 * 512 + 65 * 256 - D4_FIRST, per = (NIT + G - 1) / G, lo = vcu * per, hi = lo + per;
        __syncthreads(); bg_convert_range(*a, lds, 4, 1, lo < NIT ? lo : NIT, hi < NIT ? hi : NIT, wave, lane, 90112, 5120); } };
constexpr int N_PHASES = 19;
__global__ void __launch_bounds__(512, 2) fwd_kernel(KArgs a) {
    extern __shared__ __attribute__((aligned(16))) unsigned char lds_raw[];
    LAS unsigned char* lds = (LAS unsigned char*)lds_raw;
    volatile LAS unsigned* MISC = (volatile LAS unsigned*)(lds + MISC_OFF);
    const int tid = threadIdx.x, lane = tid & 63, wave = __builtin_amdgcn_readfirstlane(tid >> 6);
    const int G = gridDim.x; int bx = blockIdx.x; int vcu = (G % 8 == 0) ? (bx % 8) * (G / 8) + bx / 8 : bx;
    unsigned char* ws = a.ws;
    if (tid < 32) MISC[tid] = 0u;
    __syncthreads();
    XcdBarrier bar; bar.bar = (unsigned*)(ws + WS_CTL) + CW_BAR; bar.x = 0; bar.st = nullptr;
    if (MK_N_LAUNCHES == 1) bar = xcd_barrier_post((unsigned*)(ws + WS_CTL) + CW_BAR, MISC + 8);
    const int lo = a.ph_lo, hi = a.ph_hi;
#ifndef PHMASK
#define PHMASK 0xFFFFFFu
#endif
#define PH(k) ((((PHMASK) >> (k)) & 1u) && lo <= (k) && (k) < hi)
#define SEAM(k) do { if (PH(k) && PH((k) + 1)) xcd_barrier(bar); } while (0)

#ifndef HWIDS
#define HWIDS 1
#endif
#ifndef EXPER
#define EXPER 0
#endif
#ifndef REPMASK
#define REPMASK 0x0u
#endif
#define RUN(k, BODY) do { if (PH(k)) { BODY; if ((REPMASK >> (k)) & 1u) { __syncthreads(); BODY; } } } while (0)
#define P_G1 do { DenseSched S; S.ord.init(32, 8, G, bx); S.A = (const char*)(ws + WS_XP); S.B = (const char*)(ws + WS_WIN); S.lda_b = DM * 2; S.K = DM; S.mode = 1; S.agrp = (size_t)T * DM * 2; \
        EpiBf16 E{(bf16_t*)(ws + WS_POOLED), DM, nullptr, 0, 1.f}; pg8::gemm_phase(lds, DM * 2, DM, S, E); } while (0)
#define P_G2 do { DenseSched S; S.ord.init(32, 8, G, bx); S.A = (const char*)(ws + WS_POOLED); S.B = (const char*)(ws + WS_WGRP); S.lda_b = DM * 2; S.K = 512; S.mode = 1; S.agrp = 1024; \
        EpiBf16 E{(bf16_t*)(ws + WS_MIXED), DM, a.in[I_ASCALE], 0, 1.f}; pg8::gemm_phase(lds, DM * 2, 512, S, E); } while (0)
#define P_G3 do { DenseSched S; S.ord.init(32, 8, G, bx); S.A = (const char*)(ws + WS_MIXED); S.B = (const char*)(ws + WS_WOUT); S.lda_b = DM * 2; S.K = DM; S.mode = 0; S.agrp = 0; \
        EpiZ E{a.in[I_X], nullptr, (bf16_t*)(ws + WS_Z)}; pg8::gemm_phase(lds, DM * 2, DM, S, E); } while (0)
#define P_G4(l, BGK, BGL, NR, BGF, BGT) do { const int nmt = __builtin_amdgcn_readfirstlane(*(const int*)(ws + WS_NMT)); const int isp = (BGK) >= 0 ? (vcu >> 5) % (NR) : 1 << 20; \
        MoeSched S{(const int*)(ws + WS_MTE), (const int*)(ws + WS_ROWIDX), (const char*)(ws + WS_X1B), (const char*)(ws + WS_WGU) + (size_t)(l) * 65 * 1024 * 2048 * 2, nmt * 4, 4, G, vcu, 1, \
                   (size_t)1024 * 2048 * 2, (size_t)256 * 2048 * 2, 0, 0, isp}; \
        EpiSwiGLU E{(bf16_t*)(ws + WS_H), 1.f, 0}; pg8::gemm_phase(lds, DM * 2, DM, S, E); \
        if ((BGK) >= 0) { int blo, bhi; bg_share((BGF), (BGT), vcu, G, S.nunits % G, 55, blo, bhi); bg_convert_range(a, lds, (BGK), (BGL), blo, bhi, wave, lane); S.i0 = isp; S.i1 = 1 << 20; pg8::gemm_phase(lds, DM * 2, DM, S, E); } } while (0)
#define P_G4H(l, BGK, BGL, NR, BGF, BGT) do { const int nmt = __builtin_amdgcn_readfirstlane(*(const int*)(ws + WS_NMT)); const int isp = (BGK) >= 0 ? (vcu >> 5) % (NR) : 1 << 20; \
        MoeSched S{(const int*)(ws + WS_MTE), (const int*)(ws + WS_ROWIDX), (const char*)(ws + WS_X1B), (const char*)(ws + WS_WGU) + (size_t)(l) * 65 * 1024 * 2048 * 2, nmt * 4, 4, G, vcu, 1, \
                   (size_t)1024 * 2048 * 2, (size_t)256 * 2048 * 2, 0, 0, isp}; \
        EpiSwiGLU E{(bf16_t*)(ws + WS_H), 1.f, 1}; pg8::gemm_phase(lds, DM * 2, DM, S, E); \
        if ((BGK) >= 0) { int blo, bhi; bg_share((BGF), (BGT), vcu, G, S.nunits % G, 55, blo, bhi); bg_convert_range(a, lds, (BGK), (BGL), blo, bhi, wave, lane); S.i0 = isp; S.i1 = 1 << 20; pg8::gemm_phase(lds, DM * 2, DM, S, E); } } while (0)
#define P_G4F(l, BGK, BGL, NR, BGF, BGT) do { const int nmt = __builtin_amdgcn_readfirstlane(*(const int*)(ws + WS_NMT)); const int isp = (BGK) >= 0 ? (vcu >> 5) % (NR) : 1 << 20; \
        MoeSchedT<true> S{(const int*)(ws + WS_MTE), (const int*)(ws + WS_ROWIDX), (const char*)(ws + WS_X1Q), (const char*)(ws + WS_WGU) + (size_t)(l) * 65 * 1024 * 2048 * 2, nmt * 4, 4, G, vcu, 1, \
                   (size_t)1024 * 2048, (size_t)256 * 2048, 0, 0, isp}; \
        EpiSwiGLU E{(bf16_t*)(ws + WS_H), 1.f / W8_SCALE, 1}; pg8::gemm_phase(lds, DM, DM / 2, S, E); \
        if ((BGK) >= 0) { int blo, bhi; bg_share((BGF), (BGT), vcu, G, S.nunits % G, 30, blo, bhi); bg_convert_range(a, lds, (BGK), (BGL), blo, bhi, wave, lane); S.i0 = isp; S.i1 = 1 << 20; pg8::gemm_phase(lds, DM, DM / 2, S, E); } } while (0)
#define P_G5(l, BGK, BGL, NR, BGF, BGT) do { const int nmt = __builtin_amdgcn_readfirstlane(*(const int*)(ws + WS_NMT)); const int isp = (BGK) >= 0 ? (vcu >> 5) % (NR) : 1 << 20; \
        MoeSched S{(const int*)(ws + WS_MTE), (const int*)(ws + WS_ROWIDX), (const char*)(ws + WS_H), (const char*)(ws + WS_WD) + (size_t)(l) * 65 * 2048 * 512 * 2, nmt * 8, 8, G, vcu, 0, \
                   (size_t)2048 * 512 * 2, (size_t)256 * 512 * 2, (size_t)256 * 1024, 0, isp}; \
        EpiBf16 E{(bf16_t*)(ws + WS_Y), DM, nullptr, 1, 1.f}; pg8::gemm_phase(lds, ED * 2, ED, S, E); \
        if ((BGK) >= 0) { int blo, bhi; bg_share((BGF), (BGT), vcu, G, S.nunits % G, 20, blo, bhi); bg_convert_range(a, lds, (BGK), (BGL), blo, bhi, wave, lane); S.i0 = isp; S.i1 = 1 << 20; pg8::gemm_phase(lds, ED * 2, ED, S, E); } } while (0)
#define P_G5F(l, BGK, BGL, NR, BGF, BGT) do { const int nmt = __builtin_amdgcn_readfirstlane(*(const int*)(ws + WS_NMT)); const int isp = (BGK) >= 0 ? (vcu >> 5) % (NR) : 1 << 20; \
        MoeSchedT<true> S{(const int*)(ws + WS_MTE), (const int*)(ws + WS_ROWIDX), (const char*)(ws + WS_H), (const char*)(ws + WS_WD) + (size_t)(l) * 65 * 2048 * 512 * 2, nmt * 8, 8, G, vcu, 0, \
                   (size_t)2048 * 512, (size_t)256 * 512, (size_t)256 * 512, 0, isp}; \
        EpiBf16 E{(bf16_t*)(ws + WS_Y), DM, nullptr, 1, 1.f / W8_SCALE}; pg8::gemm_phase(lds, ED, ED / 2, S, E); \
        if ((BGK) >= 0) { int blo, bhi; bg_share((BGF), (BGT), vcu, G, S.nunits % G, 12, blo, bhi); bg_convert_range(a, lds, (BGK), (BGL), blo, bhi, wave, lane); S.i0 = isp; S.i1 = 1 << 20; pg8::gemm_phase(lds, ED, ED / 2, S, E); } } while (0)
#define P_G6 do { if (G > 160 && bx >= 160) { const int per = (G6_ITEMS + (G - 160) - 1) / (G - 160), blo = (bx - 160) * per, bhi = blo + per; bg_convert_range(a, lds, 3, 1, blo < G6_ITEMS ? blo : G6_ITEMS, bhi < G6_ITEMS ? bhi : G6_ITEMS, wave, lane); } \
        DenseSched S; S.ord.init(32, 5, G, bx); S.A = (const char*)(ws + WS_X2B); S.B = (const char*)(ws + WS_WKVQ); S.lda_b = DM * 2; S.K = DM; S.mode = 0; S.agrp = 0; \
        EpiBf16 E{(bf16_t*)(ws + WS_CKQ), NCKQ, nullptr, 0, 1.f}; pg8::gemm_phase(lds, DM * 2, DM, S, E); } while (0)
#define P_G7 do { DenseSched S; S.ord.init(32, 28, G, bx); S.A = (const char*)(ws + WS_CKQ); S.B = (const char*)(ws + WS_WUP); S.lda_b = NCKQ * 2; S.K = 512; S.mode = 2; S.agrp = 0; \
        EpiUp E{(bf16_t*)(ws + WS_Q), (bf16_t*)(ws + WS_K), (bf16_t*)(ws + WS_V), (const float*)(ws + WS_RSTAT), (const f32x2*)(ws + WS_ROPE)}; pg8::gemm_phase(lds, NCKQ * 2, 512, S, E); } while (0)
#define P_ATT do { AttHook H{&a, lds, vcu, G, wave, lane}; att::attn_phase((att::lptr)lds, (const bf16_t*)(ws + WS_Q), (const bf16_t*)(ws + WS_K), (const bf16_t*)(ws + WS_V), (bf16_t*)(ws + WS_ATT), vcu, G, H); } while (0)
#define P_G8 do { DenseSched S; S.ord.init(32, 8, G, bx); S.A = (const char*)(ws + WS_ATT); S.B = (const char*)(ws + WS_WBO); S.lda_b = DM * 2; S.K = DM; S.mode = 0; S.agrp = 0; \
        EpiZ E{nullptr, (const bf16_t*)(ws + WS_X2B), (bf16_t*)(ws + WS_Z)}; pg8::gemm_phase(lds, DM * 2, DM, S, E); } while (0)
#define MOE_PHASES(l, pb, K4, L4, F4, T4, K5, L5, F5, T5, G4M, G5M) do { \
        RUN(pb, phase_r1(a, lds, l, G, wave, lane)); SEAM(pb); \
        RUN((pb) + 1, phase_r2(a, lds, G, tid, wave, lane)); \
        if (EXPER && (l) == 0 && PH((pb) + 1)) { __syncthreads(); if (EXPER == 1 ? vcu < 32 : EXPER == 2 ? (vcu & 7) == 0 : EXPER == 3 ? true : EXPER == 4 ? vcu < 64 : (vcu & 3) == 0) bg_convert(a, lds, 1, 1, vcu, G, wave, lane); } \
        SEAM((pb) + 1); \
        RUN((pb) + 2, G4M(l, K4, L4, 5, F4, T4)); SEAM((pb) + 2); \
        RUN((pb) + 3, G5M(l, K5, L5, 10, F5, T5)); SEAM((pb) + 3); \
        RUN((pb) + 4, phase_ln2(a, l, vcu, G, wave, lane)); } while (0)

    RUN(0, phase_prologue(a, lds, vcu, G, wave, lane)); SEAM(0);
    if (MK_N_LAUNCHES == 1 && HWIDS && PH(0) && PH(1) && G % 8 == 0) {
        const unsigned* cen = (const unsigned*)(ws + WS_CTL) + CW_BAR; bool ok = true;
#pragma unroll
        for (int j = 0; j < 16; ++j) { const unsigned c = __hip_atomic_load(cen + XB_XCNT(j), __ATOMIC_RELAXED, __HIP_MEMORY_SCOPE_AGENT); ok = ok && (c == (j < 8 ? (unsigned)(G / 8) : 0u)); }
        const int rank = (int)MISC[16], xcc = (int)MISC[17];
        if (ok && xcc < 8 && rank < G / 8) { vcu = xcc * (G / 8) + rank; bx = rank * 8 + xcc; }
    }
    RUN(1, P_G1); SEAM(1);
    RUN(2, P_G2); SEAM(2);
    RUN(3, P_G3); SEAM(3);
    MOE_PHASES(0, 4, L0F8 ? 3 : 1, 0, 0, 65 * 256, -1, 1, 0, 0, P_G4SEL, P_G5SEL); SEAM(8);
    RUN(9, P_G6); SEAM(9);
    RUN(10, phase_stats(a, vcu, G, wave, lane)); SEAM(10);
    RUN(11, P_G7); SEAM(11);
    RUN(12, P_ATT); SEAM(12);
    RUN(13, P_G8); SEAM(13);
    MOE_PHASES(1, 14, -1, 1, 0, 0, -1, 0, 0, 0, P_G4F, P_G5F);
#undef MOE_PHASES
#undef RUN
#undef PH
#undef SEAM
}

extern "C" void kernel_launch(void* const* d_in, const int* in_sizes, int n_in, void* d_out, int out_size, void* d_ws, size_t ws_size, hipStream_t stream) {
    static int grid = 0;
    if (grid == 0) {
        if (n_in != 25 || out_size != T * DM || ws_size < WS_END) { fprintf(stderr, "kernel_launch: unexpected shapes (n_in %d, out %d, ws %zu)\n", n_in, out_size, ws_size); grid = -1; return; }
        int dev = 0, cus = 0;
        if (hipGetDevice(&dev) != hipSuccess || hipDeviceGetAttribute(&cus, hipDeviceAttributeMultiprocessorCount, dev) != hipSuccess) { grid = -1; return; }
        if (hipFuncSetAttribute((const void*)fwd_kernel, hipFuncAttributeMaxDynamicSharedMemorySize, LDS_BYTES) != hipSuccess) { fprintf(stderr, "kernel_launch: hipFuncSetAttribute failed\n"); grid = -1; return; }
        int per_cu = 0;
        if (hipOccupancyMaxActiveBlocksPerMultiprocessor(&per_cu, (const void*)fwd_kernel, 512, LDS_BYTES) != hipSuccess || per_cu < 1) fprintf(stderr, "kernel_launch: occupancy query reports %d blocks per CU\n", per_cu);
        (void)hipGetLastError();
        grid = cus;
    }
    if (grid < 0) return;
    (void)hipMemsetAsync((char*)d_ws + WS_CTL, 0, CTL_ZERO_BYTES, stream);
    KArgs a{};
    for (int i = 0; i < 25; ++i) a.in[i] = (const float*)d_in[i];
    a.out = (float*)d_out; a.ws = (unsigned char*)d_ws;
#if MK_N_LAUNCHES == 1
    a.ph_lo = 0; a.ph_hi = N_PHASES;
    hipLaunchKernelGGL(fwd_kernel, dim3(grid), dim3(512), LDS_BYTES, stream, a);
#else
    for (int k = 0; k < N_PHASES; ++k) { a.ph_lo = k; a.ph_hi = k + 1; hipLaunchKernelGGL(fwd_kernel, dim3(grid), dim3(512), LDS_BYTES, stream, a); }
#endif
}
```

```cpp
#include <hip/hip_runtime.h>
#include <cstdio>
#include <cstdint>

#ifndef MK_N_LAUNCHES
#define MK_N_LAUNCHES 1
#endif

#ifndef L0F8
#define L0F8 2
#endif
#if L0F8 == 2
#define P_G4SEL P_G4F
#define P_G5SEL P_G5F
#elif L0F8 == 1
#define P_G4SEL P_G4H
#define P_G5SEL P_G5F
#else
#define P_G4SEL P_G4
#define P_G5SEL P_G5
#endif
#define LAS __attribute__((address_space(3)))
#define GAS __attribute__((address_space(1)))
typedef unsigned short bf16_t;
typedef short bf16x8 __attribute__((ext_vector_type(8)));
typedef short s16x4 __attribute__((ext_vector_type(4)));
typedef float f32x2 __attribute__((ext_vector_type(2)));
typedef float f32x4 __attribute__((ext_vector_type(4)));
typedef float f32x16 __attribute__((ext_vector_type(16)));
typedef unsigned u32x2 __attribute__((ext_vector_type(2)));
typedef unsigned u32x4 __attribute__((ext_vector_type(4)));

constexpr int T = 8192, DM = 2048, SEQ = 4096, NBATCH = 2, NH = 16, NE = 64, TOPK = 8, ED = 512;
constexpr int DQK = 192, DV = 128, NCKQ = 1280;
constexpr float ALPHA = 1.4142135623730951f;
constexpr float LN_EPS = 1e-5f, RMS_EPS = 1e-6f;
constexpr int NSLOT_ROWS = 8192 + 65536 + 64 * 256;
constexpr int NCHUNK = T / 32;

constexpr size_t MiB = 1u << 20, KiB = 1u << 10;
constexpr size_t WS_CTL = 0, CTL_ZERO_BYTES = 1 * MiB;
constexpr size_t WS_ROPE = 1 * MiB;
constexpr size_t WS_RWHI = 2 * MiB;
constexpr size_t WS_RWLO = 2 * MiB + 512 * KiB;
constexpr size_t WS_RC = 3 * MiB;
constexpr size_t WS_CNT = 3 * MiB + 64 * KiB;
constexpr size_t WS_TOKE = 3 * MiB + 256 * KiB;
constexpr size_t WS_TOKG = 3 * MiB + 512 * KiB;
constexpr size_t WS_TOKS = 3 * MiB + 768 * KiB;
constexpr size_t WS_ROWIDX = 4 * MiB;
constexpr size_t WS_MTE = 4 * MiB + 512 * KiB;
constexpr size_t WS_NMT = 4 * MiB + 516 * KiB;
constexpr size_t WS_RSTAT = 5 * MiB;
constexpr size_t WS_WIN = 8 * MiB, WS_WGRP = 16 * MiB, WS_WOUT = 18 * MiB, WS_WKVQ = 26 * MiB, WS_WUP = 31 * MiB, WS_WBO = 38 * MiB;
constexpr size_t WS_WGU = 48 * MiB;
constexpr size_t WS_WD = 568 * MiB;
constexpr size_t WS_XP = 828 * MiB;
constexpr size_t WS_Q = 828 * MiB, WS_K = 876 * MiB, WS_V = 924 * MiB;
constexpr size_t WS_POOLED = 956 * MiB;
constexpr size_t WS_ATT = 956 * MiB;
constexpr size_t WS_X1Q = 956 * MiB;
constexpr size_t WS_MIXED = 988 * MiB;
constexpr size_t WS_CKQ = 988 * MiB;
constexpr size_t WS_Z = 1020 * MiB;
constexpr size_t WS_X1F = 1084 * MiB, WS_X1B = 1148 * MiB;
constexpr size_t WS_X2F = 1180 * MiB, WS_X2B = 1244 * MiB;
constexpr size_t WS_H = 1276 * MiB;
constexpr size_t WS_Y = 1364 * MiB;
constexpr size_t WS_END = 1716 * MiB;

constexpr int CW_BAR = 4096;

constexpr int RING_BYTES = 131072;
constexpr int MISC_OFF = RING_BYTES + 320;
constexpr int LDS_BYTES = 147456;

#define LDS_WAIT() asm volatile("s_waitcnt lgkmcnt(0)" ::: "memory")
#define VM_WAIT() asm volatile("s_waitcnt vmcnt(0)" ::: "memory")
__device__ __forceinline__ unsigned cvt_pk_bf16(float lo, float hi) { unsigned r; asm volatile("v_cvt_pk_bf16_f32 %0, %1, %2" : "=v"(r) : "v"(lo), "v"(hi)); return r; }
__device__ __forceinline__ float bf_lo(unsigned w) { return __uint_as_float(w << 16); }
__device__ __forceinline__ float bf_hi(unsigned w) { return __uint_as_float(w & 0xffff0000u); }
__device__ __forceinline__ float wave_sum(float v) {
#pragma unroll
    for (int o = 1; o < 64; o <<= 1) v += __shfl_xor(v, o);
    return v;
}

#define XB_TMO      128
#define XB_XCNT(j)  (256  + 64 * (j))
#define XB_XSUB(j)  (1280 + 64 * (j))
#define XB_XGEN(j)  (2304 + 64 * (j))
#define XB_TOP      3328
#define XB_TOPGEN   3392
#define XCD_BAR_WORDS 3456
#define XB_SPIN_CAP (1u << 18)
__device__ __forceinline__ unsigned xb_ld(unsigned* p)              { return __hip_atomic_load(p, __ATOMIC_RELAXED, __HIP_MEMORY_SCOPE_AGENT); }
__device__ __forceinline__ unsigned xb_add(unsigned* p, unsigned v) { return __hip_atomic_fetch_add(p, v, __ATOMIC_RELAXED, __HIP_MEMORY_SCOPE_AGENT); }
__device__ __forceinline__ unsigned xb_xcc_id() { return (unsigned)__builtin_amdgcn_s_getreg((3 << 11) | 20) & 0xFu; }
#define XB_SPIN(cond, bar) do { unsigned _sp = 0; while (cond) { __builtin_amdgcn_s_sleep(1); \
    if ((++_sp & 255u) == 0u) { if (xb_ld(&(bar)[XB_TMO])) break; if (_sp > XB_SPIN_CAP) { atomicAdd(&(bar)[XB_TMO], 1u); break; } } } } while (0)
struct XcdBarrier { unsigned* bar; unsigned x; volatile LAS unsigned* st; };
__device__ __forceinline__ XcdBarrier xcd_barrier_post(unsigned* bar, volatile LAS unsigned* st) {
    XcdBarrier b; b.bar = bar; b.x = xb_xcc_id(); b.st = st;
    if (threadIdx.x == 0) { const unsigned rank = xb_add(&bar[XB_XCNT(b.x)], 1u); st[8] = rank; st[9] = b.x; }
    return b;
}
__device__ __forceinline__ void xcd_barrier_complete(unsigned* bar, unsigned x, unsigned& nloc, unsigned& nx) {
    const unsigned G = gridDim.x * gridDim.y * gridDim.z;
    unsigned sum, cnt, mine, sp = 0u;
    for (;;) {
        sum = 0u; cnt = 0u; mine = 0u;
#pragma unroll
        for (unsigned j = 0; j < 16; ++j) { const unsigned c = xb_ld(&bar[XB_XCNT(j)]); sum += c; cnt += (c > 0u) ? 1u : 0u; mine = (j == x) ? c : mine; }
        if (sum == G) break;
        __builtin_amdgcn_s_sleep(1);
        if ((++sp & 255u) == 0u) { if (xb_ld(&bar[XB_TMO])) break; if (sp > XB_SPIN_CAP) { atomicAdd(&bar[XB_TMO], 1u); break; } }
    }
    nloc = mine > 0u ? mine : 1u; nx = cnt > 0u ? cnt : 1u;
}
__device__ __forceinline__ void xcd_barrier(const XcdBarrier& b) {
    asm volatile("s_waitcnt vmcnt(0)" ::: "memory");
    __syncthreads();
    if (threadIdx.x == 0) {
        unsigned* bar = b.bar;
        __builtin_amdgcn_s_waitcnt(0);
        unsigned nloc = b.st[0], nx = b.st[1];
        if (nloc == 0u) { xcd_barrier_complete(bar, b.x, nloc, nx); b.st[0] = nloc; b.st[1] = nx; }
        const unsigned old = xb_add(&bar[XB_XSUB(b.x)], 1u);
        const unsigned gen = old / nloc;
        if (old + 1u == (gen + 1u) * nloc) {
            __builtin_amdgcn_fence(__ATOMIC_RELEASE, "agent");
            asm volatile("s_waitcnt vmcnt(0)" ::: "memory");
            const unsigned og = xb_add(&bar[XB_TOP], 1u);
            const unsigned tg = og / nx;
            if (og + 1u == (tg + 1u) * nx) xb_add(&bar[XB_TOPGEN], 1u);
            else XB_SPIN(xb_ld(&bar[XB_TOPGEN]) == tg, bar);
            __builtin_amdgcn_fence(__ATOMIC_ACQUIRE, "agent");
            xb_add(&bar[XB_XGEN(b.x)], 1u);
            asm volatile("s_waitcnt vmcnt(0)" ::: "memory");
        } else {
            XB_SPIN(xb_ld(&bar[XB_XGEN(b.x)]) == gen, bar);
            __builtin_amdgcn_fence(__ATOMIC_ACQUIRE, "agent");
            asm volatile("s_waitcnt vmcnt(0)" ::: "memory");
        }
    }
    __syncthreads();
}

namespace pg8 {
constexpr int BM = 256, BK = 64, HALF = 128, HTB = HALF * BK * 2, STAGE_BYTES = 8 * HTB, NXCD = 8, WGM = 8;
__host__ __device__ __forceinline__ int lds_byte(int r, int c) { const int st = (r >> 4) * 2 + (c >> 5), rr = r & 15, cc = c & 31, ob = rr * 64 + cc * 2; return st * 1024 + (ob ^ (((ob >> 9) & 1) << 5)); }
__host__ __device__ __forceinline__ void stage_rc(int b, int& R, int& C) { const int st = b / 1024, sb = b % 1024, swz = sb ^ (((sb >> 9) & 1) << 5); R = (st >> 1) * 16 + swz / 64; C = (st & 1) * 32 + (swz % 64) / 2; }
__host__ __device__ __forceinline__ int perm32(int rho) { const int n = rho >> 4, i = rho & 15; return 8 * (i >> 2) + 4 * n + (i & 3); }

typedef int v8i32 __attribute__((ext_vector_type(8)));
typedef int v4i32 __attribute__((ext_vector_type(4)));
template <bool F8> struct FragT { typedef bf16x8 type; };
template <> struct FragT<true> { typedef v8i32 type; };
__device__ __forceinline__ void ldfrag(bf16x8& d, const LAS unsigned char* p) { d = *(const LAS bf16x8*)p; }
__device__ __forceinline__ void ldfrag(v8i32& d, const LAS unsigned char* p) { const v4i32 x = *(const LAS v4i32*)p, y = *(const LAS v4i32*)(p + 16); d = __builtin_shufflevector(x, y, 0, 1, 2, 3, 4, 5, 6, 7); }
__device__ __forceinline__ f32x4 mma(v8i32 b, v8i32 a, f32x4 c, int sc) {
    asm volatile("v_mfma_scale_f32_16x16x128_f8f6f4 %0, %1, %2, %0, %3, %3 op_sel_hi:[0,0,0]" : "+v"(c) : "v"(b), "v"(a), "v"(sc)); return c; }
__device__ __forceinline__ f32x4 mma(bf16x8 b, bf16x8 a, f32x4 c, int) { return __builtin_amdgcn_mfma_f32_16x16x32_bf16(b, a, c, 0, 0, 0); }
struct Unit { const char* A; const char* B; const int* rows; int m0, pn, aux; };

struct TileOrder {
    int nM, nN, nwg, G, c;
    __device__ __forceinline__ void init(int nM_, int nN_, int G_, int c_) { nM = nM_; nN = nN_; nwg = nM * nN; G = G_; c = c_; }
    __device__ __forceinline__ bool next(int i, int& pm, int& pn) const {
        const long L = (long)i * G + c; if (L >= nwg) return false;
        int wgid = (int)L; { const int q = nwg / NXCD, r = nwg % NXCD, xcd = wgid % NXCD, off = wgid / NXCD; wgid = (xcd < r ? xcd * (q + 1) : r * (q + 1) + (xcd - r) * q) + off; }
        const int nig = WGM * nN, gid = wgid / nig, fm = gid * WGM, gsz = (nM - fm) < WGM ? (nM - fm) : WGM;
        pm = fm + ((wgid % nig) % gsz); pn = (wgid % nig) / gsz; return true;
    }
};

template <class Epi, class Sched>
__device__ __forceinline__ void gemm_phase(LAS unsigned char* lds, const int lda_b, const int K, const Sched& S, const Epi& E) {
    const int tid = threadIdx.x, wid = __builtin_amdgcn_readfirstlane(tid >> 6), lane = tid & 63, wr = wid >> 2, wc = wid & 3, fr = lane & 15, fq = lane >> 4;
    const int nt = K / BK;
    int Rs[2]; unsigned Cb[2], voffB[2];
#pragma unroll
    for (int i = 0; i < 2; ++i) { int R, C; stage_rc(tid * 16 + i * 8192, R, C); const int Rb = Epi::PERM ? ((R & ~31) + perm32(R & 31)) : R;
        Rs[i] = R; Cb[i] = (unsigned)C * 2u; voffB[i] = (unsigned)(Rb * K + C) * 2u; }
    const size_t kstep = (size_t)(BK * 2);
    const size_t hstepB = (size_t)HALF * K * 2;
    const unsigned ldsw = (unsigned)wid * 1024u;
    int sc1 = 0x7f7f7f7f; asm volatile("" : "+v"(sc1));
    constexpr bool F8 = Sched::FP8;
    const int aoff = lds_byte(wr * 64 + fr, fq * (F8 ? 16 : 8)), boff = lds_byte(wc * 32 + fr, fq * (F8 ? 16 : 8));
#define PG8_SA(b, h) (((b) * 2 + (h)) * HTB)
#define PG8_SB(b, h) ((4 + (b) * 2 + (h)) * HTB)
#define PG8_STAGE(bufoff, gbase, voff) do { _Pragma("unroll") for (int _i = 0; _i < 2; ++_i) \
        __builtin_amdgcn_global_load_lds((const unsigned*)((const char*)(gbase) + (voff)[_i]), (LAS unsigned*)(lds + (bufoff) + ldsw + _i * 8192), 16, 0, 0); } while (0)
#define PG8_LDA(dst, b, h) do { _Pragma("unroll") for (int m = 0; m < 4; ++m) _Pragma("unroll") for (int k = 0; k < NK; ++k) pg8::ldfrag(dst[m][k], lds + PG8_SA(b, h) + aoff + m * 2048 + k * 1024); } while (0)
#define PG8_LDB(dst, b, h) do { _Pragma("unroll") for (int n = 0; n < 2; ++n) _Pragma("unroll") for (int k = 0; k < NK; ++k) pg8::ldfrag(dst[n][k], lds + PG8_SB(b, h) + boff + n * 2048 + k * 1024); } while (0)
#define PG8_MMA(ai, bj, At, Bt) do { __builtin_amdgcn_s_setprio(1); _Pragma("unroll") for (int m = 0; m < 4; ++m) _Pragma("unroll") for (int n = 0; n < 2; ++n) _Pragma("unroll") for (int k = 0; k < NK; ++k) \
        acc[ai][bj][m][n] = pg8::mma(Bt[n][k], At[m][k], acc[ai][bj][m][n], sc1); __builtin_amdgcn_s_setprio(0); } while (0)
#define PG8_WAIT_V(n) asm volatile("s_waitcnt vmcnt(" #n ")" ::: "memory")
#define PG8_WAIT_L(n) asm volatile("s_waitcnt lgkmcnt(" #n ")" ::: "memory")
#define PG8_BAR __builtin_amdgcn_s_barrier()
#define PG8_SCHED __builtin_amdgcn_sched_barrier(0)
#define PG8_MKOFF(u, vo) do { _Pragma("unroll") for (int _h = 0; _h < 2; ++_h) _Pragma("unroll") for (int _i = 0; _i < 2; ++_i) { const int _R = _h * HALF + Rs[_i]; \
        const int _row = (u).rows ? (u).rows[_R] : _R; vo[_h][_i] = (unsigned)_row * (unsigned)lda_b + Cb[_i]; } } while (0)
    Unit cur, nxt; int ui = 0;
    if (!S.next(0, cur)) return;
    f32x4 acc[2][2][4][2];
#pragma unroll
    for (int a = 0; a < 2; ++a)
#pragma unroll
        for (int b = 0; b < 2; ++b)
#pragma unroll
            for (int m = 0; m < 4; ++m)
#pragma unroll
                for (int n = 0; n < 2; ++n) acc[a][b][m][n] = (f32x4){0.f, 0.f, 0.f, 0.f};
    typedef typename pg8::FragT<F8>::type frag_t; constexpr int NK = F8 ? 1 : 2;
    frag_t At[4][NK], B0[2][NK], B1[2][NK];
    unsigned voC[2][2], voN[2][2];
    PG8_MKOFF(cur, voC);
    const char* cA = cur.A; const char* cB = cur.B;
    PG8_STAGE(PG8_SB(0, 0), cB, voffB); PG8_STAGE(PG8_SA(0, 0), cA, voC[0]); PG8_STAGE(PG8_SB(0, 1), cB + hstepB, voffB); PG8_STAGE(PG8_SA(0, 1), cA, voC[1]);
    if (wr == 1) PG8_BAR;
    PG8_WAIT_V(4); PG8_BAR;
    PG8_STAGE(PG8_SB(1, 0), cB + kstep, voffB); PG8_STAGE(PG8_SA(1, 0), cA + kstep, voC[0]); PG8_STAGE(PG8_SB(1, 1), cB + hstepB + kstep, voffB);
    PG8_WAIT_V(6); PG8_BAR;
    for (;;) {
        const bool has_next = S.next(ui + 1, nxt);
        const char* nA = has_next ? nxt.A : cA; const char* nB = has_next ? nxt.B : cB;
        if (has_next) { PG8_MKOFF(nxt, voN); }
        else {
#pragma unroll
            for (int h = 0; h < 2; ++h)
#pragma unroll
                for (int i = 0; i < 2; ++i) voN[h][i] = voC[h][i]; }
        for (int t = 0; t < nt; t += 2) {
            const bool last = (t == nt - 2);
            const char* a1 = cA + (size_t)(t + 1) * kstep;
            const char* a2 = last ? nA : cA + (size_t)(t + 2) * kstep; const char* b2 = last ? nB : cB + (size_t)(t + 2) * kstep;
            const char* a3 = a2 + kstep; const char* b3 = b2 + kstep;
            unsigned v2[2][2];
#pragma unroll
            for (int h = 0; h < 2; ++h)
#pragma unroll
                for (int i = 0; i < 2; ++i) v2[h][i] = last ? voN[h][i] : voC[h][i];
            PG8_LDB(B0, 0, 0); PG8_SCHED; PG8_LDA(At, 0, 0); PG8_STAGE(PG8_SA(1, 1), a1, voC[1]);
            PG8_WAIT_L(8); PG8_BAR; PG8_WAIT_L(0); PG8_MMA(0, 0, At, B0); PG8_BAR; PG8_SCHED;
            PG8_LDB(B1, 0, 1); PG8_STAGE(PG8_SB(0, 0), b2, voffB);
            PG8_BAR; PG8_WAIT_L(0); PG8_MMA(0, 1, At, B1); PG8_BAR;
            PG8_LDA(At, 0, 1); PG8_STAGE(PG8_SA(0, 0), a2, v2[0]);
            PG8_BAR; PG8_WAIT_L(0); PG8_MMA(1, 0, At, B0); PG8_BAR; PG8_SCHED;
            PG8_STAGE(PG8_SB(0, 1), b2 + hstepB, voffB);
            PG8_WAIT_V(6); PG8_BAR; PG8_MMA(1, 1, At, B1); PG8_BAR;
            PG8_LDB(B0, 1, 0); PG8_SCHED; PG8_LDA(At, 1, 0); PG8_STAGE(PG8_SA(0, 1), a2, v2[1]);
            PG8_WAIT_L(8); PG8_BAR; PG8_WAIT_L(0); PG8_MMA(0, 0, At, B0); PG8_BAR; PG8_SCHED;
            PG8_LDB(B1, 1, 1); PG8_STAGE(PG8_SB(1, 0), b3, voffB);
            PG8_BAR; PG8_WAIT_L(0); PG8_MMA(0, 1, At, B1); PG8_BAR;
            PG8_LDA(At, 1, 1); PG8_STAGE(PG8_SA(1, 0), a3, v2[0]);
            PG8_BAR; PG8_WAIT_L(0); PG8_MMA(1, 0, At, B0); PG8_BAR; PG8_SCHED;
            PG8_STAGE(PG8_SB(1, 1), b3 + hstepB, voffB);
            PG8_WAIT_V(6); PG8_BAR; PG8_MMA(1, 1, At, B1); PG8_BAR;
        }
        if constexpr (F8) asm volatile("s_nop 15\n\ts_nop 15\n\ts_nop 7" ::: "memory");
        E(acc, cur, wr, wc, fr, fq);
        if (!has_next) break;
#pragma unroll
        for (int a = 0; a < 2; ++a)
#pragma unroll
            for (int b = 0; b < 2; ++b)
#pragma unroll
                for (int m = 0; m < 4; ++m)
#pragma unroll
                    for (int n = 0; n < 2; ++n) acc[a][b][m][n] = (f32x4){0.f, 0.f, 0.f, 0.f};
        cur = nxt; cA = nA; cB = nB; ++ui;
#pragma unroll
        for (int h = 0; h < 2; ++h)
#pragma unroll
            for (int i = 0; i < 2; ++i) voC[h][i] = voN[h][i];
    }
    PG8_WAIT_V(0);
    if (wr == 0) PG8_BAR;
    PG8_BAR;
#undef PG8_SA
#undef PG8_SB
#undef PG8_STAGE
#undef PG8_LDA
#undef PG8_LDB
#undef PG8_MMA
#undef PG8_WAIT_V
#undef PG8_WAIT_L
#undef PG8_BAR
#undef PG8_SCHED
#undef PG8_MKOFF
}
}

__device__ __forceinline__ unsigned pk4_fp8(float a, float b, float c, float d) { int w = 0; w = __builtin_amdgcn_cvt_pk_fp8_f32(a, b, w, false); w = __builtin_amdgcn_cvt_pk_fp8_f32(c, d, w, true); return (unsigned)w; }
constexpr float W8_SCALE = 32.f;
struct EpiBf16 {
    static constexpr bool PERM = true;
    bf16_t* O; int ldc; const float* colscale; int nt; float sc;
    __device__ __forceinline__ void operator()(const f32x4 (&acc)[2][2][4][2], const pg8::Unit& u, int wr, int wc, int fr, int fq) const {
        const int col0 = u.pn * 256 + wc * 32 + 8 * fq;
        f32x4 scv[2][2];
#pragma unroll
        for (int bj = 0; bj < 2; ++bj) { scv[bj][0] = colscale ? *(const f32x4*)(colscale + col0 + bj * 128) : (f32x4){1.f, 1.f, 1.f, 1.f}; scv[bj][1] = colscale ? *(const f32x4*)(colscale + col0 + bj * 128 + 4) : (f32x4){1.f, 1.f, 1.f, 1.f}; scv[bj][0] *= sc; scv[bj][1] *= sc; }
#pragma unroll
        for (int ai = 0; ai < 2; ++ai)
#pragma unroll
            for (int m = 0; m < 4; ++m) { bf16_t* rowp = O + (size_t)(u.m0 + ai * 128 + wr * 64 + m * 16 + fr) * ldc + col0;
#pragma unroll
                for (int bj = 0; bj < 2; ++bj) { const f32x4 v0 = acc[ai][bj][m][0] * scv[bj][0], v1 = acc[ai][bj][m][1] * scv[bj][1];
                    u32x4 w; w.x = cvt_pk_bf16(v0[0], v0[1]); w.y = cvt_pk_bf16(v0[2], v0[3]); w.z = cvt_pk_bf16(v1[0], v1[1]); w.w = cvt_pk_bf16(v1[2], v1[3]);
                    if (nt) __builtin_nontemporal_store(w, (u32x4*)(rowp + bj * 128)); else *(u32x4*)(rowp + bj * 128) = w; } }
    }
};
constexpr float Y8_SCALE = 16.f;
static_assert(L0F8 >= 1, "the combine (LN2) reads e4m3 Y rows: both layers' down projections must run on the fp8 path");
struct EpiY8 {
    static constexpr bool PERM = true;
    unsigned char* O; float sc;
    __device__ __forceinline__ void operator()(const f32x4 (&acc)[2][2][4][2], const pg8::Unit& u, int wr, int wc, int fr, int fq) const {
        const int odd = fq & 1, colb = u.pn * 256 + wc * 32 + 8 * (fq - odd) + odd * 128;
#pragma unroll
        for (int ai = 0; ai < 2; ++ai)
#pragma unroll
            for (int m = 0; m < 4; ++m) { unsigned char* rowp = O + (size_t)(u.m0 + ai * 128 + wr * 64 + m * 16 + fr) * DM + colb;
                const f32x4 x0 = acc[ai][0][m][0] * sc, x1 = acc[ai][0][m][1] * sc, z0 = acc[ai][1][m][0] * sc, z1 = acc[ai][1][m][1] * sc;
                const unsigned xa = pk4_fp8(x0[0], x0[1], x0[2], x0[3]), xb = pk4_fp8(x1[0], x1[1], x1[2], x1[3]), za = pk4_fp8(z0[0], z0[1], z0[2], z0[3]), zb = pk4_fp8(z1[0], z1[1], z1[2], z1[3]);
                const auto r0 = __builtin_amdgcn_permlane16_swap(xa, za, false, false), r1 = __builtin_amdgcn_permlane16_swap(xb, zb, false, false);
                const u32x4 w = {r0[0], r1[0], r0[1], r1[1]};
                __builtin_nontemporal_store(w, (u32x4*)rowp); }
    }
};
struct EpiZ {
    static constexpr bool PERM = true;
    const float* resf; const bf16_t* resb; bf16_t* out;
    __device__ __forceinline__ void operator()(const f32x4 (&acc)[2][2][4][2], const pg8::Unit& u, int wr, int wc, int fr, int fq) const {
        const int col0 = u.pn * 256 + wc * 32 + 8 * fq;
#pragma unroll
        for (int ai = 0; ai < 2; ++ai)
#pragma unroll
            for (int mp = 0; mp < 2; ++mp) { f32x4 r[2][2][2];
#pragma unroll
                for (int mm = 0; mm < 2; ++mm) { const size_t off = (size_t)(u.m0 + ai * 128 + wr * 64 + (mp * 2 + mm) * 16 + fr) * DM + col0;
#pragma unroll
                    for (int bj = 0; bj < 2; ++bj) {
                        if (resf) { r[mm][bj][0] = *(const f32x4*)(resf + off + bj * 128); r[mm][bj][1] = *(const f32x4*)(resf + off + bj * 128 + 4); }
                        else { const u32x4 w = *(const u32x4*)(resb + off + bj * 128); r[mm][bj][0] = (f32x4){bf_lo(w.x), bf_hi(w.x), bf_lo(w.y), bf_hi(w.y)}; r[mm][bj][1] = (f32x4){bf_lo(w.z), bf_hi(w.z), bf_lo(w.w), bf_hi(w.w)}; } } }
#pragma unroll
                for (int mm = 0; mm < 2; ++mm) { const size_t off = (size_t)(u.m0 + ai * 128 + wr * 64 + (mp * 2 + mm) * 16 + fr) * DM + col0;
#pragma unroll
                    for (int bj = 0; bj < 2; ++bj) { const f32x4 z0 = r[mm][bj][0] * ALPHA + acc[ai][bj][mp * 2 + mm][0], z1 = r[mm][bj][1] * ALPHA + acc[ai][bj][mp * 2 + mm][1];
                        *(u32x4*)(out + off + bj * 128) = (u32x4){cvt_pk_bf16(z0[0], z0[1]), cvt_pk_bf16(z0[2], z0[3]), cvt_pk_bf16(z1[0], z1[1]), cvt_pk_bf16(z1[2], z1[3])}; } }
                asm volatile("" ::: "memory"); }
    }
};
struct EpiSwiGLU {
    static constexpr bool PERM = true;
    bf16_t* H; float sc; int f8;
    __device__ __forceinline__ void operator()(const f32x4 (&acc)[2][2][4][2], const pg8::Unit& u, int wr, int wc, int fr, int fq) const {
        const int col0 = u.pn * 128 + wc * 32 + 8 * fq;
#pragma unroll
        for (int ai = 0; ai < 2; ++ai)
#pragma unroll
            for (int m = 0; m < 4; ++m) { bf16_t* rowp = H + (size_t)(u.m0 + ai * 128 + wr * 64 + m * 16 + fr) * ED + col0;
                float h[8];
#pragma unroll
                for (int n = 0; n < 2; ++n)
#pragma unroll
                    for (int j = 0; j < 4; ++j) { const float g = acc[ai][0][m][n][j] * sc, up = acc[ai][1][m][n][j] * sc;
                        h[n * 4 + j] = g * __builtin_amdgcn_rcpf(1.f + __expf(-g)) * up; }
                if (f8) { *(u32x2*)((unsigned char*)H + (size_t)(u.m0 + ai * 128 + wr * 64 + m * 16 + fr) * ED + col0) = (u32x2){pk4_fp8(h[0], h[1], h[2], h[3]), pk4_fp8(h[4], h[5], h[6], h[7])}; }
                else { u32x4 w; w.x = cvt_pk_bf16(h[0], h[1]); w.y = cvt_pk_bf16(h[2], h[3]); w.z = cvt_pk_bf16(h[4], h[5]); w.w = cvt_pk_bf16(h[6], h[7]);
                *(u32x4*)rowp = w; } }
    }
};
struct EpiUp {
    static constexpr bool PERM = true;
    bf16_t* Q; bf16_t* Kb; bf16_t* V; const float* rstat; const f32x2* rope;
    __device__ __forceinline__ void operator()(const f32x4 (&acc)[2][2][4][2], const pg8::Unit& u, int wr, int wc, int fr, int fq) const {
        const int pn = u.pn;
        const float* rs = rstat + (pn < 16 ? 0 : T);
        float rsc[2][4];
#pragma unroll
        for (int ai = 0; ai < 2; ++ai)
#pragma unroll
            for (int m = 0; m < 4; ++m) rsc[ai][m] = rs[u.m0 + ai * 128 + wr * 64 + m * 16 + fr];
#pragma unroll
        for (int ai = 0; ai < 2; ++ai)
#pragma unroll
            for (int m = 0; m < 4; ++m) { const int row = u.m0 + ai * 128 + wr * 64 + m * 16 + fr; const float r = rsc[ai][m];
                if (pn < 24) {
#pragma unroll
                    for (int bj = 0; bj < 2; ++bj) { const f32x4 v0 = acc[ai][bj][m][0] * r, v1 = acc[ai][bj][m][1] * r;
                        u32x4 w; w.x = cvt_pk_bf16(v0[0], v0[1]); w.y = cvt_pk_bf16(v0[2], v0[3]); w.z = cvt_pk_bf16(v1[0], v1[1]); w.w = cvt_pk_bf16(v1[2], v1[3]);
                        const int d = wc * 32 + 8 * fq;
                        bf16_t* p;
                        if (pn < 8) p = Kb + (size_t)row * (NH * DQK) + (2 * pn + bj) * DQK + d;
                        else if (pn < 16) p = V + (size_t)row * DM + (pn - 8) * 256 + bj * 128 + d;
                        else p = Q + (size_t)row * (NH * DQK) + (2 * (pn - 16) + bj) * DQK + d;
                        *(u32x4*)p = w; }
                } else {
                    const int head = 4 * (pn - 24) + wc, i0 = 8 * fq, s = row & (SEQ - 1);
                    const f32x4* cs = (const f32x4*)(rope + (size_t)s * 32 + i0);
                    float o1[8], o2[8];
#pragma unroll
                    for (int q = 0; q < 4; ++q) { const f32x4 c2 = cs[q];
                        const int n = q >> 1, j = (q & 1) * 2;
                        const float x1a = acc[ai][0][m][n][j] * r, x2a = acc[ai][1][m][n][j] * r, x1b = acc[ai][0][m][n][j + 1] * r, x2b = acc[ai][1][m][n][j + 1] * r;
                        o1[2 * q] = x1a * c2[0] - x2a * c2[1]; o2[2 * q] = x2a * c2[0] + x1a * c2[1];
                        o1[2 * q + 1] = x1b * c2[2] - x2b * c2[3]; o2[2 * q + 1] = x2b * c2[2] + x1b * c2[3]; }
                    bf16_t* p = Q + (size_t)row * (NH * DQK) + head * DQK + 128 + i0;
                    u32x4 w; w.x = cvt_pk_bf16(o1[0], o1[1]); w.y = cvt_pk_bf16(o1[2], o1[3]); w.z = cvt_pk_bf16(o1[4], o1[5]); w.w = cvt_pk_bf16(o1[6], o1[7]);
                    *(u32x4*)p = w;
                    w.x = cvt_pk_bf16(o2[0], o2[1]); w.y = cvt_pk_bf16(o2[2], o2[3]); w.z = cvt_pk_bf16(o2[4], o2[5]); w.w = cvt_pk_bf16(o2[6], o2[7]);
                    *(u32x4*)(p + 32) = w;
                } }
    }
};

struct DenseSched {
    static constexpr bool FP8 = false;
    pg8::TileOrder ord; const char* A; const char* B; int lda_b, K; int mode;
    size_t agrp;
    __device__ __forceinline__ bool next(int i, pg8::Unit& u) const {
        int pm, pn; if (!ord.next(i, pm, pn)) return false;
        size_t ao = 0;
        if (mode == 1) ao = (size_t)(pn >> 1) * agrp; else if (mode == 2) ao = pn >= 16 ? 1024 : 0;
        u.A = A + ao + (size_t)pm * 256 * lda_b; u.B = B + (size_t)pn * 256 * K * 2; u.rows = nullptr; u.m0 = pm * 256; u.pn = pn; u.aux = 0;
        return true;
    }
};
template <bool F8_> struct MoeSchedT {
    static constexpr bool FP8 = F8_;
    const int* mte; const int* rowidx; const char* A; const char* W; int nunits, npn, G, c, gather; size_t wexp, wtile, atile; int i0, i1;
    __device__ __forceinline__ bool next(int i, pg8::Unit& u) const {
        if (i + i0 >= i1) return false;
        const int L = (i + i0) * G + c; if (L >= nunits) return false;
        const int mt = L / npn, pn = L - mt * npn; const int e = __builtin_amdgcn_readfirstlane(mte[mt]);
        u.A = gather ? A : A + (size_t)mt * atile; u.rows = gather ? rowidx + mt * 256 : nullptr;
        u.B = W + (size_t)e * wexp + (size_t)pn * wtile; u.m0 = mt * 256; u.pn = pn; u.aux = e;
        return true;
    }
};

typedef MoeSchedT<false> MoeSched;

namespace att {
constexpr int NW = 8, QBLK = 32, KVBLK = 64, QB = NW * QBLK;
constexpr int QS = NH * DQK, KS = NH * DQK, VS = DM, OS = DM;
constexpr int SHM_V = KVBLK * DV * 2, SHM_K = KVBLK * DQK * 2;
constexpr int ATT_LDS = 2 * SHM_V + 2 * SHM_K + NW * 64 * 4;
constexpr float SCALE = 0.07216878364870322f;
constexpr float THR = 8.f;
typedef LAS char* lptr;
#define KSWZ(row, colB) ((row) * 384 + ((colB) ^ ((((row) >> 1) & 7) << 4)))
#define SBAR() __builtin_amdgcn_sched_barrier(0)
__device__ __forceinline__ int v_st(int k, int c) { const int kk = (k & ~0xC) | ((k & 4) << 1) | ((k & 8) >> 1); return ((kk >> 3) * 4 + (c >> 5)) * 512 + ((kk & 7) * 32 + (c & 31)) * 2; }
__device__ __forceinline__ int v_rd_base(int lane) { return ((lane & 3) << 3) | (((lane >> 2) & 3) << 6) | (((lane >> 4) & 1) << 5) | (((lane >> 5) & 1) << 8); }
constexpr int v_rd_off(int d0, int ks, int half) { return d0 * 512 + ks * 4096 + half * 2048; }
__device__ __forceinline__ int crow(int r, int hi) { return (r & 3) + 8 * (r >> 2) + 4 * hi; }
__device__ __forceinline__ bf16x8 ld8(const bf16_t* p) { return *reinterpret_cast<const bf16x8*>(p); }
__device__ __forceinline__ void mask_tile(f32x16& p0, f32x16& p1, int dq) {
    const float NEG = -__builtin_inff();
#pragma unroll
    for (int r = 0; r < 16; ++r) {
        const int c = (r & 3) + 8 * (r >> 2);
        if (dq - c < 0) p0[r] = NEG;
        if (dq - c - 32 < 0) p1[r] = NEG;
    }
}
__device__ __forceinline__ void partialSM(f32x16& p0, f32x16& p1, float& m_reg, float& mn, float& alpha) {
    float pmax = p0[0];
#pragma unroll
    for (int r = 1; r < 16; ++r) pmax = fmaxf(pmax, p0[r]);
#pragma unroll
    for (int r = 0; r < 16; ++r) pmax = fmaxf(pmax, p1[r]);
    { auto rr = __builtin_amdgcn_permlane32_swap(__float_as_uint(pmax), __float_as_uint(pmax), false, false);
      pmax = fmaxf(__uint_as_float(rr[0]), __uint_as_float(rr[1])); }
    constexpr float C2 = 1.4426950408889634f * SCALE;
    if (__builtin_expect(__all((pmax - m_reg) * SCALE <= THR), 1)) { mn = m_reg; alpha = 1.f; }
    else { mn = fmaxf(m_reg, pmax); alpha = __builtin_amdgcn_exp2f((m_reg - mn) * C2); m_reg = mn; }
    const float mnL = -mn * C2;
#pragma unroll
    for (int r = 0; r < 16; ++r) p0[r] = fmaf(p0[r], C2, mnL);
#pragma unroll
    for (int r = 0; r < 16; ++r) p1[r] = fmaf(p1[r], C2, mnL);
#pragma unroll
    for (int r = 0; r < 16; ++r) p0[r] = __builtin_amdgcn_exp2f(p0[r]);
}
__device__ __forceinline__ void finishSM(f32x16& p0, f32x16& p1, float alpha, float& l_reg, bf16x8& pa0, bf16x8& pa1, bf16x8& pa2, bf16x8& pa3) {
#pragma unroll
    for (int r = 0; r < 16; ++r) p1[r] = __builtin_amdgcn_exp2f(p1[r]);
    float ps = 0;
#pragma unroll
    for (int r = 0; r < 16; ++r) ps += p0[r];
#pragma unroll
    for (int r = 0; r < 16; ++r) ps += p1[r];
    { auto rr = __builtin_amdgcn_permlane32_swap(__float_as_uint(ps), __float_as_uint(ps), false, false);
      ps = __uint_as_float(rr[0]) + __uint_as_float(rr[1]); }
    l_reg = l_reg * alpha + ps;
#define PK4(P, B_, OUT) do { unsigned a0 = cvt_pk_bf16(P[B_+0], P[B_+1]), a1 = cvt_pk_bf16(P[B_+2], P[B_+3]);                          \
        unsigned b0 = cvt_pk_bf16(P[B_+4], P[B_+5]), b1 = cvt_pk_bf16(P[B_+6], P[B_+7]);                                             \
        auto r0 = __builtin_amdgcn_permlane32_swap(a0, b0, false, false); auto r1 = __builtin_amdgcn_permlane32_swap(a1, b1, false, false); \
        u32x4 w = {r0[0], r1[0], r0[1], r1[1]}; OUT = *reinterpret_cast<bf16x8*>(&w); } while (0)
    PK4(p0, 0, pa0); PK4(p0, 8, pa1); PK4(p1, 0, pa2); PK4(p1, 8, pa3);
#undef PK4
}
template <int KB>
__device__ __forceinline__ void qkt(f32x16& p0, f32x16& p1, lptr K_lds, int r32, int hi, const bf16x8* qr) {
    p0 = f32x16{}; p1 = f32x16{};
    lptr kb[4];
#pragma unroll
    for (int dd = 0; dd < 4; ++dd) kb[dd] = K_lds + KB * SHM_K + KSWZ(r32, (dd * 16 + hi * 8) * 2);
#pragma unroll
    for (int d0 = 0; d0 < 12; ++d0) { lptr a = kb[d0 & 3] + (d0 >> 2) * 128;
        bf16x8 b0 = *reinterpret_cast<const LAS bf16x8*>(a);
        bf16x8 b1 = *reinterpret_cast<const LAS bf16x8*>(a + 32 * 384);
        p0 = __builtin_amdgcn_mfma_f32_32x32x16_bf16(b0, qr[d0], p0, 0, 0, 0);
        p1 = __builtin_amdgcn_mfma_f32_32x32x16_bf16(b1, qr[d0], p1, 0, 0, 0); }
}
template <int VB>
__device__ __forceinline__ void pv_tile(f32x16* o, int vb0, bf16x8 pa0, bf16x8 pa1, bf16x8 pa2, bf16x8 pa3) {
#define TRRD(dst, off) asm volatile("ds_read_b64_tr_b16 %0, %1 offset:%2" : "=&v"(dst) : "v"(vb0), "i"(off) : "memory")
#define PV_D0(d0) do { s16x4 l0, l1, l2, l3, h0, h1, h2, h3; constexpr int b_ = VB * SHM_V + v_rd_off(d0, 0, 0); \
        TRRD(l0, b_); TRRD(h0, b_ + 2048); TRRD(l1, b_ + 4096); TRRD(h1, b_ + 6144); TRRD(l2, b_ + 8192); TRRD(h2, b_ + 10240); TRRD(l3, b_ + 12288); TRRD(h3, b_ + 14336); \
        asm volatile("s_waitcnt lgkmcnt(0)" ::: "memory"); SBAR();   \
        o[d0] = __builtin_amdgcn_mfma_f32_32x32x16_bf16(pa0, (bf16x8){l0[0], l0[1], l0[2], l0[3], h0[0], h0[1], h0[2], h0[3]}, o[d0], 0, 0, 0);   \
        o[d0] = __builtin_amdgcn_mfma_f32_32x32x16_bf16(pa1, (bf16x8){l1[0], l1[1], l1[2], l1[3], h1[0], h1[1], h1[2], h1[3]}, o[d0], 0, 0, 0);   \
        o[d0] = __builtin_amdgcn_mfma_f32_32x32x16_bf16(pa2, (bf16x8){l2[0], l2[1], l2[2], l2[3], h2[0], h2[1], h2[2], h2[3]}, o[d0], 0, 0, 0);   \
        o[d0] = __builtin_amdgcn_mfma_f32_32x32x16_bf16(pa3, (bf16x8){l3[0], l3[1], l3[2], l3[3], h3[0], h3[1], h3[2], h3[3]}, o[d0], 0, 0, 0); } while (0)
    PV_D0(0); PV_D0(1); PV_D0(2); PV_D0(3);
#undef PV_D0
#undef TRRD
}
struct BlockRef { const bf16_t* Q; const bf16_t* K; const bf16_t* V; bf16_t* O; int P0; };
struct Seam { bf16x8 qr[12]; };
#define VMW() asm volatile("s_waitcnt vmcnt(0)" ::: "memory")
#define VMWN(n) asm volatile("s_waitcnt vmcnt(%0)" :: "i"(n) : "memory")
#define SLOAD_H(Kp, Vp, k0) do { st_v0 = ld8((Vp) + (size_t)((k0) + sr) * VS + sc); st_v1 = ld8((Vp) + (size_t)((k0) + 32 + sr) * VS + sc); \
        const bf16_t* kp_ = (Kp) + (size_t)((k0) + krow) * KS + kc8; st_k0 = ld8(kp_); st_k1 = ld8(kp_ + 64); st_k2 = ld8(kp_ + 128); } while (0)
#define SWRITE_H(bf) do { lptr kd_ = K_lds + (bf) * SHM_K + kws; *(LAS bf16x8*)kd_ = st_k0; *(LAS bf16x8*)(kd_ + 128) = st_k1; *(LAS bf16x8*)(kd_ + 256) = st_k2; \
        *(LAS bf16x8*)(V_lds + (bf) * SHM_V + vst0) = st_v0; *(LAS bf16x8*)(V_lds + (bf) * SHM_V + vst1) = st_v1; } while (0)
__device__ __forceinline__ void attn_prime(const BlockRef& cur, lptr lds, Seam& S) {
    const int tid = threadIdx.x, wid = __builtin_amdgcn_readfirstlane(tid >> 6), lane = tid & 63, r32 = lane & 31, hi = lane >> 5;
    const int sr = tid >> 4, sc = (tid & 15) * 8, vst0 = v_st(sr, sc), vst1 = v_st(32 + sr, sc), krow = tid >> 3, kc8 = (tid & 7) * 8, kws = KSWZ(krow, (tid & 7) * 16);
    lptr V_lds = lds; lptr K_lds = lds + 2 * SHM_V;
    bf16x8 st_v0, st_v1, st_k0, st_k1, st_k2;
#pragma unroll
    for (int d0 = 0; d0 < 12; ++d0) S.qr[d0] = ld8(cur.Q + (size_t)(wid * QBLK + r32) * QS + d0 * 16 + hi * 8);
    SLOAD_H(cur.K, cur.V, 0); VMW(); SWRITE_H(0);
    __syncthreads();
}
__device__ __forceinline__ void attn_block(const BlockRef& cur, const BlockRef& nxt, lptr lds, Seam& S) {
    const int tid = threadIdx.x, wid = __builtin_amdgcn_readfirstlane(tid >> 6), lane = tid & 63, r32 = lane & 31, hi = lane >> 5;
    const int NT = cur.P0 / KVBLK + QB / KVBLK;
    const int qlo = cur.P0 + wid * QBLK, qm = qlo + r32 - 4 * hi;
    lptr V_lds = lds; lptr K_lds = lds + 2 * SHM_V;
    LAS float* ws = (LAS float*)(lds + 2 * SHM_V + 2 * SHM_K) + wid * 64; LAS float* li_l = ws; LAS float* al_l = ws + 32;
    float m_reg = -1e30f, l_reg = 0; f32x16 o[4] = {};
    const int sr = tid >> 4, sc = (tid & 15) * 8, vst0 = v_st(sr, sc), vst1 = v_st(32 + sr, sc);
    const int krow = tid >> 3, kc8 = (tid & 7) * 8, kws = KSWZ(krow, (tid & 7) * 16);
    const int vb0 = (int)(unsigned)(uintptr_t)V_lds + v_rd_base(lane);
    const bf16_t* Kh = cur.K; const bf16_t* Vh = cur.V;
    bf16x8 st_v0, st_v1, st_k0, st_k1, st_k2;
#define RESC(a) do { if (__any((a) < 1.f)) { if (hi == 0) al_l[r32] = (a); asm volatile("s_waitcnt lgkmcnt(0)" ::: "memory");              \
                     _Pragma("unroll") for (int d_ = 0; d_ < 4; ++d_) _Pragma("unroll") for (int r = 0; r < 16; ++r) o[d_][r] *= al_l[crow(r, hi)]; } } while (0)
#define MASKT(P0_, P1_, t) do { const int kb_ = (t) * KVBLK; if (kb_ + KVBLK - 1 > qlo) mask_tile(P0_, P1_, qm - kb_); } while (0)
#define STEP(t, BF) do { f32x16 p0, p1; float mn, al; bf16x8 pa0, pa1, pa2, pa3;                                     \
        const bool lastt = (t) + 1 == NT;                                                                               \
        if (!lastt) { SLOAD_H(Kh, Vh, ((t) + 1) * KVBLK); } else { SLOAD_H(nxt.K, nxt.V, 0); }                          \
        SBAR(); qkt<BF>(p0, p1, K_lds, r32, hi, S.qr); SBAR();                                                         \
        if (lastt) { _Pragma("unroll") for (int d0 = 0; d0 < 12; ++d0) S.qr[d0] = ld8(nxt.Q + (size_t)(wid * QBLK + r32) * QS + d0 * 16 + hi * 8); SBAR(); } \
        MASKT(p0, p1, (t)); partialSM(p0, p1, m_reg, mn, al); RESC(al);                                                \
        finishSM(p0, p1, al, l_reg, pa0, pa1, pa2, pa3); SBAR();                                                       \
        pv_tile<BF>(o, vb0, pa0, pa1, pa2, pa3); SBAR();                                                               \
        if (lastt) { VMWN(12); SWRITE_H(0); } else { VMW(); SWRITE_H(1 - (BF)); }                                       \
        if (!lastt) __syncthreads(); } while (0)
    for (int t = 0; t < NT; t += 2) { STEP(t, 0); STEP(t + 1, 1); }
    if (hi == 0) li_l[r32] = l_reg; asm volatile("s_waitcnt lgkmcnt(0)" ::: "memory");
    float rli[16];
#pragma unroll
    for (int r = 0; r < 16; ++r) rli[r] = __builtin_amdgcn_rcpf(li_l[crow(r, hi)]);
    bf16_t* Ow = cur.O + (size_t)(wid * QBLK) * OS;
#pragma unroll
    for (int r = 0; r < 16; ++r) { const int orow = crow(r, hi);
#pragma unroll
        for (int d0 = 0; d0 < 4; ++d0) { const float v = o[d0][r] * rli[r];
            const float vn = __shfl_xor(v, 1);
            if ((r32 & 1) == 0) *(unsigned*)(Ow + (size_t)orow * OS + d0 * 32 + r32) = cvt_pk_bf16(v, vn); } }
    __syncthreads();
#undef RESC
#undef MASKT
#undef STEP
}
#undef VMW
#undef VMWN
#undef SLOAD_H
#undef SWRITE_H
#undef KSWZ
#undef SBAR
__device__ __forceinline__ BlockRef make_ref(int L, int pass, const bf16_t* Q, const bf16_t* K, const bf16_t* V, bf16_t* O) {
    const int bh = L >> 3, x = L & 7, qb = pass ? 15 - x : x, b = bh >> 4, h = bh & 15;
    BlockRef r; const size_t row0 = (size_t)b * SEQ;
    r.Q = Q + (row0 + (size_t)qb * QB) * QS + h * DQK; r.O = O + (row0 + (size_t)qb * QB) * OS + h * DV;
    r.K = K + row0 * KS + h * DQK; r.V = V + row0 * VS + h * DV; r.P0 = qb * QB;
    return r;
}
template <class Hook>
__device__ __forceinline__ void attn_phase(lptr lds, const bf16_t* Q, const bf16_t* K, const bf16_t* V, bf16_t* O, int vcu, int G, const Hook& hook) {
    constexpr int TOTAL = NBATCH * NH * 8;
    const int slot = (vcu >> 5) % 3;
    int L = vcu; if (L >= TOTAL) { hook(); return; }
    if (slot == 0) hook();
    int pass = 0, nblk = 0;
    BlockRef cur = make_ref(L, 0, Q, K, V, O);
    Seam S;
    attn_prime(cur, lds, S);
    for (;;) {
        const bool more_pass = pass == 0, more_item = L + G < TOTAL, last = !more_pass && !more_item;
        int passn = pass + 1, Ln = L;
        if (!more_pass) { passn = 0; Ln = more_item ? L + G : L; }
        const BlockRef nxt = last ? cur : make_ref(Ln, passn, Q, K, V, O);
        attn_block(cur, nxt, lds, S);
        ++nblk;
        if (nblk == 1 && slot == 1) hook();
        if (last) break;
        cur = nxt; pass = passn; L = Ln;
    }
    if (slot == 2 || (slot == 1 && nblk < 1)) hook();
}
}

struct KArgs { const float* in[25]; float* out; unsigned char* ws; int ph_lo, ph_hi; };
enum { I_X = 0, I_AWIN, I_AWGRP, I_ASCALE, I_AWOUT, I_KVWD, I_KVNORM, I_KVWUK, I_KVWUV, I_BWDQ, I_BQNORM, I_BWUQ, I_BWOUT, I_LN1G, I_LN1B, I_LN2G, I_LN2B,
       I_RW, I_RB, I_EWG, I_EWU, I_EWD, I_SWG, I_SWU, I_SWD };

__device__ __forceinline__ void tr_item(const float* W, int ldw, int k0, int n0, bf16_t* WT, int K, int drow0, const float* kscale, LAS float* scr, int lane) {
    const int c = lane & 7;
    f32x4 sa = {1.f, 1.f, 1.f, 1.f}, sb = sa;
    if (kscale) { sa = *(const f32x4*)(kscale + k0 + 8 * c); sb = *(const f32x4*)(kscale + k0 + 8 * c + 4); }
#pragma unroll 8
    for (int i = 0; i < 32; ++i) { const int kk = 2 * i + (lane >> 5); scr[kk * 33 + (lane & 31)] = W[(size_t)(k0 + kk) * ldw + n0 + (lane & 31)]; }
    LDS_WAIT(); asm volatile("" ::: "memory");
#pragma unroll
    for (int j = 0; j < 4; ++j) { const int n = (lane >> 3) + 8 * j; const LAS float* sp = scr + (8 * c) * 33 + n;
        u32x4 o; o.x = cvt_pk_bf16(sp[0 * 33] * sa[0], sp[1 * 33] * sa[1]); o.y = cvt_pk_bf16(sp[2 * 33] * sa[2], sp[3 * 33] * sa[3]); o.z = cvt_pk_bf16(sp[4 * 33] * sb[0], sp[5 * 33] * sb[1]); o.w = cvt_pk_bf16(sp[6 * 33] * sb[2], sp[7 * 33] * sb[3]);
        *(u32x4*)(WT + (size_t)(drow0 + n) * K + k0 + 8 * c) = o; }
    LDS_WAIT(); asm volatile("" ::: "memory");
}
struct TrItem { const float* src; bf16_t* dst; int ldw, Kd, k0, n0, gu, p; };
__device__ __forceinline__ void bg_decode(const KArgs& a, int kind  , int l, int it, TrItem& I) {
    unsigned char* ws = a.ws;
    if (kind == 0 || kind == 2) { const int e = it >> 9, q = it & 511, up = q >> 8, qq = q & 255;
        I.src = e < 64 ? a.in[up ? I_EWU : I_EWG] + (size_t)(l * 64 + e) * 2048 * 512 : a.in[up ? I_SWU : I_SWG] + (size_t)l * 2048 * 512;
        I.ldw = 512; I.k0 = (qq >> 3) * 64; I.n0 = (qq & 7) * 64; I.dst = (bf16_t*)(ws + WS_WGU + (size_t)l * 65 * 1024 * 2048 * 2 + (size_t)e * 1024 * 2048 * (kind == 2 ? 1 : 2)); I.Kd = 2048; I.gu = 1; I.p = up ? 128 : 0;
    } else { const int e = it >> 8, qq = it & 255;
        I.src = e < 64 ? a.in[I_EWD] + (size_t)(l * 64 + e) * 512 * 2048 : a.in[I_SWD] + (size_t)l * 512 * 2048;
        I.ldw = 2048; I.k0 = (qq >> 5) * 64; I.n0 = (qq & 31) * 64; I.dst = (bf16_t*)(ws + WS_WD + (size_t)l * 65 * 2048 * 512 * 2 + (size_t)e * 2048 * 512 * (kind == 3 ? 1 : 2)); I.Kd = 512; I.gu = 0; I.p = 0; }
}
__device__ __forceinline__ void bg_load(const TrItem& I, f32x4 (&v)[16], int lane) {
    const float* p = I.src + (size_t)(I.k0 + 16 * (lane >> 4)) * I.ldw + I.n0 + 4 * (lane & 15);
#pragma unroll
    for (int i = 0; i < 16; ++i) v[i] = __builtin_nontemporal_load((const f32x4*)(p + (size_t)i * I.ldw));
}
__device__ __forceinline__ void bg_emit(const TrItem& I, const f32x4 (&v)[16], LAS unsigned* scr, int lane) {
    const int n4 = lane & 15, kq = lane >> 4;
#pragma unroll
    for (int q = 0; q < 4; ++q)
#pragma unroll
        for (int h = 0; h < 2; ++h) { u32x4 o; o.x = cvt_pk_bf16(v[8 * h + 0][q], v[8 * h + 1][q]); o.y = cvt_pk_bf16(v[8 * h + 2][q], v[8 * h + 3][q]); o.z = cvt_pk_bf16(v[8 * h + 4][q], v[8 * h + 5][q]); o.w = cvt_pk_bf16(v[8 * h + 6][q], v[8 * h + 7][q]);
            *(LAS u32x4*)(scr + (4 * n4 + q) * 36 + 8 * kq + 4 * h) = o; }
    LDS_WAIT(); asm volatile("" ::: "memory");
    const int c = lane & 7;
#pragma unroll
    for (int jj = 0; jj < 8; ++jj) { const int r = (lane >> 3) + 8 * jj, n = I.n0 + r; const u32x4 o = *(const LAS u32x4*)(scr + r * 36 + 4 * c);
        const int drow = I.gu ? (n >> 7) * 256 + I.p + (n & 127) : n;
        *(u32x4*)(I.dst + (size_t)drow * I.Kd + I.k0 + 8 * c) = o; }
    LDS_WAIT(); asm volatile("" ::: "memory");
}
__device__ __forceinline__ void bg_emit8(const TrItem& I, const f32x4 (&v)[16], LAS unsigned* scr, int lane) {
    const int n4 = lane & 15, kq = lane >> 4;
#pragma unroll
    for (int q = 0; q < 4; ++q) { u32x4 o;
        o.x = pk4_fp8(v[0][q] * W8_SCALE, v[1][q] * W8_SCALE, v[2][q] * W8_SCALE, v[3][q] * W8_SCALE); o.y = pk4_fp8(v[4][q] * W8_SCALE, v[5][q] * W8_SCALE, v[6][q] * W8_SCALE, v[7][q] * W8_SCALE);
        o.z = pk4_fp8(v[8][q] * W8_SCALE, v[9][q] * W8_SCALE, v[10][q] * W8_SCALE, v[11][q] * W8_SCALE); o.w = pk4_fp8(v[12][q] * W8_SCALE, v[13][q] * W8_SCALE, v[14][q] * W8_SCALE, v[15][q] * W8_SCALE);
        *(LAS u32x4*)(scr + (4 * n4 + q) * 20 + 4 * kq) = o; }
    LDS_WAIT(); asm volatile("" ::: "memory");
    const int c = lane & 3;
#pragma unroll
    for (int jj = 0; jj < 4; ++jj) { const int r = (lane >> 2) + 16 * jj, n = I.n0 + r; const u32x4 o = *(const LAS u32x4*)(scr + r * 20 + 4 * c);
        const int drow = I.gu ? (n >> 7) * 256 + I.p + (n & 127) : n;
        *(u32x4*)((unsigned char*)I.dst + (size_t)drow * I.Kd + I.k0 + 16 * c) = o; }
    LDS_WAIT(); asm volatile("" ::: "memory");
}
__device__ __forceinline__ void bg_convert_range(const KArgs& a, LAS unsigned char* lds, int kind, int l, int lo, int hi, int wave, int lane, int scr_off = 0, int scr_stride = 16384) {
    LAS unsigned* scr = (LAS unsigned*)(lds + scr_off + wave * scr_stride);
    TrItem A, B; f32x4 va[16], vb[16];
    int it = lo + wave;
    if (it < hi) { bg_decode(a, kind, l, it, A); bg_load(A, va, lane); }
#pragma unroll 1
    while (it < hi) {
        const int i1 = it + 8, i2 = it + 16;
        if (i1 < hi) { bg_decode(a, kind, l, i1, B); bg_load(B, vb, lane); }
        if (kind >= 2) bg_emit8(A, va, scr, lane); else bg_emit(A, va, scr, lane);
        if (i1 >= hi) break;
        if (i2 < hi) { bg_decode(a, kind, l, i2, A); bg_load(A, va, lane); }
        if (kind >= 2) bg_emit8(B, vb, scr, lane); else bg_emit(B, vb, scr, lane);
        it = i2;
    }
    VM_WAIT(); __syncthreads();
}
__device__ __forceinline__ void bg_share(int first, int last, int c, int G, int n_extra, int U, int& lo, int& hi) {
    const int N = last - first; int n_lo = (N + n_extra * U + G - 1) / G, n_hi = n_lo - U;
    if (n_hi < 0) { n_hi = 0; n_lo = (N + (G - n_extra) - 1) / (G - n_extra); }
    lo = first + (c < n_extra ? c * n_hi : n_extra * n_hi + (c - n_extra) * n_lo); hi = lo + (c < n_extra ? n_hi : n_lo);
    if (lo > last) lo = last; if (hi > last) hi = last;
}
__device__ __forceinline__ void bg_convert(const KArgs& a, LAS unsigned char* lds, int kind, int l, int vcu, int G, int wave, int lane) {
    const int NIT = (kind == 0 || kind == 2) ? 65 * 512 : 65 * 256, per = (NIT + G - 1) / G; const int lo = vcu * per, hi = lo + per < NIT ? lo + per : NIT;
    bg_convert_range(a, lds, kind, l, lo < NIT ? lo : NIT, hi, wave, lane);
}
__device__ __forceinline__ void phase_prologue(const KArgs& a, LAS unsigned char* lds, int vcu, int G, int wave, int lane) {
    unsigned char* ws = a.ws;
    LAS float* scr = (LAS float*)(lds + wave * 16384);
    const int gw = vcu * 8 + wave, NGW = G * 8;
    constexpr int C_IN = 2048, C_GRP = 512, C_OUT = 2048, C_KVD = 576, C_DQ = 512, C_UK = 512, C_UV = 512, C_UQ = 768, C_BO = 2048;
    constexpr int C_SMALL = C_IN + C_GRP + C_OUT + C_KVD + C_DQ + C_UK + C_UV + C_UQ + C_BO;
    constexpr int NITEMS = C_SMALL;
    for (int it = gw; it < NITEMS; it += NGW) {
        int r = it;
        if (r < C_IN) { tr_item(a.in[I_AWIN], 2048, (r / 64) * 64, (r % 64) * 32, (bf16_t*)(ws + WS_WIN), 2048, (r % 64) * 32, nullptr, scr, lane); continue; } r -= C_IN;
        if (r < C_GRP) { const int g = r / 128, q = r % 128; tr_item(a.in[I_AWGRP] + (size_t)g * 512 * 512, 512, (q / 16) * 64, (q % 16) * 32, (bf16_t*)(ws + WS_WGRP), 512, g * 512 + (q % 16) * 32, nullptr, scr, lane); continue; } r -= C_GRP;
        if (r < C_OUT) { tr_item(a.in[I_AWOUT], 2048, (r / 64) * 64, (r % 64) * 32, (bf16_t*)(ws + WS_WOUT), 2048, (r % 64) * 32, nullptr, scr, lane); continue; } r -= C_OUT;
        if (r < C_KVD) { const int n0 = (r % 18) * 32; tr_item(a.in[I_KVWD], 576, (r / 18) * 64, n0, (bf16_t*)(ws + WS_WKVQ), 2048, n0 < 512 ? n0 : 1024 + (n0 - 512), nullptr, scr, lane); continue; } r -= C_KVD;
        if (r < C_DQ) { const int n0 = (r % 16) * 32; tr_item(a.in[I_BWDQ], 512, (r / 16) * 64, n0, (bf16_t*)(ws + WS_WKVQ), 2048, 512 + n0, nullptr, scr, lane); continue; } r -= C_DQ;
        if (r < C_UK) { const int n0 = (r % 64) * 32; tr_item(a.in[I_KVWUK], 2048, (r / 64) * 64, n0, (bf16_t*)(ws + WS_WUP), 512, n0, a.in[I_KVNORM], scr, lane); continue; } r -= C_UK;
        if (r < C_UV) { const int n0 = (r % 64) * 32; tr_item(a.in[I_KVWUV], 2048, (r / 64) * 64, n0, (bf16_t*)(ws + WS_WUP), 512, 2048 + n0, a.in[I_KVNORM], scr, lane); continue; } r -= C_UV;
        if (r < C_UQ) { const int n0 = (r % 96) * 32, h = n0 / 192, d0 = n0 % 192;
            const int drow = d0 < 128 ? 4096 + h * 128 + d0 : 6144 + (h >> 2) * 256 + (d0 >= 160 ? 128 : 0) + (h & 3) * 32;
            tr_item(a.in[I_BWUQ], 3072, (r / 96) * 64, n0, (bf16_t*)(ws + WS_WUP), 512, drow, a.in[I_BQNORM], scr, lane); continue; } r -= C_UQ;
        tr_item(a.in[I_BWOUT], 2048, (r / 64) * 64, (r % 64) * 32, (bf16_t*)(ws + WS_WBO), 2048, (r % 64) * 32, nullptr, scr, lane);
    }
    bg_convert(a, lds, L0F8 == 2 ? 2 : 0, 0, vcu, G, wave, lane);
    const int gtid = gw * 64 + lane, NGT = NGW * 64;
    for (int i = gtid; i < 192 * 2048 * 2 / 16; i += NGT) ((u32x4*)(ws + WS_WKVQ + (size_t)1088 * 2048 * 2))[i] = (u32x4){0u, 0u, 0u, 0u};
    for (int i = gtid; i < SEQ * 32; i += NGT) { const int s = i >> 5, j = i & 31;
        const float inv = 1.0f / powf(10000.0f, (float)(2 * j) / 64.0f); const float ang = (float)s * inv;
        double rev = (double)ang * 0.15915494309189535; rev -= floor(rev); const float fr = (float)rev;
        ((f32x2*)(ws + WS_ROPE))[i] = (f32x2){__builtin_amdgcn_cosf(fr), __builtin_amdgcn_sinf(fr)}; }
    for (int i = gtid; i < 2 * DM * 64; i += NGT) { const int l = i / (DM * 64), rem = i - l * (DM * 64), d = rem >> 6, e = rem & 63;
        const float w = a.in[I_RW][i] * a.in[I_LN1G][l * DM + d]; const unsigned h = cvt_pk_bf16(w, 0.f) & 0xffffu; const float wl = w - __uint_as_float(h << 16);
        ((bf16_t*)(ws + WS_RWHI))[((size_t)l * 64 + e) * DM + d] = (bf16_t)h; ((bf16_t*)(ws + WS_RWLO))[((size_t)l * 64 + e) * DM + d] = (bf16_t)(cvt_pk_bf16(wl, 0.f) & 0xffffu); }
    for (int i = gw; i < 2 * 64; i += NGW) { const int l = i / 64, e = i % 64; float c1 = 0.f, c2 = 0.f;
#pragma unroll 16
        for (int d = lane; d < DM; d += 64) { const float w = a.in[I_RW][((size_t)l * DM + d) * 64 + e]; c1 += a.in[I_LN1G][l * DM + d] * w; c2 += a.in[I_LN1B][l * DM + d] * w; }
        c1 = wave_sum(c1); c2 = wave_sum(c2);
        if (lane == 0) { ((float*)(ws + WS_RC))[l * 64 + e] = c1; ((float*)(ws + WS_RC))[128 + l * 64 + e] = c2; } }
    const float* x = a.in[I_X];
    for (int task = gtid; task < NCHUNK * 512; task += NGT) {
        const int c4 = task & 511, t0 = (task >> 9) * 32, s0 = t0 & (SEQ - 1);
        const float* xc = x + c4 * 4;
        f32x4 w[32];
#pragma unroll
        for (int j = 0; j < 16; ++j) w[j] = s0 > 0 ? *(const f32x4*)(xc + (size_t)(t0 - 16 + j) * DM) : (f32x4){0.f, 0.f, 0.f, 0.f};
        f32x4 S2 = w[14] + w[15], S4 = (w[12] + w[13]) + S2, S8 = ((w[8] + w[9]) + (w[10] + w[11])) + S4, S16 = (((w[0] + w[1]) + (w[2] + w[3])) + ((w[4] + w[5]) + (w[6] + w[7]))) + S8;
#pragma unroll 1
        for (int hb = 0; hb < 2; ++hb) { const int tb = t0 + 16 * hb, sb0 = s0 + 16 * hb;
#pragma unroll
            for (int j = 0; j < 16; ++j) w[16 + j] = *(const f32x4*)(xc + (size_t)(tb + j) * DM);
#pragma unroll
            for (int j = 0; j < 16; ++j) { const int sq = sb0 + j; const f32x4 v = w[16 + j];
                S2 += v - w[16 + j - 2]; S4 += v - w[16 + j - 4]; S8 += v - w[16 + j - 8]; S16 += v - w[j];
                const float n2 = 1.f / (float)(sq + 1 < 2 ? sq + 1 : 2), n4 = 1.f / (float)(sq + 1 < 4 ? sq + 1 : 4), n8 = 1.f / (float)(sq + 1 < 8 ? sq + 1 : 8), n16 = 1.f / (float)(sq + 1 < 16 ? sq + 1 : 16);
                const f32x4 o2 = S2 * n2 - v, o4 = S4 * n4 - v, o8 = S8 * n8 - v, o16 = S16 * n16 - v;
                bf16_t* xp = (bf16_t*)(ws + WS_XP) + (size_t)(tb + j) * DM + c4 * 4;
                *(u32x2*)(xp) = (u32x2){cvt_pk_bf16(o2[0], o2[1]), cvt_pk_bf16(o2[2], o2[3])};
                *(u32x2*)(xp + (size_t)T * DM) = (u32x2){cvt_pk_bf16(o4[0], o4[1]), cvt_pk_bf16(o4[2], o4[3])};
                *(u32x2*)(xp + (size_t)2 * T * DM) = (u32x2){cvt_pk_bf16(o8[0], o8[1]), cvt_pk_bf16(o8[2], o8[3])};
                *(u32x2*)(xp + (size_t)3 * T * DM) = (u32x2){cvt_pk_bf16(o16[0], o16[1]), cvt_pk_bf16(o16[2], o16[3])}; }
#pragma unroll
            for (int j = 0; j < 16; ++j) w[j] = w[16 + j]; }
    }
}

__device__ __forceinline__ void route_token(float score, float choice, int lane, bool& sel, float& gate) {
    int cnt = 0;
#pragma unroll
    for (int o = 1; o < 8; ++o) { const float oc = __shfl_xor(choice, o); const int j = lane ^ o; cnt += (oc > choice || (oc == choice && j < lane)) ? 1 : 0; }
    float gs = cnt < 2 ? choice : 0.f;
    gs += __shfl_xor(gs, 1); gs += __shfl_xor(gs, 2); gs += __shfl_xor(gs, 4);
    int gcnt = 0;
#pragma unroll
    for (int o = 8; o < 64; o += 8) { const float og = __shfl_xor(gs, o); const int gj = (lane ^ o) >> 3; gcnt += (og > gs || (og == gs && gj < (lane >> 3))) ? 1 : 0; }
    const bool gsel = gcnt < 4;
    float cur = gsel ? choice : -__builtin_inff();
    unsigned long long selmask = 0ull;
#pragma unroll 1
    for (int it = 0; it < 8; ++it) { float m = cur;
#pragma unroll
        for (int o = 1; o < 64; o <<= 1) m = fmaxf(m, __shfl_xor(m, o));
        const unsigned long long b = __ballot(cur == m); const int w = __ffsll((long long)b) - 1;
        selmask |= 1ull << w; if (lane == w) cur = -__builtin_inff(); }
    sel = ((selmask >> lane) & 1ull) != 0ull;
    const float ssum = wave_sum(sel ? score : 0.f);
    gate = score / ssum * 2.5f;
}
__device__ __forceinline__ void phase_r1(const KArgs& a, LAS unsigned char* lds, int l, int G, int wave, int lane) {
    unsigned char* ws = a.ws;
    const bf16_t* z = (const bf16_t*)(ws + WS_Z);
    LAS float* P = (LAS float*)lds;
    LAS float* SX = (LAS float*)(lds + 65536);
    LAS unsigned long long* MK = (LAS unsigned long long*)(lds + 65536 + 2048);
    LAS float* ST = (LAS float*)(lds + 65536 + 2048 + 256);
    const int r32 = lane & 31, hi = lane >> 5;
    const float* c1 = (const float*)(ws + WS_RC) + l * 64; const float* c2 = (const float*)(ws + WS_RC) + 128 + l * 64;
    const float* rbias = a.in[I_RB] + l * 64;
    const float* g1 = a.in[I_LN1G] + l * DM; const float* b1 = a.in[I_LN1B] + l * DM;
    int* toke = (int*)(ws + WS_TOKE); float* tokg = (float*)(ws + WS_TOKG); int* cntp = (int*)(ws + WS_CNT);
    bf16_t* x1h = (bf16_t*)(ws + WS_X1F); bf16_t* x1b = (bf16_t*)(ws + WS_X1B);
    for (int ch = blockIdx.x; ch < NCHUNK; ch += G) {
        const int row0 = ch * 32;
        {
            f32x16 acc0 = {}, acc1 = {}; float s1 = 0.f, s2 = 0.f;
            const bf16_t* zr = z + (size_t)(row0 + r32) * DM + 256 * wave + 8 * hi;
            const bf16_t* bh = (const bf16_t*)(ws + WS_RWHI) + ((size_t)l * 64 + r32) * DM + 256 * wave + 8 * hi;
            const bf16_t* bl = (const bf16_t*)(ws + WS_RWLO) + ((size_t)l * 64 + r32) * DM + 256 * wave + 8 * hi;
#pragma unroll 4
            for (int kk = 0; kk < 16; ++kk) {
                const u32x4 zw = *(const u32x4*)(zr + 16 * kk);
                const f32x4 va = {bf_lo(zw.x), bf_hi(zw.x), bf_lo(zw.y), bf_hi(zw.y)}, vb = {bf_lo(zw.z), bf_hi(zw.z), bf_lo(zw.w), bf_hi(zw.w)};
                s1 += (va[0] + va[1]) + (va[2] + va[3]) + (vb[0] + vb[1]) + (vb[2] + vb[3]);
                s2 += (va[0] * va[0] + va[1] * va[1]) + (va[2] * va[2] + va[3] * va[3]) + (vb[0] * vb[0] + vb[1] * vb[1]) + (vb[2] * vb[2] + vb[3] * vb[3]);
                const bf16x8 ah = __builtin_bit_cast(bf16x8, zw);
                const bf16x8 bh0 = *(const bf16x8*)(bh + 16 * kk), bh1 = *(const bf16x8*)(bh + (size_t)32 * DM + 16 * kk);
                const bf16x8 bl0 = *(const bf16x8*)(bl + 16 * kk), bl1 = *(const bf16x8*)(bl + (size_t)32 * DM + 16 * kk);
                acc0 = __builtin_amdgcn_mfma_f32_32x32x16_bf16(ah, bh0, acc0, 0, 0, 0); acc0 = __builtin_amdgcn_mfma_f32_32x32x16_bf16(ah, bl0, acc0, 0, 0, 0);
                acc1 = __builtin_amdgcn_mfma_f32_32x32x16_bf16(ah, bh1, acc1, 0, 0, 0); acc1 = __builtin_amdgcn_mfma_f32_32x32x16_bf16(ah, bl1, acc1, 0, 0, 0);
            }
#pragma unroll
            for (int r = 0; r < 16; ++r) { const int tk = (r & 3) + 8 * (r >> 2) + 4 * hi; P[(wave * 32 + tk) * 64 + r32] = acc0[r]; P[(wave * 32 + tk) * 64 + 32 + r32] = acc1[r]; }
            s1 += __shfl_xor(s1, 32); s2 += __shfl_xor(s2, 32);
            if (hi == 0) { SX[(wave * 32 + r32) * 2] = s1; SX[(wave * 32 + r32) * 2 + 1] = s2; }
        }
        __syncthreads();
#pragma unroll 1
        for (int j = 0; j < 4; ++j) { const int i = 4 * wave + j, t = row0 + i;
            float dot = 0.f, S1 = 0.f, S2 = 0.f;
#pragma unroll
            for (int w = 0; w < 8; ++w) { dot += P[(w * 32 + i) * 64 + lane]; S1 += SX[(w * 32 + i) * 2]; S2 += SX[(w * 32 + i) * 2 + 1]; }
            const float mu = S1 * (1.f / DM), var = S2 * (1.f / DM) - mu * mu, rstd = 1.f / sqrtf(var + LN_EPS);
            const float logit = rstd * (dot - mu * c1[lane]) + c2[lane];
            const float score = 1.f / (1.f + __expf(-logit));
            const float choice = score + rbias[lane];
            bool sel; float gate; route_token(score, choice, lane, sel, gate);
            const unsigned long long mask = __ballot(sel);
            if (lane == 0) { MK[i] = mask; ST[2 * i] = mu; ST[2 * i + 1] = rstd; }
            if (sel) { const int rk8 = __popcll(mask & ((1ull << lane) - 1ull)); tokg[t * 8 + rk8] = gate; }
        }
        __syncthreads();
#pragma unroll 1
        for (int j = 0; j < 4; ++j) { const int i = 4 * wave + j, t = row0 + i; const unsigned long long mask = MK[i];
            int lr = 0; for (int q = 0; q < i; ++q) lr += (int)((MK[q] >> lane) & 1ull);
            if ((mask >> lane) & 1ull) { const int rk8 = __popcll(mask & ((1ull << lane) - 1ull)); toke[t * 8 + rk8] = (lane << 16) | lr; } }
        if (wave == 0) { int c = 0; for (int q = 0; q < 32; ++q) c += (int)((MK[q] >> lane) & 1ull); cntp[ch * 64 + lane] = c; }
#pragma unroll 1
        for (int j = 0; j < 4; ++j) { const int i = 4 * wave + j, t = row0 + i; const float mu = ST[2 * i], rstd = ST[2 * i + 1];
            f32x4 xo[8];
#pragma unroll
            for (int jj = 0; jj < 8; ++jj) { const int col = 4 * lane + 256 * jj; const u32x2 zw = *(const u32x2*)(z + (size_t)t * DM + col); const f32x4 zv = {bf_lo(zw.x), bf_hi(zw.x), bf_lo(zw.y), bf_hi(zw.y)}, g = *(const f32x4*)(g1 + col), b = *(const f32x4*)(b1 + col);
                xo[jj] = (zv - mu) * rstd * g + b; }
#pragma unroll
            for (int jj = 0; jj < 8; ++jj) { const int col = 4 * lane + 256 * jj;
                const u32x2 xb = {cvt_pk_bf16(xo[jj][0], xo[jj][1]), cvt_pk_bf16(xo[jj][2], xo[jj][3])};
                *(u32x2*)(x1h + (size_t)t * DM + col) = xb;
                if (l == 0 && L0F8 != 2) *(u32x2*)(x1b + (size_t)t * DM + col) = xb;
                if (l == 1 || L0F8 == 2) *(unsigned*)(ws + WS_X1Q + (size_t)t * DM + col) = pk4_fp8(xo[jj][0], xo[jj][1], xo[jj][2], xo[jj][3]); } }
        __syncthreads();
    }
}

__device__ __forceinline__ void phase_r2(const KArgs& a, LAS unsigned char* lds, int G, int tid, int wave, int lane) {
    unsigned char* ws = a.ws;
    LAS int* PA = (LAS int*)lds; LAS int* PB = PA + 512; LAS int* SB = PA + 1024; LAS int* TOT = PA + 1088; LAS int* TB = PA + 1152;
    const int* cntp = (const int*)(ws + WS_CNT); const int* toke = (const int*)(ws + WS_TOKE);
    int* toks = (int*)(ws + WS_TOKS); int* rowidx = (int*)(ws + WS_ROWIDX); int* mte = (int*)(ws + WS_MTE); int* nmtp = (int*)(ws + WS_NMT);
    for (int ch = blockIdx.x; ch < NCHUNK; ch += G) {
        { int sa = 0, sb = 0; for (int c = 32 * wave; c < 32 * wave + 32; ++c) { const int v = cntp[c * 64 + lane]; sa += v; if (c < ch) sb += v; } PA[wave * 64 + lane] = sa; PB[wave * 64 + lane] = sb; }
        __syncthreads();
        if (wave == 0) { int tot = 0, off = 0;
#pragma unroll
            for (int w = 0; w < 8; ++w) { tot += PA[w * 64 + lane]; off += PB[w * 64 + lane]; }
            const int nt = (tot + 255) >> 8; int incl = nt;
#pragma unroll
            for (int o = 1; o < 64; o <<= 1) { const int v = __shfl_up(incl, o); if (lane >= o) incl += v; }
            const int tb = incl - nt;
            SB[lane] = 8192 + 256 * tb + off; TOT[lane] = tot; TB[lane] = tb;
            if (ch == 0) { for (int q = 0; q < nt; ++q) mte[32 + tb + q] = lane; if (lane < 32) mte[lane] = 64; if (lane == 63) *nmtp = 32 + incl; } }
        __syncthreads();
        if (tid < 256) { const int t = ch * 32 + (tid >> 3), k = tid & 7; const int pk = toke[t * 8 + k]; const int e = pk >> 16, lr = pk & 0xffff; const int slot = SB[e] + lr; rowidx[slot] = t; toks[t * 8 + k] = slot; }
        else if (tid < 288) { const int t = ch * 32 + (tid - 256); rowidx[t] = t; }
        if (ch < 64 && tid < 256) { const int tot = TOT[ch], tb = TB[ch], nt = (tot + 255) >> 8; const int p = tot + tid; if (p < 256 * nt) rowidx[8192 + 256 * tb + p] = 0; }
        __syncthreads();
    }
}

__device__ __forceinline__ void phase_ln2(const KArgs& a, int l, int vcu, int G, int wave, int lane) {
    unsigned char* ws = a.ws;
    const bf16_t* x1h = (const bf16_t*)(ws + WS_X1F); const unsigned char* Y = ws + WS_Y;
    const int* toks = (const int*)(ws + WS_TOKS); const float* tokg = (const float*)(ws + WS_TOKG);
    const float* g2 = a.in[I_LN2G] + l * DM; const float* b2 = a.in[I_LN2B] + l * DM;
    float* outf = a.out; bf16_t* outb = (bf16_t*)(ws + WS_X2B);
    const int gw = vcu * 8 + wave, NGW = G * 8;
    for (int t = gw; t < T; t += NGW) {
        const int slot_l = lane < 8 ? toks[t * 8 + lane] : 0; const float g_l = lane < 8 ? tokg[t * 8 + lane] * (1.f / Y8_SCALE) : 0.f;
        float v[4][8];
#define LN2_ADD(j, g, yoff) do { const u32x2 yw = __builtin_nontemporal_load((const u32x2*)(Y + (yoff))); \
            const f32x2 a0 = __builtin_amdgcn_cvt_pk_f32_fp8((int)yw.x, false), a1 = __builtin_amdgcn_cvt_pk_f32_fp8((int)yw.x, true), a2 = __builtin_amdgcn_cvt_pk_f32_fp8((int)yw.y, false), a3 = __builtin_amdgcn_cvt_pk_f32_fp8((int)yw.y, true); \
            v[j][0] += (g) * a0[0]; v[j][1] += (g) * a0[1]; v[j][2] += (g) * a1[0]; v[j][3] += (g) * a1[1]; v[j][4] += (g) * a2[0]; v[j][5] += (g) * a2[1]; v[j][6] += (g) * a3[0]; v[j][7] += (g) * a3[1]; } while (0)
#pragma unroll
        for (int j = 0; j < 4; ++j) { const int col = 8 * lane + 512 * j; const u32x4 xw = *(const u32x4*)(x1h + (size_t)t * DM + col);
            v[j][0] = ALPHA * bf_lo(xw.x); v[j][1] = ALPHA * bf_hi(xw.x); v[j][2] = ALPHA * bf_lo(xw.y); v[j][3] = ALPHA * bf_hi(xw.y);
            v[j][4] = ALPHA * bf_lo(xw.z); v[j][5] = ALPHA * bf_hi(xw.z); v[j][6] = ALPHA * bf_lo(xw.w); v[j][7] = ALPHA * bf_hi(xw.w);
            LN2_ADD(j, (1.f / Y8_SCALE), (size_t)t * DM + col); }
#pragma unroll
        for (int k = 0; k < 8; ++k) { const int slot = __builtin_amdgcn_readlane(slot_l, k); const float g = __uint_as_float((unsigned)__builtin_amdgcn_readlane((int)__float_as_uint(g_l), k));
#pragma unroll
            for (int j = 0; j < 4; ++j) LN2_ADD(j, g, (size_t)slot * DM + 8 * lane + 512 * j); }
#undef LN2_ADD
        float s = 0.f;
#pragma unroll
        for (int j = 0; j < 4; ++j)
#pragma unroll
            for (int q = 0; q < 8; ++q) s += v[j][q];
        const float mean = wave_sum(s) * (1.f / DM); float s2 = 0.f;
#pragma unroll
        for (int j = 0; j < 4; ++j)
#pragma unroll
            for (int q = 0; q < 8; ++q) { v[j][q] -= mean; s2 += v[j][q] * v[j][q]; }
        const float rstd = 1.f / sqrtf(wave_sum(s2) * (1.f / DM) + LN_EPS);
#pragma unroll
        for (int j = 0; j < 4; ++j) { const int col = 8 * lane + 512 * j; const f32x4 ga = *(const f32x4*)(g2 + col), gb = *(const f32x4*)(g2 + col + 4), ba = *(const f32x4*)(b2 + col), bb = *(const f32x4*)(b2 + col + 4);
#pragma unroll
            for (int q = 0; q < 4; ++q) { v[j][q] = v[j][q] * rstd * ga[q] + ba[q]; v[j][4 + q] = v[j][4 + q] * rstd * gb[q] + bb[q]; } }
#pragma unroll
        for (int j = 0; j < 4; ++j) { const int col = 8 * lane + 512 * j;
            if (l == 1) { *(f32x4*)(outf + (size_t)t * DM + col) = (f32x4){v[j][0], v[j][1], v[j][2], v[j][3]}; *(f32x4*)(outf + (size_t)t * DM + col + 4) = (f32x4){v[j][4], v[j][5], v[j][6], v[j][7]}; }
            if (l == 0) *(u32x4*)(outb + (size_t)t * DM + col) = (u32x4){cvt_pk_bf16(v[j][0], v[j][1]), cvt_pk_bf16(v[j][2], v[j][3]), cvt_pk_bf16(v[j][4], v[j][5]), cvt_pk_bf16(v[j][6], v[j][7])}; }
    }
}

__device__ __forceinline__ void phase_stats(const KArgs& a, int vcu, int G, int wave, int lane) {
    unsigned char* ws = a.ws;
    const bf16_t* ckq = (const bf16_t*)(ws + WS_CKQ); float* rstat = (float*)(ws + WS_RSTAT); bf16_t* Kb = (bf16_t*)(ws + WS_K); const f32x2* rope = (const f32x2*)(ws + WS_ROPE);
    const int gw = vcu * 8 + wave, NGW = G * 8;
    for (int t = gw; t < T; t += NGW) { const bf16_t* row = ckq + (size_t)t * NCKQ;
        const u32x4 c = *(const u32x4*)(row + 8 * lane), q = *(const u32x4*)(row + 512 + 8 * lane);
        float sc = bf_lo(c.x) * bf_lo(c.x) + bf_hi(c.x) * bf_hi(c.x) + bf_lo(c.y) * bf_lo(c.y) + bf_hi(c.y) * bf_hi(c.y) + bf_lo(c.z) * bf_lo(c.z) + bf_hi(c.z) * bf_hi(c.z) + bf_lo(c.w) * bf_lo(c.w) + bf_hi(c.w) * bf_hi(c.w);
        float sq = bf_lo(q.x) * bf_lo(q.x) + bf_hi(q.x) * bf_hi(q.x) + bf_lo(q.y) * bf_lo(q.y) + bf_hi(q.y) * bf_hi(q.y) + bf_lo(q.z) * bf_lo(q.z) + bf_hi(q.z) * bf_hi(q.z) + bf_lo(q.w) * bf_lo(q.w) + bf_hi(q.w) * bf_hi(q.w);
        sc = wave_sum(sc); sq = wave_sum(sq);
        if (lane == 0) { rstat[t] = 1.f / sqrtf(sc * (1.f / 512.f) + RMS_EPS); rstat[T + t] = 1.f / sqrtf(sq * (1.f / 512.f) + RMS_EPS); }
        const int i = lane & 31, s = t & (SEQ - 1);
        const float x1 = __uint_as_float((unsigned)row[1024 + i] << 16), x2 = __uint_as_float((unsigned)row[1056 + i] << 16);
        const f32x2 cs = rope[s * 32 + i];
        const float o = lane < 32 ? x1 * cs[0] - x2 * cs[1] : x2 * cs[0] + x1 * cs[1];
        const bf16_t ob = (bf16_t)(cvt_pk_bf16(o, 0.f) & 0xffffu);
        bf16_t* kr = Kb + (size_t)t * (NH * DQK) + 128 + lane;
#pragma unroll
        for (int h = 0; h < NH; ++h) kr[h * DQK] = ob;
    }
}

struct AttHook { const KArgs* a; LAS unsigned char* lds; int vcu, G, wave, lane;
    __device__ __forceinline__ void operator()() const { const int NIT = 65 * 512, per = (NIT + G - 1) / G, lo = vcu * per, hi = lo + per;
        __syncthreads(); bg_convert_range(*a, lds, 2, 1, lo < NIT ? lo : NIT, hi < NIT ? hi : NIT, wave, lane, 90112, 5120); } };
constexpr int N_PHASES = 19;
__global__ void __launch_bounds__(512, 2) fwd_kernel(KArgs a) {
    extern __shared__ __attribute__((aligned(16))) unsigned char lds_raw[];
    LAS unsigned char* lds = (LAS unsigned char*)lds_raw;
    volatile LAS unsigned* MISC = (volatile LAS unsigned*)(lds + MISC_OFF);
    const int tid = threadIdx.x, lane = tid & 63, wave = __builtin_amdgcn_readfirstlane(tid >> 6);
    const int G = gridDim.x; int bx = blockIdx.x; int vcu = (G % 8 == 0) ? (bx % 8) * (G / 8) + bx / 8 : bx;
    unsigned char* ws = a.ws;
    if (tid < 32) MISC[tid] = 0u;
    __syncthreads();
    XcdBarrier bar; bar.bar = (unsigned*)(ws + WS_CTL) + CW_BAR; bar.x = 0; bar.st = nullptr;
    if (MK_N_LAUNCHES == 1) bar = xcd_barrier_post((unsigned*)(ws + WS_CTL) + CW_BAR, MISC + 8);
    const int lo = a.ph_lo, hi = a.ph_hi;
#ifndef PHMASK
#define PHMASK 0xFFFFFFu
#endif
#define PH(k) ((((PHMASK) >> (k)) & 1u) && lo <= (k) && (k) < hi)
#define SEAM(k) do { if (PH(k) && PH((k) + 1)) xcd_barrier(bar); } while (0)

constexpr int G6_ITEMS = 96 * 60;
#ifndef HWIDS
#define HWIDS 1
#endif
#ifndef EXPER
#define EXPER 0
#endif
#ifndef REPMASK
#define REPMASK 0x0u
#endif
#define RUN(k, BODY) do { if (PH(k)) { BODY; if ((REPMASK >> (k)) & 1u) { __syncthreads(); BODY; } } } while (0)
#define P_G1 do { DenseSched S; S.ord.init(32, 8, G, bx); S.A = (const char*)(ws + WS_XP); S.B = (const char*)(ws + WS_WIN); S.lda_b = DM * 2; S.K = DM; S.mode = 1; S.agrp = (size_t)T * DM * 2; \
        EpiBf16 E{(bf16_t*)(ws + WS_POOLED), DM, nullptr, 0, 1.f}; pg8::gemm_phase(lds, DM * 2, DM, S, E); } while (0)
#define P_G2 do { DenseSched S; S.ord.init(32, 8, G, bx); S.A = (const char*)(ws + WS_POOLED); S.B = (const char*)(ws + WS_WGRP); S.lda_b = DM * 2; S.K = 512; S.mode = 1; S.agrp = 1024; \
        EpiBf16 E{(bf16_t*)(ws + WS_MIXED), DM, a.in[I_ASCALE], 0, 1.f}; pg8::gemm_phase(lds, DM * 2, 512, S, E); } while (0)
#define P_G3 do { DenseSched S; S.ord.init(32, 8, G, bx); S.A = (const char*)(ws + WS_MIXED); S.B = (const char*)(ws + WS_WOUT); S.lda_b = DM * 2; S.K = DM; S.mode = 0; S.agrp = 0; \
        EpiZ E{a.in[I_X], nullptr, (bf16_t*)(ws + WS_Z)}; pg8::gemm_phase(lds, DM * 2, DM, S, E); } while (0)
#define P_G4(l, BGK, BGL, NR, BGF, BGT) do { const int nmt = __builtin_amdgcn_readfirstlane(*(const int*)(ws + WS_NMT)); const int isp = (BGK) >= 0 ? (vcu >> 5) % (NR) : 1 << 20; \
        MoeSched S{(const int*)(ws + WS_MTE), (const int*)(ws + WS_ROWIDX), (const char*)(ws + WS_X1B), (const char*)(ws + WS_WGU) + (size_t)(l) * 65 * 1024 * 2048 * 2, nmt * 4, 4, G, vcu, 1, \
                   (size_t)1024 * 2048 * 2, (size_t)256 * 2048 * 2, 0, 0, isp}; \
        EpiSwiGLU E{(bf16_t*)(ws + WS_H), 1.f, 0}; pg8::gemm_phase(lds, DM * 2, DM, S, E); \
        if ((BGK) >= 0) { int blo, bhi; bg_share((BGF), (BGT), vcu, G, S.nunits % G, 55, blo, bhi); bg_convert_range(a, lds, (BGK), (BGL), blo, bhi, wave, lane); S.i0 = isp; S.i1 = 1 << 20; pg8::gemm_phase(lds, DM * 2, DM, S, E); } } while (0)
#define P_G4H(l, BGK, BGL, NR, BGF, BGT) do { const int nmt = __builtin_amdgcn_readfirstlane(*(const int*)(ws + WS_NMT)); const int isp = (BGK) >= 0 ? (vcu >> 5) % (NR) : 1 << 20; \
        MoeSched S{(const int*)(ws + WS_MTE), (const int*)(ws + WS_ROWIDX), (const char*)(ws + WS_X1B), (const char*)(ws + WS_WGU) + (size_t)(l) * 65 * 1024 * 2048 * 2, nmt * 4, 4, G, vcu, 1, \
                   (size_t)1024 * 2048 * 2, (size_t)256 * 2048 * 2, 0, 0, isp}; \
        EpiSwiGLU E{(bf16_t*)(ws + WS_H), 1.f, 1}; pg8::gemm_phase(lds, DM * 2, DM, S, E); \
        if ((BGK) >= 0) { int blo, bhi; bg_share((BGF), (BGT), vcu, G, S.nunits % G, 55, blo, bhi); bg_convert_range(a, lds, (BGK), (BGL), blo, bhi, wave, lane); S.i0 = isp; S.i1 = 1 << 20; pg8::gemm_phase(lds, DM * 2, DM, S, E); } } while (0)
#define P_G4F(l, BGK, BGL, NR, BGF, BGT) do { const int nmt = __builtin_amdgcn_readfirstlane(*(const int*)(ws + WS_NMT)); const int isp = (BGK) >= 0 ? (vcu >> 5) % (NR) : 1 << 20; \
        MoeSchedT<true> S{(const int*)(ws + WS_MTE), (const int*)(ws + WS_ROWIDX), (const char*)(ws + WS_X1Q), (const char*)(ws + WS_WGU) + (size_t)(l) * 65 * 1024 * 2048 * 2, nmt * 4, 4, G, vcu, 1, \
                   (size_t)1024 * 2048, (size_t)256 * 2048, 0, 0, isp}; \
        EpiSwiGLU E{(bf16_t*)(ws + WS_H), 1.f / W8_SCALE, 1}; pg8::gemm_phase(lds, DM, DM / 2, S, E); \
        if ((BGK) >= 0) { int blo, bhi; bg_share((BGF), (BGT), vcu, G, S.nunits % G, 30, blo, bhi); bg_convert_range(a, lds, (BGK), (BGL), blo, bhi, wave, lane); S.i0 = isp; S.i1 = 1 << 20; pg8::gemm_phase(lds, DM, DM / 2, S, E); } } while (0)
#define P_G5(l, BGK, BGL, NR, BGF, BGT) do { const int nmt = __builtin_amdgcn_readfirstlane(*(const int*)(ws + WS_NMT)); const int isp = (BGK) >= 0 ? (vcu >> 5) % (NR) : 1 << 20; \
        MoeSched S{(const int*)(ws + WS_MTE), (const int*)(ws + WS_ROWIDX), (const char*)(ws + WS_H), (const char*)(ws + WS_WD) + (size_t)(l) * 65 * 2048 * 512 * 2, nmt * 8, 8, G, vcu, 0, \
                   (size_t)2048 * 512 * 2, (size_t)256 * 512 * 2, (size_t)256 * 1024, 0, isp}; \
        EpiBf16 E{(bf16_t*)(ws + WS_Y), DM, nullptr, 1, 1.f}; pg8::gemm_phase(lds, ED * 2, ED, S, E); \
        if ((BGK) >= 0) { int blo, bhi; bg_share((BGF), (BGT), vcu, G, S.nunits % G, 20, blo, bhi); bg_convert_range(a, lds, (BGK), (BGL), blo, bhi, wave, lane); S.i0 = isp; S.i1 = 1 << 20; pg8::gemm_phase(lds, ED * 2, ED, S, E); } } while (0)
#define P_G5F(l, BGK, BGL, NR, BGF, BGT) do { const int nmt = __builtin_amdgcn_readfirstlane(*(const int*)(ws + WS_NMT)); const int isp = (BGK) >= 0 ? (vcu >> 5) % (NR) : 1 << 20; \
        MoeSchedT<true> S{(const int*)(ws + WS_MTE), (const int*)(ws + WS_ROWIDX), (const char*)(ws + WS_H), (const char*)(ws + WS_WD) + (size_t)(l) * 65 * 2048 * 512 * 2, nmt * 8, 8, G, vcu, 0, \
                   (size_t)2048 * 512, (size_t)256 * 512, (size_t)256 * 512, 0, isp}; \
        EpiY8 E{ws + WS_Y, Y8_SCALE / W8_SCALE}; pg8::gemm_phase(lds, ED, ED / 2, S, E); \
        if ((BGK) >= 0) { int blo, bhi; bg_share((BGF), (BGT), vcu, G, S.nunits % G, 12, blo, bhi); bg_convert_range(a, lds, (BGK), (BGL), blo, bhi, wave, lane); S.i0 = isp; S.i1 = 1 << 20; pg8::gemm_phase(lds, ED, ED / 2, S, E); } } while (0)
#define P_G6 do { if (G > 160 && bx >= 160) { const int per = (G6_ITEMS + (G - 160) - 1) / (G - 160), blo = (bx - 160) * per, bhi = blo + per; bg_convert_range(a, lds, 3, 1, blo < G6_ITEMS ? blo : G6_ITEMS, bhi < G6_ITEMS ? bhi : G6_ITEMS, wave, lane); } \
        DenseSched S; S.ord.init(32, 5, G, bx); S.A = (const char*)(ws + WS_X2B); S.B = (const char*)(ws + WS_WKVQ); S.lda_b = DM * 2; S.K = DM; S.mode = 0; S.agrp = 0; \
        EpiBf16 E{(bf16_t*)(ws + WS_CKQ), NCKQ, nullptr, 0, 1.f}; pg8::gemm_phase(lds, DM * 2, DM, S, E); } while (0)
#define P_G7 do { DenseSched S; S.ord.init(32, 28, G, bx); S.A = (const char*)(ws + WS_CKQ); S.B = (const char*)(ws + WS_WUP); S.lda_b = NCKQ * 2; S.K = 512; S.mode = 2; S.agrp = 0; \
        EpiUp E{(bf16_t*)(ws + WS_Q), (bf16_t*)(ws + WS_K), (bf16_t*)(ws + WS_V), (const float*)(ws + WS_RSTAT), (const f32x2*)(ws + WS_ROPE)}; pg8::gemm_phase(lds, NCKQ * 2, 512, S, E); } while (0)
#define P_ATT do { AttHook H{&a, lds, vcu, G, wave, lane}; att::attn_phase((att::lptr)lds, (const bf16_t*)(ws + WS_Q), (const bf16_t*)(ws + WS_K), (const bf16_t*)(ws + WS_V), (bf16_t*)(ws + WS_ATT), vcu, G, H); } while (0)
#define P_G8 do { DenseSched S; S.ord.init(32, 8, G, bx); S.A = (const char*)(ws + WS_ATT); S.B = (const char*)(ws + WS_WBO); S.lda_b = DM * 2; S.K = DM; S.mode = 0; S.agrp = 0; \
        EpiZ E{nullptr, (const bf16_t*)(ws + WS_X2B), (bf16_t*)(ws + WS_Z)}; pg8::gemm_phase(lds, DM * 2, DM, S, E); } while (0)
#define MOE_PHASES(l, pb, K4, L4, F4, T4, K5, L5, F5, T5, G4M, G5M) do { \
        RUN(pb, phase_r1(a, lds, l, G, wave, lane)); SEAM(pb); \
        RUN((pb) + 1, phase_r2(a, lds, G, tid, wave, lane)); \
        if (EXPER && (l) == 0 && PH((pb) + 1)) { __syncthreads(); if (EXPER == 1 ? vcu < 32 : EXPER == 2 ? (vcu & 7) == 0 : EXPER == 3 ? true : EXPER == 4 ? vcu < 64 : (vcu & 3) == 0) bg_convert(a, lds, 1, 1, vcu, G, wave, lane); } \
        SEAM((pb) + 1); \
        RUN((pb) + 2, G4M(l, K4, L4, 5, F4, T4)); SEAM((pb) + 2); \
        RUN((pb) + 3, G5M(l, K5, L5, 10, F5, T5)); SEAM((pb) + 3); \
        RUN((pb) + 4, phase_ln2(a, l, vcu, G, wave, lane)); } while (0)

    RUN(0, phase_prologue(a, lds, vcu, G, wave, lane)); SEAM(0);
    if (MK_N_LAUNCHES == 1 && HWIDS && PH(0) && PH(1) && G % 8 == 0) {
        const unsigned* cen = (const unsigned*)(ws + WS_CTL) + CW_BAR; bool ok = true;
#pragma unroll
        for (int j = 0; j < 16; ++j) { const unsigned c = __hip_atomic_load(cen + XB_XCNT(j), __ATOMIC_RELAXED, __HIP_MEMORY_SCOPE_AGENT); ok = ok && (c == (j < 8 ? (unsigned)(G / 8) : 0u)); }
        const int rank = (int)MISC[16], xcc = (int)MISC[17];
        if (ok && xcc < 8 && rank < G / 8) { vcu = xcc * (G / 8) + rank; bx = rank * 8 + xcc; }
    }
    RUN(1, P_G1); SEAM(1);
    RUN(2, P_G2); SEAM(2);
    RUN(3, P_G3); SEAM(3);
    MOE_PHASES(0, 4, L0F8 ? 3 : 1, 0, 0, 65 * 256, -1, 1, 0, 0, P_G4SEL, P_G5SEL); SEAM(8);
    RUN(9, P_G6); SEAM(9);
    RUN(10, phase_stats(a, vcu, G, wave, lane)); SEAM(10);
    RUN(11, P_G7); SEAM(11);
    RUN(12, P_ATT); SEAM(12);
    RUN(13, P_G8); SEAM(13);
    MOE_PHASES(1, 14, 3, 1, (G > 160 ? G6_ITEMS : 0), 65 * 256, -1, 0, 0, 0, P_G4F, P_G5F);
#undef MOE_PHASES
#undef RUN
#undef PH
#undef SEAM
}

extern "C" void kernel_launch(void* const* d_in, const int* in_sizes, int n_in, void* d_out, int out_size, void* d_ws, size_t ws_size, hipStream_t stream) {
    static int grid = 0;
    if (grid == 0) {
        if (n_in != 25 || out_size != T * DM || ws_size < WS_END) { fprintf(stderr, "kernel_launch: unexpected shapes (n_in %d, out %d, ws %zu)\n", n_in, out_size, ws_size); grid = -1; return; }
        int dev = 0, cus = 0;
        if (hipGetDevice(&dev) != hipSuccess || hipDeviceGetAttribute(&cus, hipDeviceAttributeMultiprocessorCount, dev) != hipSuccess) { grid = -1; return; }
        if (hipFuncSetAttribute((const void*)fwd_kernel, hipFuncAttributeMaxDynamicSharedMemorySize, LDS_BYTES) != hipSuccess) { fprintf(stderr, "kernel_launch: hipFuncSetAttribute failed\n"); grid = -1; return; }
        int per_cu = 0;
        if (hipOccupancyMaxActiveBlocksPerMultiprocessor(&per_cu, (const void*)fwd_kernel, 512, LDS_BYTES) != hipSuccess || per_cu < 1) fprintf(stderr, "kernel_launch: occupancy query reports %d blocks per CU\n", per_cu);
        (void)hipGetLastError();
        grid = cus;
    }
    if (grid < 0) return;
    (void)hipMemsetAsync((char*)d_ws + WS_CTL, 0, CTL_ZERO_BYTES, stream);
    KArgs a{};
    for (int i = 0; i < 25; ++i) a.in[i] = (const float*)d_in[i];
    a.out = (float*)d_out; a.ws = (unsigned char*)d_ws;
#if MK_N_LAUNCHES == 1
    a.ph_lo = 0; a.ph_hi = N_PHASES;
    hipLaunchKernelGGL(fwd_kernel, dim3(grid), dim3(512), LDS_BYTES, stream, a);
#else
    for (int k = 0; k < N_PHASES; ++k) { a.ph_lo = k; a.ph_hi = k + 1; hipLaunchKernelGGL(fwd_kernel, dim3(grid), dim3(512), LDS_BYTES, stream, a); }
#endif
}
```

```cpp
#include <hip/hip_runtime.h>
#include <cstdio>
#include <cstdint>

#ifndef MK_N_LAUNCHES
#define MK_N_LAUNCHES 1
#endif

#ifndef L0F8
#define L0F8 2
#endif
#if L0F8 == 2
#define P_G4SEL P_G4F
#define P_G5SEL P_G5F
#elif L0F8 == 1
#define P_G4SEL P_G4H
#define P_G5SEL P_G5F
#else
#define P_G4SEL P_G4
#define P_G5SEL P_G5
#endif
#define LAS __attribute__((address_space(3)))
#define GAS __attribute__((address_space(1)))
typedef unsigned short bf16_t;
typedef short bf16x8 __attribute__((ext_vector_type(8)));
typedef short s16x4 __attribute__((ext_vector_type(4)));
typedef float f32x2 __attribute__((ext_vector_type(2)));
typedef float f32x4 __attribute__((ext_vector_type(4)));
typedef float f32x16 __attribute__((ext_vector_type(16)));
typedef unsigned u32x2 __attribute__((ext_vector_type(2)));
typedef unsigned u32x4 __attribute__((ext_vector_type(4)));

constexpr int T = 8192, DM = 2048, SEQ = 4096, NBATCH = 2, NH = 16, NE = 64, TOPK = 8, ED = 512;
constexpr int DQK = 192, DV = 128, NCKQ = 1280;
constexpr float ALPHA = 1.4142135623730951f;
constexpr float LN_EPS = 1e-5f, RMS_EPS = 1e-6f;
constexpr int NSLOT_ROWS = 8192 + 65536 + 64 * 256;
constexpr int NCHUNK = T / 32;

constexpr size_t MiB = 1u << 20, KiB = 1u << 10;
constexpr size_t WS_CTL = 0, CTL_ZERO_BYTES = 1 * MiB;
constexpr size_t WS_ROPE = 1 * MiB;
constexpr size_t WS_RWHI = 2 * MiB;
constexpr size_t WS_RWLO = 2 * MiB + 512 * KiB;
constexpr size_t WS_RC = 3 * MiB;
constexpr size_t WS_CNT = 3 * MiB + 64 * KiB;
constexpr size_t WS_TOKE = 3 * MiB + 256 * KiB;
constexpr size_t WS_TOKG = 3 * MiB + 512 * KiB;
constexpr size_t WS_TOKS = 3 * MiB + 768 * KiB;
constexpr size_t WS_ROWIDX = 4 * MiB;
constexpr size_t WS_MTE = 4 * MiB + 512 * KiB;
constexpr size_t WS_NMT = 4 * MiB + 516 * KiB;
constexpr size_t WS_RSTAT = 5 * MiB;
constexpr size_t WS_WIN = 8 * MiB, WS_WGRP = 16 * MiB, WS_WOUT = 18 * MiB, WS_WKVQ = 26 * MiB, WS_WUP = 31 * MiB, WS_WBO = 38 * MiB;
constexpr size_t WS_WGU = 48 * MiB;
constexpr size_t WS_WD = 568 * MiB;
constexpr size_t WS_XP = 828 * MiB;
constexpr size_t WS_Q = 828 * MiB, WS_K = 876 * MiB, WS_V = 924 * MiB;
constexpr size_t WS_POOLED = 956 * MiB;
constexpr size_t WS_ATT = 956 * MiB;
constexpr size_t WS_X1Q = 956 * MiB;
constexpr size_t WS_MIXED = 988 * MiB;
constexpr size_t WS_CKQ = 988 * MiB;
constexpr size_t WS_Z = 1020 * MiB;
constexpr size_t WS_X1F = 1084 * MiB, WS_X1B = 1148 * MiB;
constexpr size_t WS_X2F = 1180 * MiB, WS_X2B = 1244 * MiB;
constexpr size_t WS_H = 1276 * MiB;
constexpr size_t WS_Y = 1364 * MiB;
constexpr size_t WS_END = 1716 * MiB;

constexpr int CW_BAR = 4096;

constexpr int RING_BYTES = 131072;
constexpr int MISC_OFF = RING_BYTES + 320;
constexpr int LDS_BYTES = 147456;

#define LDS_WAIT() asm volatile("s_waitcnt lgkmcnt(0)" ::: "memory")
#define VM_WAIT() asm volatile("s_waitcnt vmcnt(0)" ::: "memory")
__device__ __forceinline__ unsigned cvt_pk_bf16(float lo, float hi) { unsigned r; asm volatile("v_cvt_pk_bf16_f32 %0, %1, %2" : "=v"(r) : "v"(lo), "v"(hi)); return r; }
__device__ __forceinline__ float bf_lo(unsigned w) { return __uint_as_float(w << 16); }
__device__ __forceinline__ float bf_hi(unsigned w) { return __uint_as_float(w & 0xffff0000u); }
template <int CTRL> __device__ __forceinline__ float dpp_f(float v) { return __uint_as_float((unsigned)__builtin_amdgcn_update_dpp(0, (int)__float_as_uint(v), CTRL, 0xf, 0xf, false)); }
constexpr int DPP_X1 = 0xB1, DPP_X2 = 0x4E, DPP_X3 = 0x1B, DPP_HM = 0x141, DPP_RM = 0x140;
__device__ __forceinline__ float wave_sum(float v) {
    v += dpp_f<DPP_X1>(v); v += dpp_f<DPP_X2>(v); v += dpp_f<DPP_HM>(v); v += dpp_f<DPP_RM>(v);
    { const auto r = __builtin_amdgcn_permlane16_swap(__float_as_uint(v), __float_as_uint(v), false, false); v = __uint_as_float(r[0]) + __uint_as_float(r[1]); }
    { const auto r = __builtin_amdgcn_permlane32_swap(__float_as_uint(v), __float_as_uint(v), false, false); v = __uint_as_float(r[0]) + __uint_as_float(r[1]); }
    return v;
}
__device__ __forceinline__ float wave_sum_x(float v) {
#pragma unroll
    for (int o = 1; o < 64; o <<= 1) v += __shfl_xor(v, o);
    return v;
}
__device__ __forceinline__ float wave_max(float v) {
    v = fmaxf(v, dpp_f<DPP_X1>(v)); v = fmaxf(v, dpp_f<DPP_X2>(v)); v = fmaxf(v, dpp_f<DPP_HM>(v)); v = fmaxf(v, dpp_f<DPP_RM>(v));
    { const auto r = __builtin_amdgcn_permlane16_swap(__float_as_uint(v), __float_as_uint(v), false, false); v = fmaxf(__uint_as_float(r[0]), __uint_as_float(r[1])); }
    { const auto r = __builtin_amdgcn_permlane32_swap(__float_as_uint(v), __float_as_uint(v), false, false); v = fmaxf(__uint_as_float(r[0]), __uint_as_float(r[1])); }
    return v;
}

#define XB_TMO      128
#define XB_XCNT(j)  (256  + 64 * (j))
#define XB_XSUB(j)  (1280 + 64 * (j))
#define XB_XGEN(j)  (2304 + 64 * (j))
#define XB_TOP      3328
#define XB_TOPGEN   3392
#define XCD_BAR_WORDS 3456
#define XB_SPIN_CAP (1u << 18)
__device__ __forceinline__ unsigned xb_ld(unsigned* p)              { return __hip_atomic_load(p, __ATOMIC_RELAXED, __HIP_MEMORY_SCOPE_AGENT); }
__device__ __forceinline__ unsigned xb_add(unsigned* p, unsigned v) { return __hip_atomic_fetch_add(p, v, __ATOMIC_RELAXED, __HIP_MEMORY_SCOPE_AGENT); }
__device__ __forceinline__ unsigned xb_xcc_id() { return (unsigned)__builtin_amdgcn_s_getreg((3 << 11) | 20) & 0xFu; }
#define XB_SPIN(cond, bar) do { unsigned _sp = 0; while (cond) { __builtin_amdgcn_s_sleep(1); \
    if ((++_sp & 255u) == 0u) { if (xb_ld(&(bar)[XB_TMO])) break; if (_sp > XB_SPIN_CAP) { atomicAdd(&(bar)[XB_TMO], 1u); break; } } } } while (0)
struct XcdBarrier { unsigned* bar; unsigned x; volatile LAS unsigned* st; };
__device__ __forceinline__ XcdBarrier xcd_barrier_post(unsigned* bar, volatile LAS unsigned* st) {
    XcdBarrier b; b.bar = bar; b.x = xb_xcc_id(); b.st = st;
    if (threadIdx.x == 0) { const unsigned rank = xb_add(&bar[XB_XCNT(b.x)], 1u); st[8] = rank; st[9] = b.x; }
    return b;
}
__device__ __forceinline__ void xcd_barrier_complete(unsigned* bar, unsigned x, unsigned& nloc, unsigned& nx) {
    const unsigned G = gridDim.x * gridDim.y * gridDim.z;
    unsigned sum, cnt, mine, sp = 0u;
    for (;;) {
        sum = 0u; cnt = 0u; mine = 0u;
#pragma unroll
        for (unsigned j = 0; j < 16; ++j) { const unsigned c = xb_ld(&bar[XB_XCNT(j)]); sum += c; cnt += (c > 0u) ? 1u : 0u; mine = (j == x) ? c : mine; }
        if (sum == G) break;
        __builtin_amdgcn_s_sleep(1);
        if ((++sp & 255u) == 0u) { if (xb_ld(&bar[XB_TMO])) break; if (sp > XB_SPIN_CAP) { atomicAdd(&bar[XB_TMO], 1u); break; } }
    }
    nloc = mine > 0u ? mine : 1u; nx = cnt > 0u ? cnt : 1u;
}
__device__ __forceinline__ void xcd_barrier(const XcdBarrier& b) {
    asm volatile("s_waitcnt vmcnt(0)" ::: "memory");
    __syncthreads();
    if (threadIdx.x == 0) {
        unsigned* bar = b.bar;
        __builtin_amdgcn_s_waitcnt(0);
        unsigned nloc = b.st[0], nx = b.st[1];
        if (nloc == 0u) { xcd_barrier_complete(bar, b.x, nloc, nx); b.st[0] = nloc; b.st[1] = nx; }
        const unsigned old = xb_add(&bar[XB_XSUB(b.x)], 1u);
        const unsigned gen = old / nloc;
        if (old + 1u == (gen + 1u) * nloc) {
            __builtin_amdgcn_fence(__ATOMIC_RELEASE, "agent");
            asm volatile("s_waitcnt vmcnt(0)" ::: "memory");
            const unsigned og = xb_add(&bar[XB_TOP], 1u);
            const unsigned tg = og / nx;
            if (og + 1u == (tg + 1u) * nx) xb_add(&bar[XB_TOPGEN], 1u);
            else XB_SPIN(xb_ld(&bar[XB_TOPGEN]) == tg, bar);
            __builtin_amdgcn_fence(__ATOMIC_ACQUIRE, "agent");
            xb_add(&bar[XB_XGEN(b.x)], 1u);
            asm volatile("s_waitcnt vmcnt(0)" ::: "memory");
        } else {
            XB_SPIN(xb_ld(&bar[XB_XGEN(b.x)]) == gen, bar);
            __builtin_amdgcn_fence(__ATOMIC_ACQUIRE, "agent");
            asm volatile("s_waitcnt vmcnt(0)" ::: "memory");
        }
    }
    __syncthreads();
}

namespace pg8 {
constexpr int BM = 256, BK = 64, HALF = 128, HTB = HALF * BK * 2, STAGE_BYTES = 8 * HTB, NXCD = 8, WGM = 8;
__host__ __device__ __forceinline__ int lds_byte(int r, int c) { const int st = (r >> 4) * 2 + (c >> 5), rr = r & 15, cc = c & 31, ob = rr * 64 + cc * 2; return st * 1024 + (ob ^ (((ob >> 9) & 1) << 5)); }
__host__ __device__ __forceinline__ void stage_rc(int b, int& R, int& C) { const int st = b / 1024, sb = b % 1024, swz = sb ^ (((sb >> 9) & 1) << 5); R = (st >> 1) * 16 + swz / 64; C = (st & 1) * 32 + (swz % 64) / 2; }
__host__ __device__ __forceinline__ int perm32(int rho) { const int n = rho >> 4, i = rho & 15; return 8 * (i >> 2) + 4 * n + (i & 3); }

typedef int v8i32 __attribute__((ext_vector_type(8)));
typedef int v4i32 __attribute__((ext_vector_type(4)));
template <bool F8> struct FragT { typedef bf16x8 type; };
template <> struct FragT<true> { typedef v8i32 type; };
__device__ __forceinline__ void ldfrag(bf16x8& d, const LAS unsigned char* p) { d = *(const LAS bf16x8*)p; }
__device__ __forceinline__ void ldfrag(v8i32& d, const LAS unsigned char* p) { const v4i32 x = *(const LAS v4i32*)p, y = *(const LAS v4i32*)(p + 16); d = __builtin_shufflevector(x, y, 0, 1, 2, 3, 4, 5, 6, 7); }
__device__ __forceinline__ f32x4 mma(v8i32 b, v8i32 a, f32x4 c, int sc) {
    asm volatile("v_mfma_scale_f32_16x16x128_f8f6f4 %0, %1, %2, %0, %3, %3 op_sel_hi:[0,0,0]" : "+v"(c) : "v"(b), "v"(a), "v"(sc)); return c; }
__device__ __forceinline__ f32x4 mma(bf16x8 b, bf16x8 a, f32x4 c, int) { return __builtin_amdgcn_mfma_f32_16x16x32_bf16(b, a, c, 0, 0, 0); }
struct Unit { const char* A; const char* B; const int* rows; int m0, pn, aux; };

struct TileOrder {
    int nM, nN, nwg, G, c;
    __device__ __forceinline__ void init(int nM_, int nN_, int G_, int c_) { nM = nM_; nN = nN_; nwg = nM * nN; G = G_; c = c_; }
    __device__ __forceinline__ bool next(int i, int& pm, int& pn) const {
        const long L = (long)i * G + c; if (L >= nwg) return false;
        int wgid = (int)L; { const int q = nwg / NXCD, r = nwg % NXCD, xcd = wgid % NXCD, off = wgid / NXCD; wgid = (xcd < r ? xcd * (q + 1) : r * (q + 1) + (xcd - r) * q) + off; }
        const int nig = WGM * nN, gid = wgid / nig, fm = gid * WGM, gsz = (nM - fm) < WGM ? (nM - fm) : WGM;
        pm = fm + ((wgid % nig) % gsz); pn = (wgid % nig) / gsz; return true;
    }
};

template <class Epi, class Sched>
__device__ __forceinline__ void gemm_phase(LAS unsigned char* lds, const int lda_b, const int K, const Sched& S, const Epi& E) {
    const int tid = threadIdx.x, wid = __builtin_amdgcn_readfirstlane(tid >> 6), lane = tid & 63, wr = wid >> 2, wc = wid & 3, fr = lane & 15, fq = lane >> 4;
    const int nt = K / BK;
    int Rs[2]; unsigned Cb[2], voffB[2];
#pragma unroll
    for (int i = 0; i < 2; ++i) { int R, C; stage_rc(tid * 16 + i * 8192, R, C); const int Rb = Epi::PERM ? ((R & ~31) + perm32(R & 31)) : R;
        Rs[i] = R; Cb[i] = (unsigned)C * 2u; voffB[i] = (unsigned)(Rb * K + C) * 2u; }
    const size_t kstep = (size_t)(BK * 2);
    const size_t hstepB = (size_t)HALF * K * 2;
    const unsigned ldsw = (unsigned)wid * 1024u;
    int sc1 = 0x7f7f7f7f; asm volatile("" : "+v"(sc1));
    constexpr bool F8 = Sched::FP8;
    const int aoff = lds_byte(wr * 64 + fr, fq * (F8 ? 16 : 8)), boff = lds_byte(wc * 32 + fr, fq * (F8 ? 16 : 8));
#define PG8_SA(b, h) (((b) * 2 + (h)) * HTB)
#define PG8_SB(b, h) ((4 + (b) * 2 + (h)) * HTB)
#define PG8_STAGE(bufoff, gbase, voff) do { _Pragma("unroll") for (int _i = 0; _i < 2; ++_i) \
        __builtin_amdgcn_global_load_lds((const unsigned*)((const char*)(gbase) + (voff)[_i]), (LAS unsigned*)(lds + (bufoff) + ldsw + _i * 8192), 16, 0, 0); } while (0)
#define PG8_LDA(dst, b, h) do { _Pragma("unroll") for (int m = 0; m < 4; ++m) _Pragma("unroll") for (int k = 0; k < NK; ++k) pg8::ldfrag(dst[m][k], lds + PG8_SA(b, h) + aoff + m * 2048 + k * 1024); } while (0)
#define PG8_LDB(dst, b, h) do { _Pragma("unroll") for (int n = 0; n < 2; ++n) _Pragma("unroll") for (int k = 0; k < NK; ++k) pg8::ldfrag(dst[n][k], lds + PG8_SB(b, h) + boff + n * 2048 + k * 1024); } while (0)
#define PG8_MMA(ai, bj, At, Bt) do { __builtin_amdgcn_s_setprio(1); _Pragma("unroll") for (int m = 0; m < 4; ++m) _Pragma("unroll") for (int n = 0; n < 2; ++n) _Pragma("unroll") for (int k = 0; k < NK; ++k) \
        acc[ai][bj][m][n] = pg8::mma(Bt[n][k], At[m][k], acc[ai][bj][m][n], sc1); __builtin_amdgcn_s_setprio(0); } while (0)
#define PG8_WAIT_V(n) asm volatile("s_waitcnt vmcnt(" #n ")" ::: "memory")
#define PG8_WAIT_L(n) asm volatile("s_waitcnt lgkmcnt(" #n ")" ::: "memory")
#define PG8_BAR __builtin_amdgcn_s_barrier()
#define PG8_SCHED __builtin_amdgcn_sched_barrier(0)
#define PG8_MKOFF(u, vo) do { _Pragma("unroll") for (int _h = 0; _h < 2; ++_h) _Pragma("unroll") for (int _i = 0; _i < 2; ++_i) { const int _R = _h * HALF + Rs[_i]; \
        const int _row = (u).rows ? (u).rows[_R] : _R; vo[_h][_i] = (unsigned)_row * (unsigned)lda_b + Cb[_i]; } } while (0)
    Unit cur, nxt; int ui = 0;
    if (!S.next(0, cur)) return;
    f32x4 acc[2][2][4][2];
#pragma unroll
    for (int a = 0; a < 2; ++a)
#pragma unroll
        for (int b = 0; b < 2; ++b)
#pragma unroll
            for (int m = 0; m < 4; ++m)
#pragma unroll
                for (int n = 0; n < 2; ++n) acc[a][b][m][n] = (f32x4){0.f, 0.f, 0.f, 0.f};
    typedef typename pg8::FragT<F8>::type frag_t; constexpr int NK = F8 ? 1 : 2;
    frag_t At[4][NK], B0[2][NK], B1[2][NK];
    unsigned voC[2][2], voN[2][2];
    PG8_MKOFF(cur, voC);
    const char* cA = cur.A; const char* cB = cur.B;
    PG8_STAGE(PG8_SB(0, 0), cB, voffB); PG8_STAGE(PG8_SA(0, 0), cA, voC[0]); PG8_STAGE(PG8_SB(0, 1), cB + hstepB, voffB); PG8_STAGE(PG8_SA(0, 1), cA, voC[1]);
    if (wr == 1) PG8_BAR;
    PG8_WAIT_V(4); PG8_BAR;
    PG8_STAGE(PG8_SB(1, 0), cB + kstep, voffB); PG8_STAGE(PG8_SA(1, 0), cA + kstep, voC[0]); PG8_STAGE(PG8_SB(1, 1), cB + hstepB + kstep, voffB);
    PG8_WAIT_V(6); PG8_BAR;
    for (;;) {
        const bool has_next = S.next(ui + 1, nxt);
        const char* nA = has_next ? nxt.A : cA; const char* nB = has_next ? nxt.B : cB;
        if (has_next) { PG8_MKOFF(nxt, voN); }
        else {
#pragma unroll
            for (int h = 0; h < 2; ++h)
#pragma unroll
                for (int i = 0; i < 2; ++i) voN[h][i] = voC[h][i]; }
        for (int t = 0; t < nt; t += 2) {
            const bool last = (t == nt - 2);
            const char* a1 = cA + (size_t)(t + 1) * kstep;
            const char* a2 = last ? nA : cA + (size_t)(t + 2) * kstep; const char* b2 = last ? nB : cB + (size_t)(t + 2) * kstep;
            const char* a3 = a2 + kstep; const char* b3 = b2 + kstep;
            unsigned v2[2][2];
#pragma unroll
            for (int h = 0; h < 2; ++h)
#pragma unroll
                for (int i = 0; i < 2; ++i) v2[h][i] = last ? voN[h][i] : voC[h][i];
            PG8_LDB(B0, 0, 0); PG8_SCHED; PG8_LDA(At, 0, 0); PG8_STAGE(PG8_SA(1, 1), a1, voC[1]);
            PG8_WAIT_L(8); PG8_BAR; PG8_WAIT_L(0); PG8_MMA(0, 0, At, B0); PG8_BAR; PG8_SCHED;
            PG8_LDB(B1, 0, 1); PG8_STAGE(PG8_SB(0, 0), b2, voffB);
            PG8_BAR; PG8_WAIT_L(0); PG8_MMA(0, 1, At, B1); PG8_BAR;
            PG8_LDA(At, 0, 1); PG8_STAGE(PG8_SA(0, 0), a2, v2[0]);
            PG8_BAR; PG8_WAIT_L(0); PG8_MMA(1, 0, At, B0); PG8_BAR; PG8_SCHED;
            PG8_STAGE(PG8_SB(0, 1), b2 + hstepB, voffB);
            PG8_WAIT_V(6); PG8_BAR; PG8_MMA(1, 1, At, B1); PG8_BAR;
            PG8_LDB(B0, 1, 0); PG8_SCHED; PG8_LDA(At, 1, 0); PG8_STAGE(PG8_SA(0, 1), a2, v2[1]);
            PG8_WAIT_L(8); PG8_BAR; PG8_WAIT_L(0); PG8_MMA(0, 0, At, B0); PG8_BAR; PG8_SCHED;
            PG8_LDB(B1, 1, 1); PG8_STAGE(PG8_SB(1, 0), b3, voffB);
            PG8_BAR; PG8_WAIT_L(0); PG8_MMA(0, 1, At, B1); PG8_BAR;
            PG8_LDA(At, 1, 1); PG8_STAGE(PG8_SA(1, 0), a3, v2[0]);
            PG8_BAR; PG8_WAIT_L(0); PG8_MMA(1, 0, At, B0); PG8_BAR; PG8_SCHED;
            PG8_STAGE(PG8_SB(1, 1), b3 + hstepB, voffB);
            PG8_WAIT_V(6); PG8_BAR; PG8_MMA(1, 1, At, B1); PG8_BAR;
        }
        if constexpr (F8) asm volatile("s_nop 15\n\ts_nop 15\n\ts_nop 7" ::: "memory");
        E(acc, cur, wr, wc, fr, fq);
        if (!has_next) break;
#pragma unroll
        for (int a = 0; a < 2; ++a)
#pragma unroll
            for (int b = 0; b < 2; ++b)
#pragma unroll
                for (int m = 0; m < 4; ++m)
#pragma unroll
                    for (int n = 0; n < 2; ++n) acc[a][b][m][n] = (f32x4){0.f, 0.f, 0.f, 0.f};
        cur = nxt; cA = nA; cB = nB; ++ui;
#pragma unroll
        for (int h = 0; h < 2; ++h)
#pragma unroll
            for (int i = 0; i < 2; ++i) voC[h][i] = voN[h][i];
    }
    PG8_WAIT_V(0);
    if (wr == 0) PG8_BAR;
    PG8_BAR;
#undef PG8_SA
#undef PG8_SB
#undef PG8_STAGE
#undef PG8_LDA
#undef PG8_LDB
#undef PG8_MMA
#undef PG8_WAIT_V
#undef PG8_WAIT_L
#undef PG8_BAR
#undef PG8_SCHED
#undef PG8_MKOFF
}
}

__device__ __forceinline__ unsigned pk4_fp8(float a, float b, float c, float d) { int w = 0; w = __builtin_amdgcn_cvt_pk_fp8_f32(a, b, w, false); w = __builtin_amdgcn_cvt_pk_fp8_f32(c, d, w, true); return (unsigned)w; }
constexpr float W8_SCALE = 32.f;
struct EpiBf16 {
    static constexpr bool PERM = true;
    bf16_t* O; int ldc; const float* colscale; int nt; float sc;
    __device__ __forceinline__ void operator()(const f32x4 (&acc)[2][2][4][2], const pg8::Unit& u, int wr, int wc, int fr, int fq) const {
        const int col0 = u.pn * 256 + wc * 32 + 8 * fq;
        f32x4 scv[2][2];
#pragma unroll
        for (int bj = 0; bj < 2; ++bj) { scv[bj][0] = colscale ? *(const f32x4*)(colscale + col0 + bj * 128) : (f32x4){1.f, 1.f, 1.f, 1.f}; scv[bj][1] = colscale ? *(const f32x4*)(colscale + col0 + bj * 128 + 4) : (f32x4){1.f, 1.f, 1.f, 1.f}; scv[bj][0] *= sc; scv[bj][1] *= sc; }
#pragma unroll
        for (int ai = 0; ai < 2; ++ai)
#pragma unroll
            for (int m = 0; m < 4; ++m) { bf16_t* rowp = O + (size_t)(u.m0 + ai * 128 + wr * 64 + m * 16 + fr) * ldc + col0;
#pragma unroll
                for (int bj = 0; bj < 2; ++bj) { const f32x4 v0 = acc[ai][bj][m][0] * scv[bj][0], v1 = acc[ai][bj][m][1] * scv[bj][1];
                    u32x4 w; w.x = cvt_pk_bf16(v0[0], v0[1]); w.y = cvt_pk_bf16(v0[2], v0[3]); w.z = cvt_pk_bf16(v1[0], v1[1]); w.w = cvt_pk_bf16(v1[2], v1[3]);
                    if (nt) __builtin_nontemporal_store(w, (u32x4*)(rowp + bj * 128)); else *(u32x4*)(rowp + bj * 128) = w; } }
    }
};
constexpr float Y8_SCALE = 16.f;
static_assert(L0F8 >= 1, "the combine (LN2) reads e4m3 Y rows: both layers' down projections must run on the fp8 path");
struct EpiY8 {
    static constexpr bool PERM = true;
    unsigned char* O; float sc;
    __device__ __forceinline__ void operator()(const f32x4 (&acc)[2][2][4][2], const pg8::Unit& u, int wr, int wc, int fr, int fq) const {
        const int odd = fq & 1, colb = u.pn * 256 + wc * 32 + 8 * (fq - odd) + odd * 128;
#pragma unroll
        for (int ai = 0; ai < 2; ++ai)
#pragma unroll
            for (int m = 0; m < 4; ++m) { unsigned char* rowp = O + (size_t)(u.m0 + ai * 128 + wr * 64 + m * 16 + fr) * DM + colb;
                const f32x4 x0 = acc[ai][0][m][0] * sc, x1 = acc[ai][0][m][1] * sc, z0 = acc[ai][1][m][0] * sc, z1 = acc[ai][1][m][1] * sc;
                const unsigned xa = pk4_fp8(x0[0], x0[1], x0[2], x0[3]), xb = pk4_fp8(x1[0], x1[1], x1[2], x1[3]), za = pk4_fp8(z0[0], z0[1], z0[2], z0[3]), zb = pk4_fp8(z1[0], z1[1], z1[2], z1[3]);
                const auto r0 = __builtin_amdgcn_permlane16_swap(xa, za, false, false), r1 = __builtin_amdgcn_permlane16_swap(xb, zb, false, false);
                const u32x4 w = {r0[0], r1[0], r0[1], r1[1]};
                __builtin_nontemporal_store(w, (u32x4*)rowp); }
    }
};
struct EpiZ {
    static constexpr bool PERM = true;
    const float* resf; const bf16_t* resb; bf16_t* out;
    __device__ __forceinline__ void operator()(const f32x4 (&acc)[2][2][4][2], const pg8::Unit& u, int wr, int wc, int fr, int fq) const {
        const int col0 = u.pn * 256 + wc * 32 + 8 * fq;
#pragma unroll
        for (int ai = 0; ai < 2; ++ai)
#pragma unroll
            for (int mp = 0; mp < 2; ++mp) { f32x4 r[2][2][2];
#pragma unroll
                for (int mm = 0; mm < 2; ++mm) { const size_t off = (size_t)(u.m0 + ai * 128 + wr * 64 + (mp * 2 + mm) * 16 + fr) * DM + col0;
#pragma unroll
                    for (int bj = 0; bj < 2; ++bj) {
                        if (resf) { r[mm][bj][0] = *(const f32x4*)(resf + off + bj * 128); r[mm][bj][1] = *(const f32x4*)(resf + off + bj * 128 + 4); }
                        else { const u32x4 w = *(const u32x4*)(resb + off + bj * 128); r[mm][bj][0] = (f32x4){bf_lo(w.x), bf_hi(w.x), bf_lo(w.y), bf_hi(w.y)}; r[mm][bj][1] = (f32x4){bf_lo(w.z), bf_hi(w.z), bf_lo(w.w), bf_hi(w.w)}; } } }
#pragma unroll
                for (int mm = 0; mm < 2; ++mm) { const size_t off = (size_t)(u.m0 + ai * 128 + wr * 64 + (mp * 2 + mm) * 16 + fr) * DM + col0;
#pragma unroll
                    for (int bj = 0; bj < 2; ++bj) { const f32x4 z0 = r[mm][bj][0] * ALPHA + acc[ai][bj][mp * 2 + mm][0], z1 = r[mm][bj][1] * ALPHA + acc[ai][bj][mp * 2 + mm][1];
                        *(u32x4*)(out + off + bj * 128) = (u32x4){cvt_pk_bf16(z0[0], z0[1]), cvt_pk_bf16(z0[2], z0[3]), cvt_pk_bf16(z1[0], z1[1]), cvt_pk_bf16(z1[2], z1[3])}; } }
                asm volatile("" ::: "memory"); }
    }
};
struct EpiSwiGLU {
    static constexpr bool PERM = true;
    bf16_t* H; float sc; int f8;
    __device__ __forceinline__ void operator()(const f32x4 (&acc)[2][2][4][2], const pg8::Unit& u, int wr, int wc, int fr, int fq) const {
        const int col0 = u.pn * 128 + wc * 32 + 8 * fq;
#pragma unroll
        for (int ai = 0; ai < 2; ++ai)
#pragma unroll
            for (int m = 0; m < 4; ++m) { bf16_t* rowp = H + (size_t)(u.m0 + ai * 128 + wr * 64 + m * 16 + fr) * ED + col0;
                float h[8];
#pragma unroll
                for (int n = 0; n < 2; ++n)
#pragma unroll
                    for (int j = 0; j < 4; ++j) { const float g = acc[ai][0][m][n][j] * sc, up = acc[ai][1][m][n][j] * sc;
                        h[n * 4 + j] = g * __builtin_amdgcn_rcpf(1.f + __expf(-g)) * up; }
                if (f8) { *(u32x2*)((unsigned char*)H + (size_t)(u.m0 + ai * 128 + wr * 64 + m * 16 + fr) * ED + col0) = (u32x2){pk4_fp8(h[0], h[1], h[2], h[3]), pk4_fp8(h[4], h[5], h[6], h[7])}; }
                else { u32x4 w; w.x = cvt_pk_bf16(h[0], h[1]); w.y = cvt_pk_bf16(h[2], h[3]); w.z = cvt_pk_bf16(h[4], h[5]); w.w = cvt_pk_bf16(h[6], h[7]);
                *(u32x4*)rowp = w; } }
    }
};
struct EpiUp {
    static constexpr bool PERM = true;
    bf16_t* Q; bf16_t* Kb; bf16_t* V; const float* rstat; const f32x2* rope;
    __device__ __forceinline__ void operator()(const f32x4 (&acc)[2][2][4][2], const pg8::Unit& u, int wr, int wc, int fr, int fq) const {
        const int pn = u.pn;
        const float* rs = rstat + (pn < 16 ? 0 : T);
        float rsc[2][4];
#pragma unroll
        for (int ai = 0; ai < 2; ++ai)
#pragma unroll
            for (int m = 0; m < 4; ++m) rsc[ai][m] = rs[u.m0 + ai * 128 + wr * 64 + m * 16 + fr];
#pragma unroll
        for (int ai = 0; ai < 2; ++ai)
#pragma unroll
            for (int m = 0; m < 4; ++m) { const int row = u.m0 + ai * 128 + wr * 64 + m * 16 + fr; const float r = rsc[ai][m];
                if (pn < 24) {
#pragma unroll
                    for (int bj = 0; bj < 2; ++bj) { const f32x4 v0 = acc[ai][bj][m][0] * r, v1 = acc[ai][bj][m][1] * r;
                        u32x4 w; w.x = cvt_pk_bf16(v0[0], v0[1]); w.y = cvt_pk_bf16(v0[2], v0[3]); w.z = cvt_pk_bf16(v1[0], v1[1]); w.w = cvt_pk_bf16(v1[2], v1[3]);
                        const int d = wc * 32 + 8 * fq;
                        bf16_t* p;
                        if (pn < 8) p = Kb + (size_t)row * (NH * DQK) + (2 * pn + bj) * DQK + d;
                        else if (pn < 16) p = V + (size_t)row * DM + (pn - 8) * 256 + bj * 128 + d;
                        else p = Q + (size_t)row * (NH * DQK) + (2 * (pn - 16) + bj) * DQK + d;
                        *(u32x4*)p = w; }
                } else {
                    const int head = 4 * (pn - 24) + wc, i0 = 8 * fq, s = row & (SEQ - 1);
                    const f32x4* cs = (const f32x4*)(rope + (size_t)s * 32 + i0);
                    float o1[8], o2[8];
#pragma unroll
                    for (int q = 0; q < 4; ++q) { const f32x4 c2 = cs[q];
                        const int n = q >> 1, j = (q & 1) * 2;
                        const float x1a = acc[ai][0][m][n][j] * r, x2a = acc[ai][1][m][n][j] * r, x1b = acc[ai][0][m][n][j + 1] * r, x2b = acc[ai][1][m][n][j + 1] * r;
                        o1[2 * q] = x1a * c2[0] - x2a * c2[1]; o2[2 * q] = x2a * c2[0] + x1a * c2[1];
                        o1[2 * q + 1] = x1b * c2[2] - x2b * c2[3]; o2[2 * q + 1] = x2b * c2[2] + x1b * c2[3]; }
                    bf16_t* p = Q + (size_t)row * (NH * DQK) + head * DQK + 128 + i0;
                    u32x4 w; w.x = cvt_pk_bf16(o1[0], o1[1]); w.y = cvt_pk_bf16(o1[2], o1[3]); w.z = cvt_pk_bf16(o1[4], o1[5]); w.w = cvt_pk_bf16(o1[6], o1[7]);
                    *(u32x4*)p = w;
                    w.x = cvt_pk_bf16(o2[0], o2[1]); w.y = cvt_pk_bf16(o2[2], o2[3]); w.z = cvt_pk_bf16(o2[4], o2[5]); w.w = cvt_pk_bf16(o2[6], o2[7]);
                    *(u32x4*)(p + 32) = w;
                } }
    }
};

struct DenseSched {
    static constexpr bool FP8 = false;
    pg8::TileOrder ord; const char* A; const char* B; int lda_b, K; int mode;
    size_t agrp;
    __device__ __forceinline__ bool next(int i, pg8::Unit& u) const {
        int pm, pn; if (!ord.next(i, pm, pn)) return false;
        size_t ao = 0;
        if (mode == 1) ao = (size_t)(pn >> 1) * agrp; else if (mode == 2) ao = pn >= 16 ? 1024 : 0;
        u.A = A + ao + (size_t)pm * 256 * lda_b; u.B = B + (size_t)pn * 256 * K * 2; u.rows = nullptr; u.m0 = pm * 256; u.pn = pn; u.aux = 0;
        return true;
    }
};
template <bool F8_> struct MoeSchedT {
    static constexpr bool FP8 = F8_;
    const int* mte; const int* rowidx; const char* A; const char* W; int nunits, npn, G, c, gather; size_t wexp, wtile, atile; int i0, i1;
    __device__ __forceinline__ bool next(int i, pg8::Unit& u) const {
        if (i + i0 >= i1) return false;
        const int L = (i + i0) * G + c; if (L >= nunits) return false;
        const int mt = L / npn, pn = L - mt * npn; const int e = __builtin_amdgcn_readfirstlane(mte[mt]);
        u.A = gather ? A : A + (size_t)mt * atile; u.rows = gather ? rowidx + mt * 256 : nullptr;
        u.B = W + (size_t)e * wexp + (size_t)pn * wtile; u.m0 = mt * 256; u.pn = pn; u.aux = e;
        return true;
    }
};

typedef MoeSchedT<false> MoeSched;

namespace att {
constexpr int NW = 8, QBLK = 32, KVBLK = 64, QB = NW * QBLK;
constexpr int QS = NH * DQK, KS = NH * DQK, VS = DM, OS = DM;
constexpr int SHM_V = KVBLK * DV * 2, SHM_K = KVBLK * DQK * 2;
constexpr int ATT_LDS = 2 * SHM_V + 2 * SHM_K + NW * 64 * 4;
constexpr float SCALE = 0.07216878364870322f;
constexpr float THR = 8.f;
typedef LAS char* lptr;
#define KSWZ(row, colB) ((row) * 384 + ((colB) ^ ((((row) >> 1) & 7) << 4)))
#define SBAR() __builtin_amdgcn_sched_barrier(0)
__device__ __forceinline__ int v_st(int k, int c) { const int kk = (k & ~0xC) | ((k & 4) << 1) | ((k & 8) >> 1); return ((kk >> 3) * 4 + (c >> 5)) * 512 + ((kk & 7) * 32 + (c & 31)) * 2; }
__device__ __forceinline__ int v_rd_base(int lane) { return ((lane & 3) << 3) | (((lane >> 2) & 3) << 6) | (((lane >> 4) & 1) << 5) | (((lane >> 5) & 1) << 8); }
constexpr int v_rd_off(int d0, int ks, int half) { return d0 * 512 + ks * 4096 + half * 2048; }
__device__ __forceinline__ int crow(int r, int hi) { return (r & 3) + 8 * (r >> 2) + 4 * hi; }
__device__ __forceinline__ bf16x8 ld8(const bf16_t* p) { return *reinterpret_cast<const bf16x8*>(p); }
__device__ __forceinline__ void mask_tile(f32x16& p0, f32x16& p1, int dq) {
    const float NEG = -__builtin_inff();
#pragma unroll
    for (int r = 0; r < 16; ++r) {
        const int c = (r & 3) + 8 * (r >> 2);
        if (dq - c < 0) p0[r] = NEG;
        if (dq - c - 32 < 0) p1[r] = NEG;
    }
}
__device__ __forceinline__ void partialSM(f32x16& p0, f32x16& p1, float& m_reg, float& mn, float& alpha) {
    float pmax = p0[0];
#pragma unroll
    for (int r = 1; r < 16; ++r) pmax = fmaxf(pmax, p0[r]);
#pragma unroll
    for (int r = 0; r < 16; ++r) pmax = fmaxf(pmax, p1[r]);
    { auto rr = __builtin_amdgcn_permlane32_swap(__float_as_uint(pmax), __float_as_uint(pmax), false, false);
      pmax = fmaxf(__uint_as_float(rr[0]), __uint_as_float(rr[1])); }
    constexpr float C2 = 1.4426950408889634f * SCALE;
    if (__builtin_expect(__all((pmax - m_reg) * SCALE <= THR), 1)) { mn = m_reg; alpha = 1.f; }
    else { mn = fmaxf(m_reg, pmax); alpha = __builtin_amdgcn_exp2f((m_reg - mn) * C2); m_reg = mn; }
    const float mnL = -mn * C2;
#pragma unroll
    for (int r = 0; r < 16; ++r) p0[r] = fmaf(p0[r], C2, mnL);
#pragma unroll
    for (int r = 0; r < 16; ++r) p1[r] = fmaf(p1[r], C2, mnL);
#pragma unroll
    for (int r = 0; r < 16; ++r) p0[r] = __builtin_amdgcn_exp2f(p0[r]);
}
__device__ __forceinline__ void finishSM(f32x16& p0, f32x16& p1, float alpha, float& l_reg, bf16x8& pa0, bf16x8& pa1, bf16x8& pa2, bf16x8& pa3) {
#pragma unroll
    for (int r = 0; r < 16; ++r) p1[r] = __builtin_amdgcn_exp2f(p1[r]);
    float ps = 0;
#pragma unroll
    for (int r = 0; r < 16; ++r) ps += p0[r];
#pragma unroll
    for (int r = 0; r < 16; ++r) ps += p1[r];
    { auto rr = __builtin_amdgcn_permlane32_swap(__float_as_uint(ps), __float_as_uint(ps), false, false);
      ps = __uint_as_float(rr[0]) + __uint_as_float(rr[1]); }
    l_reg = l_reg * alpha + ps;
#define PK4(P, B_, OUT) do { unsigned a0 = cvt_pk_bf16(P[B_+0], P[B_+1]), a1 = cvt_pk_bf16(P[B_+2], P[B_+3]);                          \
        unsigned b0 = cvt_pk_bf16(P[B_+4], P[B_+5]), b1 = cvt_pk_bf16(P[B_+6], P[B_+7]);                                             \
        auto r0 = __builtin_amdgcn_permlane32_swap(a0, b0, false, false); auto r1 = __builtin_amdgcn_permlane32_swap(a1, b1, false, false); \
        u32x4 w = {r0[0], r1[0], r0[1], r1[1]}; OUT = *reinterpret_cast<bf16x8*>(&w); } while (0)
    PK4(p0, 0, pa0); PK4(p0, 8, pa1); PK4(p1, 0, pa2); PK4(p1, 8, pa3);
#undef PK4
}
template <int KB>
__device__ __forceinline__ void qkt(f32x16& p0, f32x16& p1, lptr K_lds, int r32, int hi, const bf16x8* qr) {
    p0 = f32x16{}; p1 = f32x16{};
    lptr kb[4];
#pragma unroll
    for (int dd = 0; dd < 4; ++dd) kb[dd] = K_lds + KB * SHM_K + KSWZ(r32, (dd * 16 + hi * 8) * 2);
#pragma unroll
    for (int d0 = 0; d0 < 12; ++d0) { lptr a = kb[d0 & 3] + (d0 >> 2) * 128;
        bf16x8 b0 = *reinterpret_cast<const LAS bf16x8*>(a);
        bf16x8 b1 = *reinterpret_cast<const LAS bf16x8*>(a + 32 * 384);
        p0 = __builtin_amdgcn_mfma_f32_32x32x16_bf16(b0, qr[d0], p0, 0, 0, 0);
        p1 = __builtin_amdgcn_mfma_f32_32x32x16_bf16(b1, qr[d0], p1, 0, 0, 0); }
}
template <int VB>
__device__ __forceinline__ void pv_tile(f32x16* o, int vb0, bf16x8 pa0, bf16x8 pa1, bf16x8 pa2, bf16x8 pa3) {
#define TRRD(dst, off) asm volatile("ds_read_b64_tr_b16 %0, %1 offset:%2" : "=&v"(dst) : "v"(vb0), "i"(off) : "memory")
#define PV_D0(d0) do { s16x4 l0, l1, l2, l3, h0, h1, h2, h3; constexpr int b_ = VB * SHM_V + v_rd_off(d0, 0, 0); \
        TRRD(l0, b_); TRRD(h0, b_ + 2048); TRRD(l1, b_ + 4096); TRRD(h1, b_ + 6144); TRRD(l2, b_ + 8192); TRRD(h2, b_ + 10240); TRRD(l3, b_ + 12288); TRRD(h3, b_ + 14336); \
        asm volatile("s_waitcnt lgkmcnt(0)" ::: "memory"); SBAR();   \
        o[d0] = __builtin_amdgcn_mfma_f32_32x32x16_bf16(pa0, (bf16x8){l0[0], l0[1], l0[2], l0[3], h0[0], h0[1], h0[2], h0[3]}, o[d0], 0, 0, 0);   \
        o[d0] = __builtin_amdgcn_mfma_f32_32x32x16_bf16(pa1, (bf16x8){l1[0], l1[1], l1[2], l1[3], h1[0], h1[1], h1[2], h1[3]}, o[d0], 0, 0, 0);   \
        o[d0] = __builtin_amdgcn_mfma_f32_32x32x16_bf16(pa2, (bf16x8){l2[0], l2[1], l2[2], l2[3], h2[0], h2[1], h2[2], h2[3]}, o[d0], 0, 0, 0);   \
        o[d0] = __builtin_amdgcn_mfma_f32_32x32x16_bf16(pa3, (bf16x8){l3[0], l3[1], l3[2], l3[3], h3[0], h3[1], h3[2], h3[3]}, o[d0], 0, 0, 0); } while (0)
    PV_D0(0); PV_D0(1); PV_D0(2); PV_D0(3);
#undef PV_D0
#undef TRRD
}
struct BlockRef { const bf16_t* Q; const bf16_t* K; const bf16_t* V; bf16_t* O; int P0; };
struct Seam { bf16x8 qr[12]; };
#define VMW() asm volatile("s_waitcnt vmcnt(0)" ::: "memory")
#define VMWN(n) asm volatile("s_waitcnt vmcnt(%0)" :: "i"(n) : "memory")
#define SLOAD_H(Kp, Vp, k0) do { st_v0 = ld8((Vp) + (size_t)((k0) + sr) * VS + sc); st_v1 = ld8((Vp) + (size_t)((k0) + 32 + sr) * VS + sc); \
        const bf16_t* kp_ = (Kp) + (size_t)((k0) + krow) * KS + kc8; st_k0 = ld8(kp_); st_k1 = ld8(kp_ + 64); st_k2 = ld8(kp_ + 128); } while (0)
#define SWRITE_H(bf) do { lptr kd_ = K_lds + (bf) * SHM_K + kws; *(LAS bf16x8*)kd_ = st_k0; *(LAS bf16x8*)(kd_ + 128) = st_k1; *(LAS bf16x8*)(kd_ + 256) = st_k2; \
        *(LAS bf16x8*)(V_lds + (bf) * SHM_V + vst0) = st_v0; *(LAS bf16x8*)(V_lds + (bf) * SHM_V + vst1) = st_v1; } while (0)
__device__ __forceinline__ void attn_prime(const BlockRef& cur, lptr lds, Seam& S) {
    const int tid = threadIdx.x, wid = __builtin_amdgcn_readfirstlane(tid >> 6), lane = tid & 63, r32 = lane & 31, hi = lane >> 5;
    const int sr = tid >> 4, sc = (tid & 15) * 8, vst0 = v_st(sr, sc), vst1 = v_st(32 + sr, sc), krow = tid >> 3, kc8 = (tid & 7) * 8, kws = KSWZ(krow, (tid & 7) * 16);
    lptr V_lds = lds; lptr K_lds = lds + 2 * SHM_V;
    bf16x8 st_v0, st_v1, st_k0, st_k1, st_k2;
#pragma unroll
    for (int d0 = 0; d0 < 12; ++d0) S.qr[d0] = ld8(cur.Q + (size_t)(wid * QBLK + r32) * QS + d0 * 16 + hi * 8);
    SLOAD_H(cur.K, cur.V, 0); VMW(); SWRITE_H(0);
    __syncthreads();
}
__device__ __forceinline__ void attn_block(const BlockRef& cur, const BlockRef& nxt, lptr lds, Seam& S) {
    const int tid = threadIdx.x, wid = __builtin_amdgcn_readfirstlane(tid >> 6), lane = tid & 63, r32 = lane & 31, hi = lane >> 5;
    const int NT = cur.P0 / KVBLK + QB / KVBLK;
    const int qlo = cur.P0 + wid * QBLK, qm = qlo + r32 - 4 * hi;
    lptr V_lds = lds; lptr K_lds = lds + 2 * SHM_V;
    LAS float* ws = (LAS float*)(lds + 2 * SHM_V + 2 * SHM_K) + wid * 64; LAS float* li_l = ws; LAS float* al_l = ws + 32;
    float m_reg = -1e30f, l_reg = 0; f32x16 o[4] = {};
    const int sr = tid >> 4, sc = (tid & 15) * 8, vst0 = v_st(sr, sc), vst1 = v_st(32 + sr, sc);
    const int krow = tid >> 3, kc8 = (tid & 7) * 8, kws = KSWZ(krow, (tid & 7) * 16);
    const int vb0 = (int)(unsigned)(uintptr_t)V_lds + v_rd_base(lane);
    const bf16_t* Kh = cur.K; const bf16_t* Vh = cur.V;
    bf16x8 st_v0, st_v1, st_k0, st_k1, st_k2;
#define RESC(a) do { if (__any((a) < 1.f)) { if (hi == 0) al_l[r32] = (a); asm volatile("s_waitcnt lgkmcnt(0)" ::: "memory");              \
                     _Pragma("unroll") for (int d_ = 0; d_ < 4; ++d_) _Pragma("unroll") for (int r = 0; r < 16; ++r) o[d_][r] *= al_l[crow(r, hi)]; } } while (0)
#define MASKT(P0_, P1_, t) do { const int kb_ = (t) * KVBLK; if (kb_ + KVBLK - 1 > qlo) mask_tile(P0_, P1_, qm - kb_); } while (0)
#define STEP(t, BF) do { f32x16 p0, p1; float mn, al; bf16x8 pa0, pa1, pa2, pa3;                                     \
        const bool lastt = (t) + 1 == NT;                                                                               \
        if (!lastt) { SLOAD_H(Kh, Vh, ((t) + 1) * KVBLK); } else { SLOAD_H(nxt.K, nxt.V, 0); }                          \
        SBAR(); qkt<BF>(p0, p1, K_lds, r32, hi, S.qr); SBAR();                                                         \
        if (lastt) { _Pragma("unroll") for (int d0 = 0; d0 < 12; ++d0) S.qr[d0] = ld8(nxt.Q + (size_t)(wid * QBLK + r32) * QS + d0 * 16 + hi * 8); SBAR(); } \
        MASKT(p0, p1, (t)); partialSM(p0, p1, m_reg, mn, al); RESC(al);                                                \
        finishSM(p0, p1, al, l_reg, pa0, pa1, pa2, pa3); SBAR();                                                       \
        pv_tile<BF>(o, vb0, pa0, pa1, pa2, pa3); SBAR();                                                               \
        if (lastt) { VMWN(12); SWRITE_H(0); } else { VMW(); SWRITE_H(1 - (BF)); }                                       \
        if (!lastt) __syncthreads(); } while (0)
    for (int t = 0; t < NT; t += 2) { STEP(t, 0); STEP(t + 1, 1); }
    if (hi == 0) li_l[r32] = l_reg; asm volatile("s_waitcnt lgkmcnt(0)" ::: "memory");
    float rli[16];
#pragma unroll
    for (int r = 0; r < 16; ++r) rli[r] = __builtin_amdgcn_rcpf(li_l[crow(r, hi)]);
    bf16_t* Ow = cur.O + (size_t)(wid * QBLK) * OS;
#pragma unroll
    for (int r = 0; r < 16; ++r) { const int orow = crow(r, hi);
#pragma unroll
        for (int d0 = 0; d0 < 4; ++d0) { const float v = o[d0][r] * rli[r];
            const float vn = __shfl_xor(v, 1);
            if ((r32 & 1) == 0) *(unsigned*)(Ow + (size_t)orow * OS + d0 * 32 + r32) = cvt_pk_bf16(v, vn); } }
    __syncthreads();
#undef RESC
#undef MASKT
#undef STEP
}
#undef VMW
#undef VMWN
#undef SLOAD_H
#undef SWRITE_H
#undef KSWZ
#undef SBAR
__device__ __forceinline__ BlockRef make_ref(int L, int pass, const bf16_t* Q, const bf16_t* K, const bf16_t* V, bf16_t* O) {
    const int bh = L >> 3, x = L & 7, qb = pass ? 15 - x : x, b = bh >> 4, h = bh & 15;
    BlockRef r; const size_t row0 = (size_t)b * SEQ;
    r.Q = Q + (row0 + (size_t)qb * QB) * QS + h * DQK; r.O = O + (row0 + (size_t)qb * QB) * OS + h * DV;
    r.K = K + row0 * KS + h * DQK; r.V = V + row0 * VS + h * DV; r.P0 = qb * QB;
    return r;
}
template <class Hook>
__device__ __forceinline__ void attn_phase(lptr lds, const bf16_t* Q, const bf16_t* K, const bf16_t* V, bf16_t* O, int vcu, int G, const Hook& hook) {
    constexpr int TOTAL = NBATCH * NH * 8;
    const int slot = (vcu >> 5) % 3;
    int L = vcu; if (L >= TOTAL) { hook(); return; }
    if (slot == 0) hook();
    int pass = 0, nblk = 0;
    BlockRef cur = make_ref(L, 0, Q, K, V, O);
    Seam S;
    attn_prime(cur, lds, S);
    for (;;) {
        const bool more_pass = pass == 0, more_item = L + G < TOTAL, last = !more_pass && !more_item;
        int passn = pass + 1, Ln = L;
        if (!more_pass) { passn = 0; Ln = more_item ? L + G : L; }
        const BlockRef nxt = last ? cur : make_ref(Ln, passn, Q, K, V, O);
        attn_block(cur, nxt, lds, S);
        ++nblk;
        if (nblk == 1 && slot == 1) hook();
        if (last) break;
        cur = nxt; pass = passn; L = Ln;
    }
    if (slot == 2 || (slot == 1 && nblk < 1)) hook();
}
}

struct KArgs { const float* in[25]; float* out; unsigned char* ws; int ph_lo, ph_hi; };
enum { I_X = 0, I_AWIN, I_AWGRP, I_ASCALE, I_AWOUT, I_KVWD, I_KVNORM, I_KVWUK, I_KVWUV, I_BWDQ, I_BQNORM, I_BWUQ, I_BWOUT, I_LN1G, I_LN1B, I_LN2G, I_LN2B,
       I_RW, I_RB, I_EWG, I_EWU, I_EWD, I_SWG, I_SWU, I_SWD };

__device__ __forceinline__ void tr_item(const float* W, int ldw, int k0, int n0, bf16_t* WT, int K, int drow0, const float* kscale, LAS float* scr, int lane) {
    const int c = lane & 7;
    f32x4 sa = {1.f, 1.f, 1.f, 1.f}, sb = sa;
    if (kscale) { sa = *(const f32x4*)(kscale + k0 + 8 * c); sb = *(const f32x4*)(kscale + k0 + 8 * c + 4); }
#pragma unroll 8
    for (int i = 0; i < 32; ++i) { const int kk = 2 * i + (lane >> 5); scr[kk * 33 + (lane & 31)] = W[(size_t)(k0 + kk) * ldw + n0 + (lane & 31)]; }
    LDS_WAIT(); asm volatile("" ::: "memory");
#pragma unroll
    for (int j = 0; j < 4; ++j) { const int n = (lane >> 3) + 8 * j; const LAS float* sp = scr + (8 * c) * 33 + n;
        u32x4 o; o.x = cvt_pk_bf16(sp[0 * 33] * sa[0], sp[1 * 33] * sa[1]); o.y = cvt_pk_bf16(sp[2 * 33] * sa[2], sp[3 * 33] * sa[3]); o.z = cvt_pk_bf16(sp[4 * 33] * sb[0], sp[5 * 33] * sb[1]); o.w = cvt_pk_bf16(sp[6 * 33] * sb[2], sp[7 * 33] * sb[3]);
        *(u32x4*)(WT + (size_t)(drow0 + n) * K + k0 + 8 * c) = o; }
    LDS_WAIT(); asm volatile("" ::: "memory");
}
struct TrItem { const float* src; bf16_t* dst; int ldw, Kd, k0, n0, gu, p; };
__device__ __forceinline__ void bg_decode(const KArgs& a, int kind  , int l, int it, TrItem& I) {
    unsigned char* ws = a.ws;
    if (kind == 0 || kind == 2) { const int e = it >> 9, q = it & 511, up = q >> 8, qq = q & 255;
        I.src = e < 64 ? a.in[up ? I_EWU : I_EWG] + (size_t)(l * 64 + e) * 2048 * 512 : a.in[up ? I_SWU : I_SWG] + (size_t)l * 2048 * 512;
        I.ldw = 512; I.k0 = (qq >> 3) * 64; I.n0 = (qq & 7) * 64; I.dst = (bf16_t*)(ws + WS_WGU + (size_t)l * 65 * 1024 * 2048 * 2 + (size_t)e * 1024 * 2048 * (kind == 2 ? 1 : 2)); I.Kd = 2048; I.gu = 1; I.p = up ? 128 : 0;
    } else { const int e = it >> 8, qq = it & 255;
        I.src = e < 64 ? a.in[I_EWD] + (size_t)(l * 64 + e) * 512 * 2048 : a.in[I_SWD] + (size_t)l * 512 * 2048;
        I.ldw = 2048; I.k0 = (qq >> 5) * 64; I.n0 = (qq & 31) * 64; I.dst = (bf16_t*)(ws + WS_WD + (size_t)l * 65 * 2048 * 512 * 2 + (size_t)e * 2048 * 512 * (kind == 3 ? 1 : 2)); I.Kd = 512; I.gu = 0; I.p = 0; }
}
__device__ __forceinline__ void bg_load(const TrItem& I, f32x4 (&v)[16], int lane) {
    const float* p = I.src + (size_t)(I.k0 + 16 * (lane >> 4)) * I.ldw + I.n0 + 4 * (lane & 15);
#pragma unroll
    for (int i = 0; i < 16; ++i) v[i] = __builtin_nontemporal_load((const f32x4*)(p + (size_t)i * I.ldw));
}
__device__ __forceinline__ void bg_emit(const TrItem& I, const f32x4 (&v)[16], LAS unsigned* scr, int lane) {
    const int n4 = lane & 15, kq = lane >> 4;
#pragma unroll
    for (int q = 0; q < 4; ++q)
#pragma unroll
        for (int h = 0; h < 2; ++h) { u32x4 o; o.x = cvt_pk_bf16(v[8 * h + 0][q], v[8 * h + 1][q]); o.y = cvt_pk_bf16(v[8 * h + 2][q], v[8 * h + 3][q]); o.z = cvt_pk_bf16(v[8 * h + 4][q], v[8 * h + 5][q]); o.w = cvt_pk_bf16(v[8 * h + 6][q], v[8 * h + 7][q]);
            *(LAS u32x4*)(scr + (4 * n4 + q) * 36 + 8 * kq + 4 * h) = o; }
    LDS_WAIT(); asm volatile("" ::: "memory");
    const int c = lane & 7;
#pragma unroll
    for (int jj = 0; jj < 8; ++jj) { const int r = (lane >> 3) + 8 * jj, n = I.n0 + r; const u32x4 o = *(const LAS u32x4*)(scr + r * 36 + 4 * c);
        const int drow = I.gu ? (n >> 7) * 256 + I.p + (n & 127) : n;
        *(u32x4*)(I.dst + (size_t)drow * I.Kd + I.k0 + 8 * c) = o; }
    LDS_WAIT(); asm volatile("" ::: "memory");
}
__device__ __forceinline__ void bg_emit8(const TrItem& I, const f32x4 (&v)[16], LAS unsigned* scr, int lane) {
    const int n4 = lane & 15, kq = lane >> 4;
#pragma unroll
    for (int q = 0; q < 4; ++q) { u32x4 o;
        o.x = pk4_fp8(v[0][q] * W8_SCALE, v[1][q] * W8_SCALE, v[2][q] * W8_SCALE, v[3][q] * W8_SCALE); o.y = pk4_fp8(v[4][q] * W8_SCALE, v[5][q] * W8_SCALE, v[6][q] * W8_SCALE, v[7][q] * W8_SCALE);
        o.z = pk4_fp8(v[8][q] * W8_SCALE, v[9][q] * W8_SCALE, v[10][q] * W8_SCALE, v[11][q] * W8_SCALE); o.w = pk4_fp8(v[12][q] * W8_SCALE, v[13][q] * W8_SCALE, v[14][q] * W8_SCALE, v[15][q] * W8_SCALE);
        *(LAS u32x4*)(scr + (4 * n4 + q) * 20 + 4 * kq) = o; }
    LDS_WAIT(); asm volatile("" ::: "memory");
    const int c = lane & 3;
#pragma unroll
    for (int jj = 0; jj < 4; ++jj) { const int r = (lane >> 2) + 16 * jj, n = I.n0 + r; const u32x4 o = *(const LAS u32x4*)(scr + r * 20 + 4 * c);
        const int drow = I.gu ? (n >> 7) * 256 + I.p + (n & 127) : n;
        *(u32x4*)((unsigned char*)I.dst + (size_t)drow * I.Kd + I.k0 + 16 * c) = o; }
    LDS_WAIT(); asm volatile("" ::: "memory");
}
__device__ __forceinline__ void bg_convert_range(const KArgs& a, LAS unsigned char* lds, int kind, int l, int lo, int hi, int wave, int lane, int scr_off = 0, int scr_stride = 16384) {
    LAS unsigned* scr = (LAS unsigned*)(lds + scr_off + wave * scr_stride);
    TrItem A, B; f32x4 va[16], vb[16];
    int it = lo + wave;
    if (it < hi) { bg_decode(a, kind, l, it, A); bg_load(A, va, lane); }
#pragma unroll 1
    while (it < hi) {
        const int i1 = it + 8, i2 = it + 16;
        if (i1 < hi) { bg_decode(a, kind, l, i1, B); bg_load(B, vb, lane); }
        if (kind >= 2) bg_emit8(A, va, scr, lane); else bg_emit(A, va, scr, lane);
        if (i1 >= hi) break;
        if (i2 < hi) { bg_decode(a, kind, l, i2, A); bg_load(A, va, lane); }
        if (kind >= 2) bg_emit8(B, vb, scr, lane); else bg_emit(B, vb, scr, lane);
        it = i2;
    }
    VM_WAIT(); __syncthreads();
}
__device__ __forceinline__ void bg_share(int first, int last, int c, int G, int n_extra, int U, int& lo, int& hi) {
    const int N = last - first; int n_lo = (N + n_extra * U + G - 1) / G, n_hi = n_lo - U;
    if (n_hi < 0) { n_hi = 0; n_lo = (N + (G - n_extra) - 1) / (G - n_extra); }
    lo = first + (c < n_extra ? c * n_hi : n_extra * n_hi + (c - n_extra) * n_lo); hi = lo + (c < n_extra ? n_hi : n_lo);
    if (lo > last) lo = last; if (hi > last) hi = last;
}
__device__ __forceinline__ void bg_convert(const KArgs& a, LAS unsigned char* lds, int kind, int l, int vcu, int G, int wave, int lane) {
    const int NIT = (kind == 0 || kind == 2) ? 65 * 512 : 65 * 256, per = (NIT + G - 1) / G; const int lo = vcu * per, hi = lo + per < NIT ? lo + per : NIT;
    bg_convert_range(a, lds, kind, l, lo < NIT ? lo : NIT, hi, wave, lane);
}
__device__ __forceinline__ void phase_prologue(const KArgs& a, LAS unsigned char* lds, int vcu, int G, int wave, int lane) {
    unsigned char* ws = a.ws;
    LAS float* scr = (LAS float*)(lds + wave * 16384);
    const int gw = vcu * 8 + wave, NGW = G * 8;
    constexpr int C_IN = 2048, C_GRP = 512, C_OUT = 2048, C_KVD = 576, C_DQ = 512, C_UK = 512, C_UV = 512, C_UQ = 768, C_BO = 2048;
    constexpr int C_SMALL = C_IN + C_GRP + C_OUT + C_KVD + C_DQ + C_UK + C_UV + C_UQ + C_BO;
    constexpr int NITEMS = C_SMALL;
    for (int it = gw; it < NITEMS; it += NGW) {
        int r = it;
        if (r < C_IN) { tr_item(a.in[I_AWIN], 2048, (r / 64) * 64, (r % 64) * 32, (bf16_t*)(ws + WS_WIN), 2048, (r % 64) * 32, nullptr, scr, lane); continue; } r -= C_IN;
        if (r < C_GRP) { const int g = r / 128, q = r % 128; tr_item(a.in[I_AWGRP] + (size_t)g * 512 * 512, 512, (q / 16) * 64, (q % 16) * 32, (bf16_t*)(ws + WS_WGRP), 512, g * 512 + (q % 16) * 32, nullptr, scr, lane); continue; } r -= C_GRP;
        if (r < C_OUT) { tr_item(a.in[I_AWOUT], 2048, (r / 64) * 64, (r % 64) * 32, (bf16_t*)(ws + WS_WOUT), 2048, (r % 64) * 32, nullptr, scr, lane); continue; } r -= C_OUT;
        if (r < C_KVD) { const int n0 = (r % 18) * 32; tr_item(a.in[I_KVWD], 576, (r / 18) * 64, n0, (bf16_t*)(ws + WS_WKVQ), 2048, n0 < 512 ? n0 : 1024 + (n0 - 512), nullptr, scr, lane); continue; } r -= C_KVD;
        if (r < C_DQ) { const int n0 = (r % 16) * 32; tr_item(a.in[I_BWDQ], 512, (r / 16) * 64, n0, (bf16_t*)(ws + WS_WKVQ), 2048, 512 + n0, nullptr, scr, lane); continue; } r -= C_DQ;
        if (r < C_UK) { const int n0 = (r % 64) * 32; tr_item(a.in[I_KVWUK], 2048, (r / 64) * 64, n0, (bf16_t*)(ws + WS_WUP), 512, n0, a.in[I_KVNORM], scr, lane); continue; } r -= C_UK;
        if (r < C_UV) { const int n0 = (r % 64) * 32; tr_item(a.in[I_KVWUV], 2048, (r / 64) * 64, n0, (bf16_t*)(ws + WS_WUP), 512, 2048 + n0, a.in[I_KVNORM], scr, lane); continue; } r -= C_UV;
        if (r < C_UQ) { const int n0 = (r % 96) * 32, h = n0 / 192, d0 = n0 % 192;
            const int drow = d0 < 128 ? 4096 + h * 128 + d0 : 6144 + (h >> 2) * 256 + (d0 >= 160 ? 128 : 0) + (h & 3) * 32;
            tr_item(a.in[I_BWUQ], 3072, (r / 96) * 64, n0, (bf16_t*)(ws + WS_WUP), 512, drow, a.in[I_BQNORM], scr, lane); continue; } r -= C_UQ;
        tr_item(a.in[I_BWOUT], 2048, (r / 64) * 64, (r % 64) * 32, (bf16_t*)(ws + WS_WBO), 2048, (r % 64) * 32, nullptr, scr, lane);
    }
    bg_convert(a, lds, L0F8 == 2 ? 2 : 0, 0, vcu, G, wave, lane);
    const int gtid = gw * 64 + lane, NGT = NGW * 64;
    for (int i = gtid; i < 192 * 2048 * 2 / 16; i += NGT) ((u32x4*)(ws + WS_WKVQ + (size_t)1088 * 2048 * 2))[i] = (u32x4){0u, 0u, 0u, 0u};
    for (int i = gtid; i < SEQ * 32; i += NGT) { const int s = i >> 5, j = i & 31;
        const float inv = 1.0f / powf(10000.0f, (float)(2 * j) / 64.0f); const float ang = (float)s * inv;
        double rev = (double)ang * 0.15915494309189535; rev -= floor(rev); const float fr = (float)rev;
        ((f32x2*)(ws + WS_ROPE))[i] = (f32x2){__builtin_amdgcn_cosf(fr), __builtin_amdgcn_sinf(fr)}; }
    for (int i = gtid; i < 2 * DM * 64; i += NGT) { const int l = i / (DM * 64), rem = i - l * (DM * 64), d = rem >> 6, e = rem & 63;
        const float w = a.in[I_RW][i] * a.in[I_LN1G][l * DM + d]; const unsigned h = cvt_pk_bf16(w, 0.f) & 0xffffu; const float wl = w - __uint_as_float(h << 16);
        ((bf16_t*)(ws + WS_RWHI))[((size_t)l * 64 + e) * DM + d] = (bf16_t)h; ((bf16_t*)(ws + WS_RWLO))[((size_t)l * 64 + e) * DM + d] = (bf16_t)(cvt_pk_bf16(wl, 0.f) & 0xffffu); }
    for (int i = gw; i < 2 * 64; i += NGW) { const int l = i / 64, e = i % 64; float c1 = 0.f, c2 = 0.f;
#pragma unroll 16
        for (int d = lane; d < DM; d += 64) { const float w = a.in[I_RW][((size_t)l * DM + d) * 64 + e]; c1 += a.in[I_LN1G][l * DM + d] * w; c2 += a.in[I_LN1B][l * DM + d] * w; }
        c1 = wave_sum(c1); c2 = wave_sum(c2);
        if (lane == 0) { ((float*)(ws + WS_RC))[l * 64 + e] = c1; ((float*)(ws + WS_RC))[128 + l * 64 + e] = c2; } }
    const float* x = a.in[I_X];
    for (int task = gtid; task < NCHUNK * 512; task += NGT) {
        const int c4 = task & 511, t0 = (task >> 9) * 32, s0 = t0 & (SEQ - 1);
        const float* xc = x + c4 * 4;
        f32x4 w[32];
#pragma unroll
        for (int j = 0; j < 16; ++j) w[j] = s0 > 0 ? *(const f32x4*)(xc + (size_t)(t0 - 16 + j) * DM) : (f32x4){0.f, 0.f, 0.f, 0.f};
        f32x4 S2 = w[14] + w[15], S4 = (w[12] + w[13]) + S2, S8 = ((w[8] + w[9]) + (w[10] + w[11])) + S4, S16 = (((w[0] + w[1]) + (w[2] + w[3])) + ((w[4] + w[5]) + (w[6] + w[7]))) + S8;
#pragma unroll 1
        for (int hb = 0; hb < 2; ++hb) { const int tb = t0 + 16 * hb, sb0 = s0 + 16 * hb;
#pragma unroll
            for (int j = 0; j < 16; ++j) w[16 + j] = *(const f32x4*)(xc + (size_t)(tb + j) * DM);
#pragma unroll
            for (int j = 0; j < 16; ++j) { const int sq = sb0 + j; const f32x4 v = w[16 + j];
                S2 += v - w[16 + j - 2]; S4 += v - w[16 + j - 4]; S8 += v - w[16 + j - 8]; S16 += v - w[j];
                const float n2 = 1.f / (float)(sq + 1 < 2 ? sq + 1 : 2), n4 = 1.f / (float)(sq + 1 < 4 ? sq + 1 : 4), n8 = 1.f / (float)(sq + 1 < 8 ? sq + 1 : 8), n16 = 1.f / (float)(sq + 1 < 16 ? sq + 1 : 16);
                const f32x4 o2 = S2 * n2 - v, o4 = S4 * n4 - v, o8 = S8 * n8 - v, o16 = S16 * n16 - v;
                bf16_t* xp = (bf16_t*)(ws + WS_XP) + (size_t)(tb + j) * DM + c4 * 4;
                *(u32x2*)(xp) = (u32x2){cvt_pk_bf16(o2[0], o2[1]), cvt_pk_bf16(o2[2], o2[3])};
                *(u32x2*)(xp + (size_t)T * DM) = (u32x2){cvt_pk_bf16(o4[0], o4[1]), cvt_pk_bf16(o4[2], o4[3])};
                *(u32x2*)(xp + (size_t)2 * T * DM) = (u32x2){cvt_pk_bf16(o8[0], o8[1]), cvt_pk_bf16(o8[2], o8[3])};
                *(u32x2*)(xp + (size_t)3 * T * DM) = (u32x2){cvt_pk_bf16(o16[0], o16[1]), cvt_pk_bf16(o16[2], o16[3])}; }
#pragma unroll
            for (int j = 0; j < 16; ++j) w[j] = w[16 + j]; }
    }
}

__device__ __forceinline__ void route_token(float score, float choice, int lane, bool& sel, float& gate) {
    int cnt = 0;
    const float hm = dpp_f<DPP_HM>(choice);
    const float ocs[7] = {dpp_f<DPP_X1>(choice), dpp_f<DPP_X2>(choice), dpp_f<DPP_X3>(choice), dpp_f<DPP_X3>(hm), dpp_f<DPP_X2>(hm), dpp_f<DPP_X1>(hm), hm};
#pragma unroll
    for (int o = 1; o < 8; ++o) { const float oc = ocs[o - 1]; const int j = lane ^ o; cnt += (oc > choice || (oc == choice && j < lane)) ? 1 : 0; }
    float gs = cnt < 2 ? choice : 0.f;
    gs += dpp_f<DPP_X1>(gs); gs += dpp_f<DPP_X2>(gs); gs += dpp_f<DPP_HM>(gs);
    int gcnt = 0;
#pragma unroll
    for (int o = 8; o < 64; o += 8) { const float og = __shfl_xor(gs, o); const int gj = (lane ^ o) >> 3; gcnt += (og > gs || (og == gs && gj < (lane >> 3))) ? 1 : 0; }
    const bool gsel = gcnt < 4;
    float cur = gsel ? choice : -__builtin_inff();
    unsigned long long selmask = 0ull;
#pragma unroll 1
    for (int it = 0; it < 8; ++it) { const float m = wave_max(cur);
        const unsigned long long b = __ballot(cur == m); const int w = __ffsll((long long)b) - 1;
        selmask |= 1ull << w; if (lane == w) cur = -__builtin_inff(); }
    sel = ((selmask >> lane) & 1ull) != 0ull;
    const float ssum = wave_sum(sel ? score : 0.f);
    gate = score / ssum * 2.5f;
}
__device__ __forceinline__ void phase_r1(const KArgs& a, LAS unsigned char* lds, int l, int G, int wave, int lane) {
    unsigned char* ws = a.ws;
    const bf16_t* z = (const bf16_t*)(ws + WS_Z);
    LAS float* P = (LAS float*)lds;
    LAS float* SX = (LAS float*)(lds + 65536);
    LAS unsigned long long* MK = (LAS unsigned long long*)(lds + 65536 + 2048);
    LAS float* ST = (LAS float*)(lds + 65536 + 2048 + 256);
    const int r32 = lane & 31, hi = lane >> 5;
    const float* c1 = (const float*)(ws + WS_RC) + l * 64; const float* c2 = (const float*)(ws + WS_RC) + 128 + l * 64;
    const float* rbias = a.in[I_RB] + l * 64;
    const float* g1 = a.in[I_LN1G] + l * DM; const float* b1 = a.in[I_LN1B] + l * DM;
    int* toke = (int*)(ws + WS_TOKE); float* tokg = (float*)(ws + WS_TOKG); int* cntp = (int*)(ws + WS_CNT);
    bf16_t* x1h = (bf16_t*)(ws + WS_X1F); bf16_t* x1b = (bf16_t*)(ws + WS_X1B);
    for (int ch = blockIdx.x; ch < NCHUNK; ch += G) {
        const int row0 = ch * 32;
        {
            f32x16 acc0 = {}, acc1 = {}; float s1 = 0.f, s2 = 0.f;
            const bf16_t* zr = z + (size_t)(row0 + r32) * DM + 256 * wave + 8 * hi;
            const bf16_t* bh = (const bf16_t*)(ws + WS_RWHI) + ((size_t)l * 64 + r32) * DM + 256 * wave + 8 * hi;
            const bf16_t* bl = (const bf16_t*)(ws + WS_RWLO) + ((size_t)l * 64 + r32) * DM + 256 * wave + 8 * hi;
#pragma unroll 4
            for (int kk = 0; kk < 16; ++kk) {
                const u32x4 zw = *(const u32x4*)(zr + 16 * kk);
                const f32x4 va = {bf_lo(zw.x), bf_hi(zw.x), bf_lo(zw.y), bf_hi(zw.y)}, vb = {bf_lo(zw.z), bf_hi(zw.z), bf_lo(zw.w), bf_hi(zw.w)};
                s1 += (va[0] + va[1]) + (va[2] + va[3]) + (vb[0] + vb[1]) + (vb[2] + vb[3]);
                s2 += (va[0] * va[0] + va[1] * va[1]) + (va[2] * va[2] + va[3] * va[3]) + (vb[0] * vb[0] + vb[1] * vb[1]) + (vb[2] * vb[2] + vb[3] * vb[3]);
                const bf16x8 ah = __builtin_bit_cast(bf16x8, zw);
                const bf16x8 bh0 = *(const bf16x8*)(bh + 16 * kk), bh1 = *(const bf16x8*)(bh + (size_t)32 * DM + 16 * kk);
                const bf16x8 bl0 = *(const bf16x8*)(bl + 16 * kk), bl1 = *(const bf16x8*)(bl + (size_t)32 * DM + 16 * kk);
                acc0 = __builtin_amdgcn_mfma_f32_32x32x16_bf16(ah, bh0, acc0, 0, 0, 0); acc0 = __builtin_amdgcn_mfma_f32_32x32x16_bf16(ah, bl0, acc0, 0, 0, 0);
                acc1 = __builtin_amdgcn_mfma_f32_32x32x16_bf16(ah, bh1, acc1, 0, 0, 0); acc1 = __builtin_amdgcn_mfma_f32_32x32x16_bf16(ah, bl1, acc1, 0, 0, 0);
            }
#pragma unroll
            for (int r = 0; r < 16; ++r) { const int tk = (r & 3) + 8 * (r >> 2) + 4 * hi; P[(wave * 32 + tk) * 64 + r32] = acc0[r]; P[(wave * 32 + tk) * 64 + 32 + r32] = acc1[r]; }
            s1 += __shfl_xor(s1, 32); s2 += __shfl_xor(s2, 32);
            if (hi == 0) { SX[(wave * 32 + r32) * 2] = s1; SX[(wave * 32 + r32) * 2 + 1] = s2; }
        }
        __syncthreads();
#pragma unroll 1
        for (int j = 0; j < 4; ++j) { const int i = 4 * wave + j, t = row0 + i;
            float dot = 0.f, S1 = 0.f, S2 = 0.f;
#pragma unroll
            for (int w = 0; w < 8; ++w) { dot += P[(w * 32 + i) * 64 + lane]; S1 += SX[(w * 32 + i) * 2]; S2 += SX[(w * 32 + i) * 2 + 1]; }
            const float mu = S1 * (1.f / DM), var = S2 * (1.f / DM) - mu * mu, rstd = 1.f / sqrtf(var + LN_EPS);
            const float logit = rstd * (dot - mu * c1[lane]) + c2[lane];
            const float score = 1.f / (1.f + __expf(-logit));
            const float choice = score + rbias[lane];
            bool sel; float gate; route_token(score, choice, lane, sel, gate);
            const unsigned long long mask = __ballot(sel);
            if (lane == 0) { MK[i] = mask; ST[2 * i] = mu; ST[2 * i + 1] = rstd; }
            if (sel) { const int rk8 = __popcll(mask & ((1ull << lane) - 1ull)); tokg[t * 8 + rk8] = gate; }
        }
        __syncthreads();
#pragma unroll 1
        for (int j = 0; j < 4; ++j) { const int i = 4 * wave + j, t = row0 + i; const unsigned long long mask = MK[i];
            int lr = 0; for (int q = 0; q < i; ++q) lr += (int)((MK[q] >> lane) & 1ull);
            if ((mask >> lane) & 1ull) { const int rk8 = __popcll(mask & ((1ull << lane) - 1ull)); toke[t * 8 + rk8] = (lane << 16) | lr; } }
        if (wave == 0) { int c = 0; for (int q = 0; q < 32; ++q) c += (int)((MK[q] >> lane) & 1ull); cntp[ch * 64 + lane] = c; }
#pragma unroll 1
        for (int j = 0; j < 4; ++j) { const int i = 4 * wave + j, t = row0 + i; const float mu = ST[2 * i], rstd = ST[2 * i + 1];
            f32x4 xo[8];
#pragma unroll
            for (int jj = 0; jj < 8; ++jj) { const int col = 4 * lane + 256 * jj; const u32x2 zw = *(const u32x2*)(z + (size_t)t * DM + col); const f32x4 zv = {bf_lo(zw.x), bf_hi(zw.x), bf_lo(zw.y), bf_hi(zw.y)}, g = *(const f32x4*)(g1 + col), b = *(const f32x4*)(b1 + col);
                xo[jj] = (zv - mu) * rstd * g + b; }
#pragma unroll
            for (int jj = 0; jj < 8; ++jj) { const int col = 4 * lane + 256 * jj;
                const u32x2 xb = {cvt_pk_bf16(xo[jj][0], xo[jj][1]), cvt_pk_bf16(xo[jj][2], xo[jj][3])};
                *(u32x2*)(x1h + (size_t)t * DM + col) = xb;
                if (l == 0 && L0F8 != 2) *(u32x2*)(x1b + (size_t)t * DM + col) = xb;
                if (l == 1 || L0F8 == 2) *(unsigned*)(ws + WS_X1Q + (size_t)t * DM + col) = pk4_fp8(xo[jj][0], xo[jj][1], xo[jj][2], xo[jj][3]); } }
        __syncthreads();
    }
}

__device__ __forceinline__ void phase_r2(const KArgs& a, LAS unsigned char* lds, int G, int tid, int wave, int lane) {
    unsigned char* ws = a.ws;
    LAS int* PA = (LAS int*)lds; LAS int* PB = PA + 512; LAS int* SB = PA + 1024; LAS int* TOT = PA + 1088; LAS int* TB = PA + 1152;
    const int* cntp = (const int*)(ws + WS_CNT); const int* toke = (const int*)(ws + WS_TOKE);
    int* toks = (int*)(ws + WS_TOKS); int* rowidx = (int*)(ws + WS_ROWIDX); int* mte = (int*)(ws + WS_MTE); int* nmtp = (int*)(ws + WS_NMT);
    for (int ch = blockIdx.x; ch < NCHUNK; ch += G) {
        { int sa = 0, sb = 0; for (int c = 32 * wave; c < 32 * wave + 32; ++c) { const int v = cntp[c * 64 + lane]; sa += v; if (c < ch) sb += v; } PA[wave * 64 + lane] = sa; PB[wave * 64 + lane] = sb; }
        __syncthreads();
        if (wave == 0) { int tot = 0, off = 0;
#pragma unroll
            for (int w = 0; w < 8; ++w) { tot += PA[w * 64 + lane]; off += PB[w * 64 + lane]; }
            const int nt = (tot + 255) >> 8; int incl = nt;
#pragma unroll
            for (int o = 1; o < 64; o <<= 1) { const int v = __shfl_up(incl, o); if (lane >= o) incl += v; }
            const int tb = incl - nt;
            SB[lane] = 8192 + 256 * tb + off; TOT[lane] = tot; TB[lane] = tb;
            if (ch == 0) { for (int q = 0; q < nt; ++q) mte[32 + tb + q] = lane; if (lane < 32) mte[lane] = 64; if (lane == 63) *nmtp = 32 + incl; } }
        __syncthreads();
        if (tid < 256) { const int t = ch * 32 + (tid >> 3), k = tid & 7; const int pk = toke[t * 8 + k]; const int e = pk >> 16, lr = pk & 0xffff; const int slot = SB[e] + lr; rowidx[slot] = t; toks[t * 8 + k] = slot; }
        else if (tid < 288) { const int t = ch * 32 + (tid - 256); rowidx[t] = t; }
        if (ch < 64 && tid < 256) { const int tot = TOT[ch], tb = TB[ch], nt = (tot + 255) >> 8; const int p = tot + tid; if (p < 256 * nt) rowidx[8192 + 256 * tb + p] = 0; }
        __syncthreads();
    }
}

__device__ __forceinline__ void phase_ln2(const KArgs& a, int l, int vcu, int G, int wave, int lane) {
    unsigned char* ws = a.ws;
    const bf16_t* x1h = (const bf16_t*)(ws + WS_X1F); const unsigned char* Y = ws + WS_Y;
    const int* toks = (const int*)(ws + WS_TOKS); const float* tokg = (const float*)(ws + WS_TOKG);
    const float* g2 = a.in[I_LN2G] + l * DM; const float* b2 = a.in[I_LN2B] + l * DM;
    float* outf = a.out; bf16_t* outb = (bf16_t*)(ws + WS_X2B);
    const int gw = vcu * 8 + wave, NGW = G * 8;
    for (int t = gw; t < T; t += NGW) {
        const int slot_l = lane < 8 ? toks[t * 8 + lane] : 0; const float g_l = lane < 8 ? tokg[t * 8 + lane] * (1.f / Y8_SCALE) : 0.f;
        float v[4][8];
#define LN2_ADD(j, g, yoff) do { const u32x2 yw = __builtin_nontemporal_load((const u32x2*)(Y + (yoff))); \
            const f32x2 a0 = __builtin_amdgcn_cvt_pk_f32_fp8((int)yw.x, false), a1 = __builtin_amdgcn_cvt_pk_f32_fp8((int)yw.x, true), a2 = __builtin_amdgcn_cvt_pk_f32_fp8((int)yw.y, false), a3 = __builtin_amdgcn_cvt_pk_f32_fp8((int)yw.y, true); \
            v[j][0] += (g) * a0[0]; v[j][1] += (g) * a0[1]; v[j][2] += (g) * a1[0]; v[j][3] += (g) * a1[1]; v[j][4] += (g) * a2[0]; v[j][5] += (g) * a2[1]; v[j][6] += (g) * a3[0]; v[j][7] += (g) * a3[1]; } while (0)
#pragma unroll
        for (int j = 0; j < 4; ++j) { const int col = 8 * lane + 512 * j; const u32x4 xw = *(const u32x4*)(x1h + (size_t)t * DM + col);
            v[j][0] = ALPHA * bf_lo(xw.x); v[j][1] = ALPHA * bf_hi(xw.x); v[j][2] = ALPHA * bf_lo(xw.y); v[j][3] = ALPHA * bf_hi(xw.y);
            v[j][4] = ALPHA * bf_lo(xw.z); v[j][5] = ALPHA * bf_hi(xw.z); v[j][6] = ALPHA * bf_lo(xw.w); v[j][7] = ALPHA * bf_hi(xw.w);
            LN2_ADD(j, (1.f / Y8_SCALE), (size_t)t * DM + col); }
#pragma unroll
        for (int k = 0; k < 8; ++k) { const int slot = __builtin_amdgcn_readlane(slot_l, k); const float g = __uint_as_float((unsigned)__builtin_amdgcn_readlane((int)__float_as_uint(g_l), k));
#pragma unroll
            for (int j = 0; j < 4; ++j) LN2_ADD(j, g, (size_t)slot * DM + 8 * lane + 512 * j); }
#undef LN2_ADD
        float s = 0.f;
#pragma unroll
        for (int j = 0; j < 4; ++j)
#pragma unroll
            for (int q = 0; q < 8; ++q) s += v[j][q];
        const float mean = wave_sum_x(s) * (1.f / DM); float s2 = 0.f;
#pragma unroll
        for (int j = 0; j < 4; ++j)
#pragma unroll
            for (int q = 0; q < 8; ++q) { v[j][q] -= mean; s2 += v[j][q] * v[j][q]; }
        const float rstd = 1.f / sqrtf(wave_sum_x(s2) * (1.f / DM) + LN_EPS);
#pragma unroll
        for (int j = 0; j < 4; ++j) { const int col = 8 * lane + 512 * j; const f32x4 ga = *(const f32x4*)(g2 + col), gb = *(const f32x4*)(g2 + col + 4), ba = *(const f32x4*)(b2 + col), bb = *(const f32x4*)(b2 + col + 4);
#pragma unroll
            for (int q = 0; q < 4; ++q) { v[j][q] = v[j][q] * rstd * ga[q] + ba[q]; v[j][4 + q] = v[j][4 + q] * rstd * gb[q] + bb[q]; } }
#pragma unroll
        for (int j = 0; j < 4; ++j) { const int col = 8 * lane + 512 * j;
            if (l == 1) { *(f32x4*)(outf + (size_t)t * DM + col) = (f32x4){v[j][0], v[j][1], v[j][2], v[j][3]}; *(f32x4*)(outf + (size_t)t * DM + col + 4) = (f32x4){v[j][4], v[j][5], v[j][6], v[j][7]}; }
            if (l == 0) *(u32x4*)(outb + (size_t)t * DM + col) = (u32x4){cvt_pk_bf16(v[j][0], v[j][1]), cvt_pk_bf16(v[j][2], v[j][3]), cvt_pk_bf16(v[j][4], v[j][5]), cvt_pk_bf16(v[j][6], v[j][7])}; }
    }
}

__device__ __forceinline__ void phase_stats(const KArgs& a, int vcu, int G, int wave, int lane) {
    unsigned char* ws = a.ws;
    const bf16_t* ckq = (const bf16_t*)(ws + WS_CKQ); float* rstat = (float*)(ws + WS_RSTAT); bf16_t* Kb = (bf16_t*)(ws + WS_K); const f32x2* rope = (const f32x2*)(ws + WS_ROPE);
    const int gw = vcu * 8 + wave, NGW = G * 8;
    for (int t = gw; t < T; t += NGW) { const bf16_t* row = ckq + (size_t)t * NCKQ;
        const u32x4 c = *(const u32x4*)(row + 8 * lane), q = *(const u32x4*)(row + 512 + 8 * lane);
        float sc = bf_lo(c.x) * bf_lo(c.x) + bf_hi(c.x) * bf_hi(c.x) + bf_lo(c.y) * bf_lo(c.y) + bf_hi(c.y) * bf_hi(c.y) + bf_lo(c.z) * bf_lo(c.z) + bf_hi(c.z) * bf_hi(c.z) + bf_lo(c.w) * bf_lo(c.w) + bf_hi(c.w) * bf_hi(c.w);
        float sq = bf_lo(q.x) * bf_lo(q.x) + bf_hi(q.x) * bf_hi(q.x) + bf_lo(q.y) * bf_lo(q.y) + bf_hi(q.y) * bf_hi(q.y) + bf_lo(q.z) * bf_lo(q.z) + bf_hi(q.z) * bf_hi(q.z) + bf_lo(q.w) * bf_lo(q.w) + bf_hi(q.w) * bf_hi(q.w);
        sc = wave_sum(sc); sq = wave_sum(sq);
        if (lane == 0) { rstat[t] = 1.f / sqrtf(sc * (1.f / 512.f) + RMS_EPS); rstat[T + t] = 1.f / sqrtf(sq * (1.f / 512.f) + RMS_EPS); }
        const int i = lane & 31, s = t & (SEQ - 1);
        const float x1 = __uint_as_float((unsigned)row[1024 + i] << 16), x2 = __uint_as_float((unsigned)row[1056 + i] << 16);
        const f32x2 cs = rope[s * 32 + i];
        const float o = lane < 32 ? x1 * cs[0] - x2 * cs[1] : x2 * cs[0] + x1 * cs[1];
        const bf16_t ob = (bf16_t)(cvt_pk_bf16(o, 0.f) & 0xffffu);
        bf16_t* kr = Kb + (size_t)t * (NH * DQK) + 128 + lane;
#pragma unroll
        for (int h = 0; h < NH; ++h) kr[h * DQK] = ob;
    }
}

struct AttHook { const KArgs* a; LAS unsigned char* lds; int vcu, G, wave, lane;
    __device__ __forceinline__ void operator()() const { const int NIT = 65 * 512, per = (NIT + G - 1) / G, lo = vcu * per, hi = lo + per;
        __syncthreads(); bg_convert_range(*a, lds, 2, 1, lo < NIT ? lo : NIT, hi < NIT ? hi : NIT, wave, lane, 90112, 5120); } };
constexpr int N_PHASES = 19;
__global__ void __launch_bounds__(512, 2) fwd_kernel(KArgs a) {
    extern __shared__ __attribute__((aligned(16))) unsigned char lds_raw[];
    LAS unsigned char* lds = (LAS unsigned char*)lds_raw;
    volatile LAS unsigned* MISC = (volatile LAS unsigned*)(lds + MISC_OFF);
    const int tid = threadIdx.x, lane = tid & 63, wave = __builtin_amdgcn_readfirstlane(tid >> 6);
    const int G = gridDim.x; int bx = blockIdx.x; int vcu = (G % 8 == 0) ? (bx % 8) * (G / 8) + bx / 8 : bx;
    unsigned char* ws = a.ws;
    if (tid < 32) MISC[tid] = 0u;
    __syncthreads();
    XcdBarrier bar; bar.bar = (unsigned*)(ws + WS_CTL) + CW_BAR; bar.x = 0; bar.st = nullptr;
    if (MK_N_LAUNCHES == 1) bar = xcd_barrier_post((unsigned*)(ws + WS_CTL) + CW_BAR, MISC + 8);
    const int lo = a.ph_lo, hi = a.ph_hi;
#ifndef PHMASK
#define PHMASK 0xFFFFFFu
#endif
#define PH(k) ((((PHMASK) >> (k)) & 1u) && lo <= (k) && (k) < hi)
#define SEAM(k) do { if (PH(k) && PH((k) + 1)) xcd_barrier(bar); } while (0)

constexpr int G6_ITEMS = 96 * 60;
#ifndef HWIDS
#define HWIDS 1
#endif
#ifndef EXPER
#define EXPER 0
#endif
#ifndef REPMASK
#define REPMASK 0x0u
#endif
#define RUN(k, BODY) do { if (PH(k)) { BODY; if ((REPMASK >> (k)) & 1u) { __syncthreads(); BODY; } } } while (0)
#define P_G1 do { DenseSched S; S.ord.init(32, 8, G, bx); S.A = (const char*)(ws + WS_XP); S.B = (const char*)(ws + WS_WIN); S.lda_b = DM * 2; S.K = DM; S.mode = 1; S.agrp = (size_t)T * DM * 2; \
        EpiBf16 E{(bf16_t*)(ws + WS_POOLED), DM, nullptr, 0, 1.f}; pg8::gemm_phase(lds, DM * 2, DM, S, E); } while (0)
#define P_G2 do { DenseSched S; S.ord.init(32, 8, G, bx); S.A = (const char*)(ws + WS_POOLED); S.B = (const char*)(ws + WS_WGRP); S.lda_b = DM * 2; S.K = 512; S.mode = 1; S.agrp = 1024; \
        EpiBf16 E{(bf16_t*)(ws + WS_MIXED), DM, a.in[I_ASCALE], 0, 1.f}; pg8::gemm_phase(lds, DM * 2, 512, S, E); } while (0)
#define P_G3 do { DenseSched S; S.ord.init(32, 8, G, bx); S.A = (const char*)(ws + WS_MIXED); S.B = (const char*)(ws + WS_WOUT); S.lda_b = DM * 2; S.K = DM; S.mode = 0; S.agrp = 0; \
        EpiZ E{a.in[I_X], nullptr, (bf16_t*)(ws + WS_Z)}; pg8::gemm_phase(lds, DM * 2, DM, S, E); } while (0)
#define P_G4(l, BGK, BGL, NR, BGF, BGT) do { const int nmt = __builtin_amdgcn_readfirstlane(*(const int*)(ws + WS_NMT)); const int isp = (BGK) >= 0 ? (vcu >> 5) % (NR) : 1 << 20; \
        MoeSched S{(const int*)(ws + WS_MTE), (const int*)(ws + WS_ROWIDX), (const char*)(ws + WS_X1B), (const char*)(ws + WS_WGU) + (size_t)(l) * 65 * 1024 * 2048 * 2, nmt * 4, 4, G, vcu, 1, \
                   (size_t)1024 * 2048 * 2, (size_t)256 * 2048 * 2, 0, 0, isp}; \
        EpiSwiGLU E{(bf16_t*)(ws + WS_H), 1.f, 0}; pg8::gemm_phase(lds, DM * 2, DM, S, E); \
        if ((BGK) >= 0) { int blo, bhi; bg_share((BGF), (BGT), vcu, G, S.nunits % G, 55, blo, bhi); bg_convert_range(a, lds, (BGK), (BGL), blo, bhi, wave, lane); S.i0 = isp; S.i1 = 1 << 20; pg8::gemm_phase(lds, DM * 2, DM, S, E); } } while (0)
#define P_G4H(l, BGK, BGL, NR, BGF, BGT) do { const int nmt = __builtin_amdgcn_readfirstlane(*(const int*)(ws + WS_NMT)); const int isp = (BGK) >= 0 ? (vcu >> 5) % (NR) : 1 << 20; \
        MoeSched S{(const int*)(ws + WS_MTE), (const int*)(ws + WS_ROWIDX), (const char*)(ws + WS_X1B), (const char*)(ws + WS_WGU) + (size_t)(l) * 65 * 1024 * 2048 * 2, nmt * 4, 4, G, vcu, 1, \
                   (size_t)1024 * 2048 * 2, (size_t)256 * 2048 * 2, 0, 0, isp}; \
        EpiSwiGLU E{(bf16_t*)(ws + WS_H), 1.f, 1}; pg8::gemm_phase(lds, DM * 2, DM, S, E); \
        if ((BGK) >= 0) { int blo, bhi; bg_share((BGF), (BGT), vcu, G, S.nunits % G, 55, blo, bhi); bg_convert_range(a, lds, (BGK), (BGL), blo, bhi, wave, lane); S.i0 = isp; S.i1 = 1 << 20; pg8::gemm_phase(lds, DM * 2, DM, S, E); } } while (0)
#define P_G4F(l, BGK, BGL, NR, BGF, BGT) do { const int nmt = __builtin_amdgcn_readfirstlane(*(const int*)(ws + WS_NMT)); const int isp = (BGK) >= 0 ? (vcu >> 5) % (NR) : 1 << 20; \
        MoeSchedT<true> S{(const int*)(ws + WS_MTE), (const int*)(ws + WS_ROWIDX), (const char*)(ws + WS_X1Q), (const char*)(ws + WS_WGU) + (size_t)(l) * 65 * 1024 * 2048 * 2, nmt * 4, 4, G, vcu, 1, \
                   (size_t)1024 * 2048, (size_t)256 * 2048, 0, 0, isp}; \
        EpiSwiGLU E{(bf16_t*)(ws + WS_H), 1.f / W8_SCALE, 1}; pg8::gemm_phase(lds, DM, DM / 2, S, E); \
        if ((BGK) >= 0) { int blo, bhi; bg_share((BGF), (BGT), vcu, G, S.nunits % G, 30, blo, bhi); bg_convert_range(a, lds, (BGK), (BGL), blo, bhi, wave, lane); S.i0 = isp; S.i1 = 1 << 20; pg8::gemm_phase(lds, DM, DM / 2, S, E); } } while (0)
#define P_G5(l, BGK, BGL, NR, BGF, BGT) do { const int nmt = __builtin_amdgcn_readfirstlane(*(const int*)(ws + WS_NMT)); const int isp = (BGK) >= 0 ? (vcu >> 5) % (NR) : 1 << 20; \
        MoeSched S{(const int*)(ws + WS_MTE), (const int*)(ws + WS_ROWIDX), (const char*)(ws + WS_H), (const char*)(ws + WS_WD) + (size_t)(l) * 65 * 2048 * 512 * 2, nmt * 8, 8, G, vcu, 0, \
                   (size_t)2048 * 512 * 2, (size_t)256 * 512 * 2, (size_t)256 * 1024, 0, isp}; \
        EpiBf16 E{(bf16_t*)(ws + WS_Y), DM, nullptr, 1, 1.f}; pg8::gemm_phase(lds, ED * 2, ED, S, E); \
        if ((BGK) >= 0) { int blo, bhi; bg_share((BGF), (BGT), vcu, G, S.nunits % G, 20, blo, bhi); bg_convert_range(a, lds, (BGK), (BGL), blo, bhi, wave, lane); S.i0 = isp; S.i1 = 1 << 20; pg8::gemm_phase(lds, ED * 2, ED, S, E); } } while (0)
#define P_G5F(l, BGK, BGL, NR, BGF, BGT) do { const int nmt = __builtin_amdgcn_readfirstlane(*(const int*)(ws + WS_NMT)); const int isp = (BGK) >= 0 ? (vcu >> 5) % (NR) : 1 << 20; \
        MoeSchedT<true> S{(const int*)(ws + WS_MTE), (const int*)(ws + WS_ROWIDX), (const char*)(ws + WS_H), (const char*)(ws + WS_WD) + (size_t)(l) * 65 * 2048 * 512 * 2, nmt * 8, 8, G, vcu, 0, \
                   (size_t)2048 * 512, (size_t)256 * 512, (size_t)256 * 512, 0, isp}; \
        EpiY8 E{ws + WS_Y, Y8_SCALE / W8_SCALE}; pg8::gemm_phase(lds, ED, ED / 2, S, E); \
        if ((BGK) >= 0) { int blo, bhi; bg_share((BGF), (BGT), vcu, G, S.nunits % G, 12, blo, bhi); bg_convert_range(a, lds, (BGK), (BGL), blo, bhi, wave, lane); S.i0 = isp; S.i1 = 1 << 20; pg8::gemm_phase(lds, ED, ED / 2, S, E); } } while (0)
#define P_G6 do { if (G > 160 && bx >= 160) { const int per = (G6_ITEMS + (G - 160) - 1) / (G - 160), blo = (bx - 160) * per, bhi = blo + per; bg_convert_range(a, lds, 3, 1, blo < G6_ITEMS ? blo : G6_ITEMS, bhi < G6_ITEMS ? bhi : G6_ITEMS, wave, lane); } \
        DenseSched S; S.ord.init(32, 5, G, bx); S.A = (const char*)(ws + WS_X2B); S.B = (const char*)(ws + WS_WKVQ); S.lda_b = DM * 2; S.K = DM; S.mode = 0; S.agrp = 0; \
        EpiBf16 E{(bf16_t*)(ws + WS_CKQ), NCKQ, nullptr, 0, 1.f}; pg8::gemm_phase(lds, DM * 2, DM, S, E); } while (0)
#define P_G7 do { DenseSched S; S.ord.init(32, 28, G, bx); S.A = (const char*)(ws + WS_CKQ); S.B = (const char*)(ws + WS_WUP); S.lda_b = NCKQ * 2; S.K = 512; S.mode = 2; S.agrp = 0; \
        EpiUp E{(bf16_t*)(ws + WS_Q), (bf16_t*)(ws + WS_K), (bf16_t*)(ws + WS_V), (const float*)(ws + WS_RSTAT), (const f32x2*)(ws + WS_ROPE)}; pg8::gemm_phase(lds, NCKQ * 2, 512, S, E); } while (0)
#define P_ATT do { AttHook H{&a, lds, vcu, G, wave, lane}; att::attn_phase((att::lptr)lds, (const bf16_t*)(ws + WS_Q), (const bf16_t*)(ws + WS_K), (const bf16_t*)(ws + WS_V), (bf16_t*)(ws + WS_ATT), vcu, G, H); } while (0)
#define P_G8 do { DenseSched S; S.ord.init(32, 8, G, bx); S.A = (const char*)(ws + WS_ATT); S.B = (const char*)(ws + WS_WBO); S.lda_b = DM * 2; S.K = DM; S.mode = 0; S.agrp = 0; \
        EpiZ E{nullptr, (const bf16_t*)(ws + WS_X2B), (bf16_t*)(ws + WS_Z)}; pg8::gemm_phase(lds, DM * 2, DM, S, E); } while (0)
#define MOE_PHASES(l, pb, K4, L4, F4, T4, K5, L5, F5, T5, G4M, G5M) do { \
        RUN(pb, phase_r1(a, lds, l, G, wave, lane)); SEAM(pb); \
        RUN((pb) + 1, phase_r2(a, lds, G, tid, wave, lane)); \
        if (EXPER && (l) == 0 && PH((pb) + 1)) { __syncthreads(); if (EXPER == 1 ? vcu < 32 : EXPER == 2 ? (vcu & 7) == 0 : EXPER == 3 ? true : EXPER == 4 ? vcu < 64 : (vcu & 3) == 0) bg_convert(a, lds, 1, 1, vcu, G, wave, lane); } \
        SEAM((pb) + 1); \
        RUN((pb) + 2, G4M(l, K4, L4, 5, F4, T4)); SEAM((pb) + 2); \
        RUN((pb) + 3, G5M(l, K5, L5, 10, F5, T5)); SEAM((pb) + 3); \
        RUN((pb) + 4, phase_ln2(a, l, vcu, G, wave, lane)); } while (0)

    RUN(0, phase_prologue(a, lds, vcu, G, wave, lane)); SEAM(0);
    if (MK_N_LAUNCHES == 1 && HWIDS && PH(0) && PH(1) && G % 8 == 0) {
        const unsigned* cen = (const unsigned*)(ws + WS_CTL) + CW_BAR; bool ok = true;
#pragma unroll
        for (int j = 0; j < 16; ++j) { const unsigned c = __hip_atomic_load(cen + XB_XCNT(j), __ATOMIC_RELAXED, __HIP_MEMORY_SCOPE_AGENT); ok = ok && (c == (j < 8 ? (unsigned)(G / 8) : 0u)); }
        const int rank = (int)MISC[16], xcc = (int)MISC[17];
        if (ok && xcc < 8 && rank < G / 8) { vcu = xcc * (G / 8) + rank; bx = rank * 8 + xcc; }
    }
    RUN(1, P_G1); SEAM(1);
    RUN(2, P_G2); SEAM(2);
    RUN(3, P_G3); SEAM(3);
    MOE_PHASES(0, 4, L0F8 ? 3 : 1, 0, 0, 65 * 256, -1, 1, 0, 0, P_G4SEL, P_G5SEL); SEAM(8);
    RUN(9, P_G6); SEAM(9);
    RUN(10, phase_stats(a, vcu, G, wave, lane)); SEAM(10);
    RUN(11, P_G7); SEAM(11);
    RUN(12, P_ATT); SEAM(12);
    RUN(13, P_G8); SEAM(13);
    MOE_PHASES(1, 14, 3, 1, (G > 160 ? G6_ITEMS : 0), 65 * 256, -1, 0, 0, 0, P_G4F, P_G5F);
#undef MOE_PHASES
#undef RUN
#undef PH
#undef SEAM
}

extern "C" void kernel_launch(void* const* d_in, const int* in_sizes, int n_in, void* d_out, int out_size, void* d_ws, size_t ws_size, hipStream_t stream) {
    static int grid = 0;
    if (grid == 0) {
        if (n_in != 25 || out_size != T * DM || ws_size < WS_END) { fprintf(stderr, "kernel_launch: unexpected shapes (n_in %d, out %d, ws %zu)\n", n_in, out_size, ws_size); grid = -1; return; }
        int dev = 0, cus = 0;
        if (hipGetDevice(&dev) != hipSuccess || hipDeviceGetAttribute(&cus, hipDeviceAttributeMultiprocessorCount, dev) != hipSuccess) { grid = -1; return; }
        if (hipFuncSetAttribute((const void*)fwd_kernel, hipFuncAttributeMaxDynamicSharedMemorySize, LDS_BYTES) != hipSuccess) { fprintf(stderr, "kernel_launch: hipFuncSetAttribute failed\n"); grid = -1; return; }
        int per_cu = 0;
        if (hipOccupancyMaxActiveBlocksPerMultiprocessor(&per_cu, (const void*)fwd_kernel, 512, LDS_BYTES) != hipSuccess || per_cu < 1) fprintf(stderr, "kernel_launch: occupancy query reports %d blocks per CU\n", per_cu);
        (void)hipGetLastError();
        grid = cus;
    }
    if (grid < 0) return;
    (void)hipMemsetAsync((char*)d_ws + WS_CTL, 0, CTL_ZERO_BYTES, stream);
    KArgs a{};
    for (int i = 0; i < 25; ++i) a.in[i] = (const float*)d_in[i];
    a.out = (float*)d_out; a.ws = (unsigned char*)d_ws;
#if MK_N_LAUNCHES == 1
    a.ph_lo = 0; a.ph_hi = N_PHASES;
    hipLaunchKernelGGL(fwd_kernel, dim3(grid), dim3(512), LDS_BYTES, stream, a);
#else
    for (int k = 0; k < N_PHASES; ++k) { a.ph_lo = k; a.ph_hi = k + 1; hipLaunchKernelGGL(fwd_kernel, dim3(grid), dim3(512), LDS_BYTES, stream, a); }
#endif
}
```

```cpp
#include <hip/hip_runtime.h>
#include <cstdio>
#include <cstdint>

#ifndef MK_N_LAUNCHES
#define MK_N_LAUNCHES 1
#endif

#ifndef L0F8
#define L0F8 2
#endif
#if L0F8 == 2
#define P_G4SEL P_G4F
#define P_G5SEL P_G5F
#elif L0F8 == 1
#define P_G4SEL P_G4H
#define P_G5SEL P_G5F
#else
#define P_G4SEL P_G4
#define P_G5SEL P_G5
#endif
#define LAS __attribute__((address_space(3)))
#define GAS __attribute__((address_space(1)))
typedef unsigned short bf16_t;
typedef short bf16x8 __attribute__((ext_vector_type(8)));
typedef short s16x4 __attribute__((ext_vector_type(4)));
typedef float f32x2 __attribute__((ext_vector_type(2)));
typedef float f32x4 __attribute__((ext_vector_type(4)));
typedef float f32x16 __attribute__((ext_vector_type(16)));
typedef unsigned u32x2 __attribute__((ext_vector_type(2)));
typedef unsigned u32x4 __attribute__((ext_vector_type(4)));

constexpr int T = 8192, DM = 2048, SEQ = 4096, NBATCH = 2, NH = 16, NE = 64, TOPK = 8, ED = 512;
constexpr int DQK = 192, DV = 128, NCKQ = 1280;
constexpr float ALPHA = 1.4142135623730951f;
constexpr float LN_EPS = 1e-5f, RMS_EPS = 1e-6f;
constexpr int NSLOT_ROWS = 8192 + 65536 + 64 * 256;
constexpr int NCHUNK = T / 32;

constexpr size_t MiB = 1u << 20, KiB = 1u << 10;
constexpr size_t WS_CTL = 0, CTL_ZERO_BYTES = 1 * MiB;
constexpr size_t WS_ROPE = 1 * MiB;
constexpr size_t WS_RWHI = 2 * MiB;
constexpr size_t WS_RWLO = 2 * MiB + 512 * KiB;
constexpr size_t WS_RC = 3 * MiB;
constexpr size_t WS_CNT = 3 * MiB + 64 * KiB;
constexpr size_t WS_TOKE = 3 * MiB + 256 * KiB;
constexpr size_t WS_TOKG = 3 * MiB + 512 * KiB;
constexpr size_t WS_TOKS = 3 * MiB + 768 * KiB;
constexpr size_t WS_ROWIDX = 4 * MiB;
constexpr size_t WS_MTE = 4 * MiB + 512 * KiB;
constexpr size_t WS_NMT = 4 * MiB + 516 * KiB;
constexpr size_t WS_RSTAT = 5 * MiB;
constexpr size_t WS_WIN = 8 * MiB, WS_WGRP = 16 * MiB, WS_WOUT = 18 * MiB, WS_WKVQ = 26 * MiB, WS_WUP = 31 * MiB, WS_WBO = 38 * MiB;
constexpr size_t WS_WGU = 48 * MiB;
constexpr size_t WS_WD = 568 * MiB;
constexpr size_t WS_XP = 828 * MiB;
constexpr size_t WS_Q = 828 * MiB, WS_K = 876 * MiB, WS_V = 924 * MiB;
constexpr size_t WS_POOLED = 956 * MiB;
constexpr size_t WS_ATT = 956 * MiB;
constexpr size_t WS_X1Q = 956 * MiB;
constexpr size_t WS_MIXED = 988 * MiB;
constexpr size_t WS_CKQ = 988 * MiB;
constexpr size_t WS_Z = 1020 * MiB;
constexpr size_t WS_X1F = 1084 * MiB, WS_X1B = 1148 * MiB;
constexpr size_t WS_X2F = 1180 * MiB, WS_X2B = 1244 * MiB;
constexpr size_t WS_H = 1276 * MiB;
constexpr size_t WS_Y = 1364 * MiB;
constexpr size_t WS_END = 1716 * MiB;

constexpr int CW_BAR = 4096;

constexpr int RING_BYTES = 131072;
constexpr int MISC_OFF = RING_BYTES + 320;
constexpr int LDS_BYTES = 147456;

#define LDS_WAIT() asm volatile("s_waitcnt lgkmcnt(0)" ::: "memory")
#define VM_WAIT() asm volatile("s_waitcnt vmcnt(0)" ::: "memory")
__device__ __forceinline__ unsigned cvt_pk_bf16(float lo, float hi) { unsigned r; asm volatile("v_cvt_pk_bf16_f32 %0, %1, %2" : "=v"(r) : "v"(lo), "v"(hi)); return r; }
__device__ __forceinline__ float bf_lo(unsigned w) { return __uint_as_float(w << 16); }
__device__ __forceinline__ float bf_hi(unsigned w) { return __uint_as_float(w & 0xffff0000u); }
template <int CTRL> __device__ __forceinline__ float dpp_f(float v) { return __uint_as_float((unsigned)__builtin_amdgcn_update_dpp(0, (int)__float_as_uint(v), CTRL, 0xf, 0xf, false)); }
constexpr int DPP_X1 = 0xB1, DPP_X2 = 0x4E, DPP_X3 = 0x1B, DPP_HM = 0x141, DPP_RM = 0x140;
__device__ __forceinline__ float wave_sum(float v) {
    v += dpp_f<DPP_X1>(v); v += dpp_f<DPP_X2>(v); v += dpp_f<DPP_HM>(v); v += dpp_f<DPP_RM>(v);
    { const auto r = __builtin_amdgcn_permlane16_swap(__float_as_uint(v), __float_as_uint(v), false, false); v = __uint_as_float(r[0]) + __uint_as_float(r[1]); }
    { const auto r = __builtin_amdgcn_permlane32_swap(__float_as_uint(v), __float_as_uint(v), false, false); v = __uint_as_float(r[0]) + __uint_as_float(r[1]); }
    return v;
}
__device__ __forceinline__ float wave_sum_x(float v) {
#pragma unroll
    for (int o = 1; o < 64; o <<= 1) v += __shfl_xor(v, o);
    return v;
}
__device__ __forceinline__ float wave_max(float v) {
    v = fmaxf(v, dpp_f<DPP_X1>(v)); v = fmaxf(v, dpp_f<DPP_X2>(v)); v = fmaxf(v, dpp_f<DPP_HM>(v)); v = fmaxf(v, dpp_f<DPP_RM>(v));
    { const auto r = __builtin_amdgcn_permlane16_swap(__float_as_uint(v), __float_as_uint(v), false, false); v = fmaxf(__uint_as_float(r[0]), __uint_as_float(r[1])); }
    { const auto r = __builtin_amdgcn_permlane32_swap(__float_as_uint(v), __float_as_uint(v), false, false); v = fmaxf(__uint_as_float(r[0]), __uint_as_float(r[1])); }
    return v;
}

#define XB_TMO      128
#define XB_XCNT(j)  (256  + 64 * (j))
#define XB_XSUB(j)  (1280 + 64 * (j))
#define XB_XGEN(j)  (2304 + 64 * (j))
#define XB_TOP      3328
#define XB_TOPGEN   3392
#define XCD_BAR_WORDS 3456
#define XB_SPIN_CAP (1u << 18)
__device__ __forceinline__ unsigned xb_ld(unsigned* p)              { return __hip_atomic_load(p, __ATOMIC_RELAXED, __HIP_MEMORY_SCOPE_AGENT); }
__device__ __forceinline__ unsigned xb_add(unsigned* p, unsigned v) { return __hip_atomic_fetch_add(p, v, __ATOMIC_RELAXED, __HIP_MEMORY_SCOPE_AGENT); }
__device__ __forceinline__ unsigned xb_xcc_id() { return (unsigned)__builtin_amdgcn_s_getreg((3 << 11) | 20) & 0xFu; }
#define XB_SPIN(cond, bar) do { unsigned _sp = 0; while (cond) { __builtin_amdgcn_s_sleep(1); \
    if ((++_sp & 255u) == 0u) { if (xb_ld(&(bar)[XB_TMO])) break; if (_sp > XB_SPIN_CAP) { atomicAdd(&(bar)[XB_TMO], 1u); break; } } } } while (0)
struct XcdBarrier { unsigned* bar; unsigned x; volatile LAS unsigned* st; };
__device__ __forceinline__ XcdBarrier xcd_barrier_post(unsigned* bar, volatile LAS unsigned* st) {
    XcdBarrier b; b.bar = bar; b.x = xb_xcc_id(); b.st = st;
    if (threadIdx.x == 0) { const unsigned rank = xb_add(&bar[XB_XCNT(b.x)], 1u); st[8] = rank; st[9] = b.x; }
    return b;
}
__device__ __forceinline__ void xcd_barrier_complete(unsigned* bar, unsigned x, unsigned& nloc, unsigned& nx) {
    const unsigned G = gridDim.x * gridDim.y * gridDim.z;
    unsigned sum, cnt, mine, sp = 0u;
    for (;;) {
        sum = 0u; cnt = 0u; mine = 0u;
#pragma unroll
        for (unsigned j = 0; j < 16; ++j) { const unsigned c = xb_ld(&bar[XB_XCNT(j)]); sum += c; cnt += (c > 0u) ? 1u : 0u; mine = (j == x) ? c : mine; }
        if (sum == G) break;
        __builtin_amdgcn_s_sleep(1);
        if ((++sp & 255u) == 0u) { if (xb_ld(&bar[XB_TMO])) break; if (sp > XB_SPIN_CAP) { atomicAdd(&bar[XB_TMO], 1u); break; } }
    }
    nloc = mine > 0u ? mine : 1u; nx = cnt > 0u ? cnt : 1u;
}
__device__ __forceinline__ void xcd_barrier(const XcdBarrier& b) {
    asm volatile("s_waitcnt vmcnt(0)" ::: "memory");
    __syncthreads();
    if (threadIdx.x == 0) {
        unsigned* bar = b.bar;
        __builtin_amdgcn_s_waitcnt(0);
        unsigned nloc = b.st[0], nx = b.st[1];
        if (nloc == 0u) { xcd_barrier_complete(bar, b.x, nloc, nx); b.st[0] = nloc; b.st[1] = nx; }
        asm volatile("buffer_inv sc1" ::: "memory");
        const unsigned old = xb_add(&bar[XB_XSUB(b.x)], 1u);
        const unsigned gen = old / nloc;
        if (old + 1u == (gen + 1u) * nloc) {
            __builtin_amdgcn_fence(__ATOMIC_RELEASE, "agent");
            asm volatile("s_waitcnt vmcnt(0)" ::: "memory");
            const unsigned og = xb_add(&bar[XB_TOP], 1u);
            const unsigned tg = og / nx;
            if (og + 1u == (tg + 1u) * nx) xb_add(&bar[XB_TOPGEN], 1u);
            else XB_SPIN(xb_ld(&bar[XB_TOPGEN]) == tg, bar);
            xb_add(&bar[XB_XGEN(b.x)], 1u);
            asm volatile("s_waitcnt vmcnt(0)" ::: "memory");
        } else {
            XB_SPIN(xb_ld(&bar[XB_XGEN(b.x)]) == gen, bar);
            asm volatile("s_waitcnt vmcnt(0)" ::: "memory");
        }
    }
    __syncthreads();
}

namespace pg8 {
constexpr int BM = 256, BK = 64, HALF = 128, HTB = HALF * BK * 2, STAGE_BYTES = 8 * HTB, NXCD = 8, WGM = 8;
__host__ __device__ __forceinline__ int lds_byte(int r, int c) { const int st = (r >> 4) * 2 + (c >> 5), rr = r & 15, cc = c & 31, ob = rr * 64 + cc * 2; return st * 1024 + (ob ^ (((ob >> 9) & 1) << 5)); }
__host__ __device__ __forceinline__ void stage_rc(int b, int& R, int& C) { const int st = b / 1024, sb = b % 1024, swz = sb ^ (((sb >> 9) & 1) << 5); R = (st >> 1) * 16 + swz / 64; C = (st & 1) * 32 + (swz % 64) / 2; }
__host__ __device__ __forceinline__ int perm32(int rho) { const int n = rho >> 4, i = rho & 15; return 8 * (i >> 2) + 4 * n + (i & 3); }

typedef int v8i32 __attribute__((ext_vector_type(8)));
typedef int v4i32 __attribute__((ext_vector_type(4)));
template <bool F8> struct FragT { typedef bf16x8 type; };
template <> struct FragT<true> { typedef v8i32 type; };
__device__ __forceinline__ void ldfrag(bf16x8& d, const LAS unsigned char* p) { d = *(const LAS bf16x8*)p; }
__device__ __forceinline__ void ldfrag(v8i32& d, const LAS unsigned char* p) { const v4i32 x = *(const LAS v4i32*)p, y = *(const LAS v4i32*)(p + 16); d = __builtin_shufflevector(x, y, 0, 1, 2, 3, 4, 5, 6, 7); }
__device__ __forceinline__ f32x4 mma(v8i32 b, v8i32 a, f32x4 c, int sc) {
    asm volatile("v_mfma_scale_f32_16x16x128_f8f6f4 %0, %1, %2, %0, %3, %3 op_sel_hi:[0,0,0]" : "+v"(c) : "v"(b), "v"(a), "v"(sc)); return c; }
__device__ __forceinline__ f32x4 mma(bf16x8 b, bf16x8 a, f32x4 c, int) { return __builtin_amdgcn_mfma_f32_16x16x32_bf16(b, a, c, 0, 0, 0); }
struct Unit { const char* A; const char* B; const int* rows; int m0, pn, aux; };

struct TileOrder {
    int nM, nN, nwg, G, c;
    __device__ __forceinline__ void init(int nM_, int nN_, int G_, int c_) { nM = nM_; nN = nN_; nwg = nM * nN; G = G_; c = c_; }
    __device__ __forceinline__ bool next(int i, int& pm, int& pn) const {
        const long L = (long)i * G + c; if (L >= nwg) return false;
        int wgid = (int)L; { const int q = nwg / NXCD, r = nwg % NXCD, xcd = wgid % NXCD, off = wgid / NXCD; wgid = (xcd < r ? xcd * (q + 1) : r * (q + 1) + (xcd - r) * q) + off; }
        const int nig = WGM * nN, gid = wgid / nig, fm = gid * WGM, gsz = (nM - fm) < WGM ? (nM - fm) : WGM;
        pm = fm + ((wgid % nig) % gsz); pn = (wgid % nig) / gsz; return true;
    }
};

template <class Epi, class Sched>
__device__ __forceinline__ void gemm_phase(LAS unsigned char* lds, const int lda_b, const int K, const Sched& S, const Epi& E) {
    const int tid = threadIdx.x, wid = __builtin_amdgcn_readfirstlane(tid >> 6), lane = tid & 63, wr = wid >> 2, wc = wid & 3, fr = lane & 15, fq = lane >> 4;
    const int nt = K / BK;
    int Rs[2]; unsigned Cb[2], voffB[2];
#pragma unroll
    for (int i = 0; i < 2; ++i) { int R, C; stage_rc(tid * 16 + i * 8192, R, C); const int Rb = Epi::PERM ? ((R & ~31) + perm32(R & 31)) : R;
        Rs[i] = R; Cb[i] = (unsigned)C * 2u; voffB[i] = (unsigned)(Rb * K + C) * 2u; }
    const size_t kstep = (size_t)(BK * 2);
    const size_t hstepB = (size_t)HALF * K * 2;
    const unsigned ldsw = (unsigned)wid * 1024u;
    int sc1 = 0x7f7f7f7f; asm volatile("" : "+v"(sc1));
    constexpr bool F8 = Sched::FP8;
    const int aoff = lds_byte(wr * 64 + fr, fq * (F8 ? 16 : 8)), boff = lds_byte(wc * 32 + fr, fq * (F8 ? 16 : 8));
#define PG8_SA(b, h) (((b) * 2 + (h)) * HTB)
#define PG8_SB(b, h) ((4 + (b) * 2 + (h)) * HTB)
#define PG8_STAGE(bufoff, gbase, voff) do { _Pragma("unroll") for (int _i = 0; _i < 2; ++_i) \
        __builtin_amdgcn_global_load_lds((const unsigned*)((const char*)(gbase) + (voff)[_i]), (LAS unsigned*)(lds + (bufoff) + ldsw + _i * 8192), 16, 0, 0); } while (0)
#define PG8_LDA(dst, b, h) do { _Pragma("unroll") for (int m = 0; m < 4; ++m) _Pragma("unroll") for (int k = 0; k < NK; ++k) pg8::ldfrag(dst[m][k], lds + PG8_SA(b, h) + aoff + m * 2048 + k * 1024); } while (0)
#define PG8_LDB(dst, b, h) do { _Pragma("unroll") for (int n = 0; n < 2; ++n) _Pragma("unroll") for (int k = 0; k < NK; ++k) pg8::ldfrag(dst[n][k], lds + PG8_SB(b, h) + boff + n * 2048 + k * 1024); } while (0)
#define PG8_MMA(ai, bj, At, Bt) do { __builtin_amdgcn_s_setprio(1); _Pragma("unroll") for (int m = 0; m < 4; ++m) _Pragma("unroll") for (int n = 0; n < 2; ++n) _Pragma("unroll") for (int k = 0; k < NK; ++k) \
        acc[ai][bj][m][n] = pg8::mma(Bt[n][k], At[m][k], acc[ai][bj][m][n], sc1); __builtin_amdgcn_s_setprio(0); } while (0)
#define PG8_WAIT_V(n) asm volatile("s_waitcnt vmcnt(" #n ")" ::: "memory")
#define PG8_WAIT_L(n) asm volatile("s_waitcnt lgkmcnt(" #n ")" ::: "memory")
#define PG8_BAR __builtin_amdgcn_s_barrier()
#define PG8_SCHED __builtin_amdgcn_sched_barrier(0)
#define PG8_MKOFF(u, vo) do { _Pragma("unroll") for (int _h = 0; _h < 2; ++_h) _Pragma("unroll") for (int _i = 0; _i < 2; ++_i) { const int _R = _h * HALF + Rs[_i]; \
        const int _row = (u).rows ? (u).rows[_R] : _R; vo[_h][_i] = (unsigned)_row * (unsigned)lda_b + Cb[_i]; } } while (0)
    Unit cur, nxt; int ui = 0;
    if (!S.next(0, cur)) return;
    f32x4 acc[2][2][4][2];
#pragma unroll
    for (int a = 0; a < 2; ++a)
#pragma unroll
        for (int b = 0; b < 2; ++b)
#pragma unroll
            for (int m = 0; m < 4; ++m)
#pragma unroll
                for (int n = 0; n < 2; ++n) acc[a][b][m][n] = (f32x4){0.f, 0.f, 0.f, 0.f};
    typedef typename pg8::FragT<F8>::type frag_t; constexpr int NK = F8 ? 1 : 2;
    frag_t At[4][NK], B0[2][NK], B1[2][NK];
    unsigned voC[2][2], voN[2][2];
    PG8_MKOFF(cur, voC);
    const char* cA = cur.A; const char* cB = cur.B;
    PG8_STAGE(PG8_SB(0, 0), cB, voffB); PG8_STAGE(PG8_SA(0, 0), cA, voC[0]); PG8_STAGE(PG8_SB(0, 1), cB + hstepB, voffB); PG8_STAGE(PG8_SA(0, 1), cA, voC[1]);
    if (wr == 1) PG8_BAR;
    PG8_WAIT_V(4); PG8_BAR;
    PG8_STAGE(PG8_SB(1, 0), cB + kstep, voffB); PG8_STAGE(PG8_SA(1, 0), cA + kstep, voC[0]); PG8_STAGE(PG8_SB(1, 1), cB + hstepB + kstep, voffB);
    PG8_WAIT_V(6); PG8_BAR;
    for (;;) {
        const bool has_next = S.next(ui + 1, nxt);
        const char* nA = has_next ? nxt.A : cA; const char* nB = has_next ? nxt.B : cB;
        if (has_next) { PG8_MKOFF(nxt, voN); }
        else {
#pragma unroll
            for (int h = 0; h < 2; ++h)
#pragma unroll
                for (int i = 0; i < 2; ++i) voN[h][i] = voC[h][i]; }
        for (int t = 0; t < nt; t += 2) {
            const bool last = (t == nt - 2);
            const char* a1 = cA + (size_t)(t + 1) * kstep;
            const char* a2 = last ? nA : cA + (size_t)(t + 2) * kstep; const char* b2 = last ? nB : cB + (size_t)(t + 2) * kstep;
            const char* a3 = a2 + kstep; const char* b3 = b2 + kstep;
            unsigned v2[2][2];
#pragma unroll
            for (int h = 0; h < 2; ++h)
#pragma unroll
                for (int i = 0; i < 2; ++i) v2[h][i] = last ? voN[h][i] : voC[h][i];
            PG8_LDB(B0, 0, 0); PG8_SCHED; PG8_LDA(At, 0, 0); PG8_STAGE(PG8_SA(1, 1), a1, voC[1]);
            PG8_WAIT_L(8); PG8_BAR; PG8_WAIT_L(0); PG8_MMA(0, 0, At, B0); PG8_BAR; PG8_SCHED;
            PG8_LDB(B1, 0, 1); PG8_STAGE(PG8_SB(0, 0), b2, voffB);
            PG8_BAR; PG8_WAIT_L(0); PG8_MMA(0, 1, At, B1); PG8_BAR;
            PG8_LDA(At, 0, 1); PG8_STAGE(PG8_SA(0, 0), a2, v2[0]);
            PG8_BAR; PG8_WAIT_L(0); PG8_MMA(1, 0, At, B0); PG8_BAR; PG8_SCHED;
            PG8_STAGE(PG8_SB(0, 1), b2 + hstepB, voffB);
            PG8_WAIT_V(6); PG8_BAR; PG8_MMA(1, 1, At, B1); PG8_BAR;
            PG8_LDB(B0, 1, 0); PG8_SCHED; PG8_LDA(At, 1, 0); PG8_STAGE(PG8_SA(0, 1), a2, v2[1]);
            PG8_WAIT_L(8); PG8_BAR; PG8_WAIT_L(0); PG8_MMA(0, 0, At, B0); PG8_BAR; PG8_SCHED;
            PG8_LDB(B1, 1, 1); PG8_STAGE(PG8_SB(1, 0), b3, voffB);
            PG8_BAR; PG8_WAIT_L(0); PG8_MMA(0, 1, At, B1); PG8_BAR;
            PG8_LDA(At, 1, 1); PG8_STAGE(PG8_SA(1, 0), a3, v2[0]);
            PG8_BAR; PG8_WAIT_L(0); PG8_MMA(1, 0, At, B0); PG8_BAR; PG8_SCHED;
            PG8_STAGE(PG8_SB(1, 1), b3 + hstepB, voffB);
            PG8_WAIT_V(6); PG8_BAR; PG8_MMA(1, 1, At, B1); PG8_BAR;
        }
        if constexpr (F8) asm volatile("s_nop 15\n\ts_nop 15\n\ts_nop 7" ::: "memory");
        E(acc, cur, wr, wc, fr, fq);
        if (!has_next) break;
#pragma unroll
        for (int a = 0; a < 2; ++a)
#pragma unroll
            for (int b = 0; b < 2; ++b)
#pragma unroll
                for (int m = 0; m < 4; ++m)
#pragma unroll
                    for (int n = 0; n < 2; ++n) acc[a][b][m][n] = (f32x4){0.f, 0.f, 0.f, 0.f};
        cur = nxt; cA = nA; cB = nB; ++ui;
#pragma unroll
        for (int h = 0; h < 2; ++h)
#pragma unroll
            for (int i = 0; i < 2; ++i) voC[h][i] = voN[h][i];
    }
    PG8_WAIT_V(0);
    if (wr == 0) PG8_BAR;
    PG8_BAR;
#undef PG8_SA
#undef PG8_SB
#undef PG8_STAGE
#undef PG8_LDA
#undef PG8_LDB
#undef PG8_MMA
#undef PG8_WAIT_V
#undef PG8_WAIT_L
#undef PG8_BAR
#undef PG8_SCHED
#undef PG8_MKOFF
}
}

__device__ __forceinline__ unsigned pk4_fp8(float a, float b, float c, float d) { int w = 0; w = __builtin_amdgcn_cvt_pk_fp8_f32(a, b, w, false); w = __builtin_amdgcn_cvt_pk_fp8_f32(c, d, w, true); return (unsigned)w; }
constexpr float W8_SCALE = 32.f;
struct EpiBf16 {
    static constexpr bool PERM = true;
    bf16_t* O; int ldc; const float* colscale; int nt; float sc;
    __device__ __forceinline__ void operator()(const f32x4 (&acc)[2][2][4][2], const pg8::Unit& u, int wr, int wc, int fr, int fq) const {
        const int col0 = u.pn * 256 + wc * 32 + 8 * fq;
        f32x4 scv[2][2];
#pragma unroll
        for (int bj = 0; bj < 2; ++bj) { scv[bj][0] = colscale ? *(const f32x4*)(colscale + col0 + bj * 128) : (f32x4){1.f, 1.f, 1.f, 1.f}; scv[bj][1] = colscale ? *(const f32x4*)(colscale + col0 + bj * 128 + 4) : (f32x4){1.f, 1.f, 1.f, 1.f}; scv[bj][0] *= sc; scv[bj][1] *= sc; }
#pragma unroll
        for (int ai = 0; ai < 2; ++ai)
#pragma unroll
            for (int m = 0; m < 4; ++m) { bf16_t* rowp = O + (size_t)(u.m0 + ai * 128 + wr * 64 + m * 16 + fr) * ldc + col0;
#pragma unroll
                for (int bj = 0; bj < 2; ++bj) { const f32x4 v0 = acc[ai][bj][m][0] * scv[bj][0], v1 = acc[ai][bj][m][1] * scv[bj][1];
                    u32x4 w; w.x = cvt_pk_bf16(v0[0], v0[1]); w.y = cvt_pk_bf16(v0[2], v0[3]); w.z = cvt_pk_bf16(v1[0], v1[1]); w.w = cvt_pk_bf16(v1[2], v1[3]);
                    if (nt) __builtin_nontemporal_store(w, (u32x4*)(rowp + bj * 128)); else *(u32x4*)(rowp + bj * 128) = w; } }
    }
};
constexpr float Y8_SCALE = 16.f;
static_assert(L0F8 >= 1, "the combine (LN2) reads e4m3 Y rows: both layers' down projections must run on the fp8 path");
struct EpiY8 {
    static constexpr bool PERM = true;
    unsigned char* O; float sc;
    __device__ __forceinline__ void operator()(const f32x4 (&acc)[2][2][4][2], const pg8::Unit& u, int wr, int wc, int fr, int fq) const {
        const int odd = fq & 1, colb = u.pn * 256 + wc * 32 + 8 * (fq - odd) + odd * 128;
#pragma unroll
        for (int ai = 0; ai < 2; ++ai)
#pragma unroll
            for (int m = 0; m < 4; ++m) { unsigned char* rowp = O + (size_t)(u.m0 + ai * 128 + wr * 64 + m * 16 + fr) * DM + colb;
                const f32x4 x0 = acc[ai][0][m][0] * sc, x1 = acc[ai][0][m][1] * sc, z0 = acc[ai][1][m][0] * sc, z1 = acc[ai][1][m][1] * sc;
                const unsigned xa = pk4_fp8(x0[0], x0[1], x0[2], x0[3]), xb = pk4_fp8(x1[0], x1[1], x1[2], x1[3]), za = pk4_fp8(z0[0], z0[1], z0[2], z0[3]), zb = pk4_fp8(z1[0], z1[1], z1[2], z1[3]);
                const auto r0 = __builtin_amdgcn_permlane16_swap(xa, za, false, false), r1 = __builtin_amdgcn_permlane16_swap(xb, zb, false, false);
                const u32x4 w = {r0[0], r1[0], r0[1], r1[1]};
                __builtin_nontemporal_store(w, (u32x4*)rowp); }
    }
};
struct EpiZ {
    static constexpr bool PERM = true;
    const float* resf; const bf16_t* resb; bf16_t* out;
    __device__ __forceinline__ void operator()(const f32x4 (&acc)[2][2][4][2], const pg8::Unit& u, int wr, int wc, int fr, int fq) const {
        const int col0 = u.pn * 256 + wc * 32 + 8 * fq;
#pragma unroll
        for (int ai = 0; ai < 2; ++ai)
#pragma unroll
            for (int mp = 0; mp < 2; ++mp) { f32x4 r[2][2][2];
#pragma unroll
                for (int mm = 0; mm < 2; ++mm) { const size_t off = (size_t)(u.m0 + ai * 128 + wr * 64 + (mp * 2 + mm) * 16 + fr) * DM + col0;
#pragma unroll
                    for (int bj = 0; bj < 2; ++bj) {
                        if (resf) { r[mm][bj][0] = *(const f32x4*)(resf + off + bj * 128); r[mm][bj][1] = *(const f32x4*)(resf + off + bj * 128 + 4); }
                        else { const u32x4 w = *(const u32x4*)(resb + off + bj * 128); r[mm][bj][0] = (f32x4){bf_lo(w.x), bf_hi(w.x), bf_lo(w.y), bf_hi(w.y)}; r[mm][bj][1] = (f32x4){bf_lo(w.z), bf_hi(w.z), bf_lo(w.w), bf_hi(w.w)}; } } }
#pragma unroll
                for (int mm = 0; mm < 2; ++mm) { const size_t off = (size_t)(u.m0 + ai * 128 + wr * 64 + (mp * 2 + mm) * 16 + fr) * DM + col0;
#pragma unroll
                    for (int bj = 0; bj < 2; ++bj) { const f32x4 z0 = r[mm][bj][0] * ALPHA + acc[ai][bj][mp * 2 + mm][0], z1 = r[mm][bj][1] * ALPHA + acc[ai][bj][mp * 2 + mm][1];
                        *(u32x4*)(out + off + bj * 128) = (u32x4){cvt_pk_bf16(z0[0], z0[1]), cvt_pk_bf16(z0[2], z0[3]), cvt_pk_bf16(z1[0], z1[1]), cvt_pk_bf16(z1[2], z1[3])}; } }
                asm volatile("" ::: "memory"); }
    }
};
struct EpiSwiGLU {
    static constexpr bool PERM = true;
    bf16_t* H; float sc; int f8;
    __device__ __forceinline__ void operator()(const f32x4 (&acc)[2][2][4][2], const pg8::Unit& u, int wr, int wc, int fr, int fq) const {
        const int col0 = u.pn * 128 + wc * 32 + 8 * fq;
#pragma unroll
        for (int ai = 0; ai < 2; ++ai)
#pragma unroll
            for (int m = 0; m < 4; ++m) { bf16_t* rowp = H + (size_t)(u.m0 + ai * 128 + wr * 64 + m * 16 + fr) * ED + col0;
                float h[8];
#pragma unroll
                for (int n = 0; n < 2; ++n)
#pragma unroll
                    for (int j = 0; j < 4; ++j) { const float g = acc[ai][0][m][n][j] * sc, up = acc[ai][1][m][n][j] * sc;
                        h[n * 4 + j] = g * __builtin_amdgcn_rcpf(1.f + __expf(-g)) * up; }
                if (f8) { *(u32x2*)((unsigned char*)H + (size_t)(u.m0 + ai * 128 + wr * 64 + m * 16 + fr) * ED + col0) = (u32x2){pk4_fp8(h[0], h[1], h[2], h[3]), pk4_fp8(h[4], h[5], h[6], h[7])}; }
                else { u32x4 w; w.x = cvt_pk_bf16(h[0], h[1]); w.y = cvt_pk_bf16(h[2], h[3]); w.z = cvt_pk_bf16(h[4], h[5]); w.w = cvt_pk_bf16(h[6], h[7]);
                *(u32x4*)rowp = w; } }
    }
};
struct EpiUp {
    static constexpr bool PERM = true;
    bf16_t* Q; bf16_t* Kb; bf16_t* V; const float* rstat; const f32x2* rope;
    __device__ __forceinline__ void operator()(const f32x4 (&acc)[2][2][4][2], const pg8::Unit& u, int wr, int wc, int fr, int fq) const {
        const int pn = u.pn;
        const float* rs = rstat + (pn < 16 ? 0 : T);
        float rsc[2][4];
#pragma unroll
        for (int ai = 0; ai < 2; ++ai)
#pragma unroll
            for (int m = 0; m < 4; ++m) rsc[ai][m] = rs[u.m0 + ai * 128 + wr * 64 + m * 16 + fr];
#pragma unroll
        for (int ai = 0; ai < 2; ++ai)
#pragma unroll
            for (int m = 0; m < 4; ++m) { const int row = u.m0 + ai * 128 + wr * 64 + m * 16 + fr; const float r = rsc[ai][m];
                if (pn < 24) {
#pragma unroll
                    for (int bj = 0; bj < 2; ++bj) { const f32x4 v0 = acc[ai][bj][m][0] * r, v1 = acc[ai][bj][m][1] * r;
                        u32x4 w; w.x = cvt_pk_bf16(v0[0], v0[1]); w.y = cvt_pk_bf16(v0[2], v0[3]); w.z = cvt_pk_bf16(v1[0], v1[1]); w.w = cvt_pk_bf16(v1[2], v1[3]);
                        const int d = wc * 32 + 8 * fq;
                        bf16_t* p;
                        if (pn < 8) p = Kb + (size_t)row * (NH * DQK) + (2 * pn + bj) * DQK + d;
                        else if (pn < 16) p = V + (size_t)row * DM + (pn - 8) * 256 + bj * 128 + d;
                        else p = Q + (size_t)row * (NH * DQK) + (2 * (pn - 16) + bj) * DQK + d;
                        *(u32x4*)p = w; }
                } else {
                    const int head = 4 * (pn - 24) + wc, i0 = 8 * fq, s = row & (SEQ - 1);
                    const f32x4* cs = (const f32x4*)(rope + (size_t)s * 32 + i0);
                    float o1[8], o2[8];
#pragma unroll
                    for (int q = 0; q < 4; ++q) { const f32x4 c2 = cs[q];
                        const int n = q >> 1, j = (q & 1) * 2;
                        const float x1a = acc[ai][0][m][n][j] * r, x2a = acc[ai][1][m][n][j] * r, x1b = acc[ai][0][m][n][j + 1] * r, x2b = acc[ai][1][m][n][j + 1] * r;
                        o1[2 * q] = x1a * c2[0] - x2a * c2[1]; o2[2 * q] = x2a * c2[0] + x1a * c2[1];
                        o1[2 * q + 1] = x1b * c2[2] - x2b * c2[3]; o2[2 * q + 1] = x2b * c2[2] + x1b * c2[3]; }
                    bf16_t* p = Q + (size_t)row * (NH * DQK) + head * DQK + 128 + i0;
                    u32x4 w; w.x = cvt_pk_bf16(o1[0], o1[1]); w.y = cvt_pk_bf16(o1[2], o1[3]); w.z = cvt_pk_bf16(o1[4], o1[5]); w.w = cvt_pk_bf16(o1[6], o1[7]);
                    *(u32x4*)p = w;
                    w.x = cvt_pk_bf16(o2[0], o2[1]); w.y = cvt_pk_bf16(o2[2], o2[3]); w.z = cvt_pk_bf16(o2[4], o2[5]); w.w = cvt_pk_bf16(o2[6], o2[7]);
                    *(u32x4*)(p + 32) = w;
                } }
    }
};

struct DenseSched {
    static constexpr bool FP8 = false;
    pg8::TileOrder ord; const char* A; const char* B; int lda_b, K; int mode;
    size_t agrp;
    __device__ __forceinline__ bool next(int i, pg8::Unit& u) const {
        int pm, pn; if (!ord.next(i, pm, pn)) return false;
        size_t ao = 0;
        if (mode == 1) ao = (size_t)(pn >> 1) * agrp; else if (mode == 2) ao = pn >= 16 ? 1024 : 0;
        u.A = A + ao + (size_t)pm * 256 * lda_b; u.B = B + (size_t)pn * 256 * K * 2; u.rows = nullptr; u.m0 = pm * 256; u.pn = pn; u.aux = 0;
        return true;
    }
};
template <bool F8_> struct MoeSchedT {
    static constexpr bool FP8 = F8_;
    const int* mte; const int* rowidx; const char* A; const char* W; int nunits, npn, G, c, gather; size_t wexp, wtile, atile; int i0, i1;
    __device__ __forceinline__ bool next(int i, pg8::Unit& u) const {
        if (i + i0 >= i1) return false;
        const int L = (i + i0) * G + c; if (L >= nunits) return false;
        const int mt = L / npn, pn = L - mt * npn; const int e = __builtin_amdgcn_readfirstlane(mte[mt]);
        u.A = gather ? A : A + (size_t)mt * atile; u.rows = gather ? rowidx + mt * 256 : nullptr;
        u.B = W + (size_t)e * wexp + (size_t)pn * wtile; u.m0 = mt * 256; u.pn = pn; u.aux = e;
        return true;
    }
};

typedef MoeSchedT<false> MoeSched;

namespace att {
constexpr int NW = 8, QBLK = 32, KVBLK = 64, QB = NW * QBLK;
constexpr int QS = NH * DQK, KS = NH * DQK, VS = DM, OS = DM;
constexpr int SHM_V = KVBLK * DV * 2, SHM_K = KVBLK * DQK * 2;
constexpr int ATT_LDS = 2 * SHM_V + 2 * SHM_K + NW * 64 * 4;
constexpr float SCALE = 0.07216878364870322f;
constexpr float THR = 8.f;
typedef LAS char* lptr;
#define KSWZ(row, colB) ((row) * 384 + ((colB) ^ ((((row) >> 1) & 7) << 4)))
#define SBAR() __builtin_amdgcn_sched_barrier(0)
__device__ __forceinline__ int v_st(int k, int c) { const int kk = (k & ~0xC) | ((k & 4) << 1) | ((k & 8) >> 1); return ((kk >> 3) * 4 + (c >> 5)) * 512 + ((kk & 7) * 32 + (c & 31)) * 2; }
__device__ __forceinline__ int v_rd_base(int lane) { return ((lane & 3) << 3) | (((lane >> 2) & 3) << 6) | (((lane >> 4) & 1) << 5) | (((lane >> 5) & 1) << 8); }
constexpr int v_rd_off(int d0, int ks, int half) { return d0 * 512 + ks * 4096 + half * 2048; }
__device__ __forceinline__ int crow(int r, int hi) { return (r & 3) + 8 * (r >> 2) + 4 * hi; }
__device__ __forceinline__ bf16x8 ld8(const bf16_t* p) { return *reinterpret_cast<const bf16x8*>(p); }
__device__ __forceinline__ void mask_tile(f32x16& p0, f32x16& p1, int dq) {
    const float NEG = -__builtin_inff();
#pragma unroll
    for (int r = 0; r < 16; ++r) {
        const int c = (r & 3) + 8 * (r >> 2);
        if (dq - c < 0) p0[r] = NEG;
        if (dq - c - 32 < 0) p1[r] = NEG;
    }
}
__device__ __forceinline__ void partialSM(f32x16& p0, f32x16& p1, float& m_reg, float& mn, float& alpha) {
    float pmax = p0[0];
#pragma unroll
    for (int r = 1; r < 16; ++r) pmax = fmaxf(pmax, p0[r]);
#pragma unroll
    for (int r = 0; r < 16; ++r) pmax = fmaxf(pmax, p1[r]);
    { auto rr = __builtin_amdgcn_permlane32_swap(__float_as_uint(pmax), __float_as_uint(pmax), false, false);
      pmax = fmaxf(__uint_as_float(rr[0]), __uint_as_float(rr[1])); }
    constexpr float C2 = 1.4426950408889634f * SCALE;
    if (__builtin_expect(__all((pmax - m_reg) * SCALE <= THR), 1)) { mn = m_reg; alpha = 1.f; }
    else { mn = fmaxf(m_reg, pmax); alpha = __builtin_amdgcn_exp2f((m_reg - mn) * C2); m_reg = mn; }
    const float mnL = -mn * C2;
#pragma unroll
    for (int r = 0; r < 16; ++r) p0[r] = fmaf(p0[r], C2, mnL);
#pragma unroll
    for (int r = 0; r < 16; ++r) p1[r] = fmaf(p1[r], C2, mnL);
#pragma unroll
    for (int r = 0; r < 16; ++r) p0[r] = __builtin_amdgcn_exp2f(p0[r]);
}
__device__ __forceinline__ void finishSM(f32x16& p0, f32x16& p1, float alpha, float& l_reg, bf16x8& pa0, bf16x8& pa1, bf16x8& pa2, bf16x8& pa3) {
#pragma unroll
    for (int r = 0; r < 16; ++r) p1[r] = __builtin_amdgcn_exp2f(p1[r]);
    float ps = 0;
#pragma unroll
    for (int r = 0; r < 16; ++r) ps += p0[r];
#pragma unroll
    for (int r = 0; r < 16; ++r) ps += p1[r];
    { auto rr = __builtin_amdgcn_permlane32_swap(__float_as_uint(ps), __float_as_uint(ps), false, false);
      ps = __uint_as_float(rr[0]) + __uint_as_float(rr[1]); }
    l_reg = l_reg * alpha + ps;
#define PK4(P, B_, OUT) do { unsigned a0 = cvt_pk_bf16(P[B_+0], P[B_+1]), a1 = cvt_pk_bf16(P[B_+2], P[B_+3]);                          \
        unsigned b0 = cvt_pk_bf16(P[B_+4], P[B_+5]), b1 = cvt_pk_bf16(P[B_+6], P[B_+7]);                                             \
        auto r0 = __builtin_amdgcn_permlane32_swap(a0, b0, false, false); auto r1 = __builtin_amdgcn_permlane32_swap(a1, b1, false, false); \
        u32x4 w = {r0[0], r1[0], r0[1], r1[1]}; OUT = *reinterpret_cast<bf16x8*>(&w); } while (0)
    PK4(p0, 0, pa0); PK4(p0, 8, pa1); PK4(p1, 0, pa2); PK4(p1, 8, pa3);
#undef PK4
}
template <int KB>
__device__ __forceinline__ void qkt(f32x16& p0, f32x16& p1, lptr K_lds, int r32, int hi, const bf16x8* qr) {
    p0 = f32x16{}; p1 = f32x16{};
    lptr kb[4];
#pragma unroll
    for (int dd = 0; dd < 4; ++dd) kb[dd] = K_lds + KB * SHM_K + KSWZ(r32, (dd * 16 + hi * 8) * 2);
#pragma unroll
    for (int d0 = 0; d0 < 12; ++d0) { lptr a = kb[d0 & 3] + (d0 >> 2) * 128;
        bf16x8 b0 = *reinterpret_cast<const LAS bf16x8*>(a);
        bf16x8 b1 = *reinterpret_cast<const LAS bf16x8*>(a + 32 * 384);
        p0 = __builtin_amdgcn_mfma_f32_32x32x16_bf16(b0, qr[d0], p0, 0, 0, 0);
        p1 = __builtin_amdgcn_mfma_f32_32x32x16_bf16(b1, qr[d0], p1, 0, 0, 0); }
}
template <int VB>
__device__ __forceinline__ void pv_tile(f32x16* o, int vb0, bf16x8 pa0, bf16x8 pa1, bf16x8 pa2, bf16x8 pa3) {
#define TRRD(dst, off) asm volatile("ds_read_b64_tr_b16 %0, %1 offset:%2" : "=&v"(dst) : "v"(vb0), "i"(off) : "memory")
#define PV_D0(d0) do { s16x4 l0, l1, l2, l3, h0, h1, h2, h3; constexpr int b_ = VB * SHM_V + v_rd_off(d0, 0, 0); \
        TRRD(l0, b_); TRRD(h0, b_ + 2048); TRRD(l1, b_ + 4096); TRRD(h1, b_ + 6144); TRRD(l2, b_ + 8192); TRRD(h2, b_ + 10240); TRRD(l3, b_ + 12288); TRRD(h3, b_ + 14336); \
        asm volatile("s_waitcnt lgkmcnt(0)" ::: "memory"); SBAR();   \
        o[d0] = __builtin_amdgcn_mfma_f32_32x32x16_bf16(pa0, (bf16x8){l0[0], l0[1], l0[2], l0[3], h0[0], h0[1], h0[2], h0[3]}, o[d0], 0, 0, 0);   \
        o[d0] = __builtin_amdgcn_mfma_f32_32x32x16_bf16(pa1, (bf16x8){l1[0], l1[1], l1[2], l1[3], h1[0], h1[1], h1[2], h1[3]}, o[d0], 0, 0, 0);   \
        o[d0] = __builtin_amdgcn_mfma_f32_32x32x16_bf16(pa2, (bf16x8){l2[0], l2[1], l2[2], l2[3], h2[0], h2[1], h2[2], h2[3]}, o[d0], 0, 0, 0);   \
        o[d0] = __builtin_amdgcn_mfma_f32_32x32x16_bf16(pa3, (bf16x8){l3[0], l3[1], l3[2], l3[3], h3[0], h3[1], h3[2], h3[3]}, o[d0], 0, 0, 0); } while (0)
    PV_D0(0); PV_D0(1); PV_D0(2); PV_D0(3);
#undef PV_D0
#undef TRRD
}
struct BlockRef { const bf16_t* Q; const bf16_t* K; const bf16_t* V; bf16_t* O; int P0; };
struct Seam { bf16x8 qr[12]; };
#define VMW() asm volatile("s_waitcnt vmcnt(0)" ::: "memory")
#define VMWN(n) asm volatile("s_waitcnt vmcnt(%0)" :: "i"(n) : "memory")
#define SLOAD_H(Kp, Vp, k0) do { st_v0 = ld8((Vp) + (size_t)((k0) + sr) * VS + sc); st_v1 = ld8((Vp) + (size_t)((k0) + 32 + sr) * VS + sc); \
        const bf16_t* kp_ = (Kp) + (size_t)((k0) + krow) * KS + kc8; st_k0 = ld8(kp_); st_k1 = ld8(kp_ + 64); st_k2 = ld8(kp_ + 128); } while (0)
#define SWRITE_H(bf) do { lptr kd_ = K_lds + (bf) * SHM_K + kws; *(LAS bf16x8*)kd_ = st_k0; *(LAS bf16x8*)(kd_ + 128) = st_k1; *(LAS bf16x8*)(kd_ + 256) = st_k2; \
        *(LAS bf16x8*)(V_lds + (bf) * SHM_V + vst0) = st_v0; *(LAS bf16x8*)(V_lds + (bf) * SHM_V + vst1) = st_v1; } while (0)
__device__ __forceinline__ void attn_prime(const BlockRef& cur, lptr lds, Seam& S) {
    const int tid = threadIdx.x, wid = __builtin_amdgcn_readfirstlane(tid >> 6), lane = tid & 63, r32 = lane & 31, hi = lane >> 5;
    const int sr = tid >> 4, sc = (tid & 15) * 8, vst0 = v_st(sr, sc), vst1 = v_st(32 + sr, sc), krow = tid >> 3, kc8 = (tid & 7) * 8, kws = KSWZ(krow, (tid & 7) * 16);
    lptr V_lds = lds; lptr K_lds = lds + 2 * SHM_V;
    bf16x8 st_v0, st_v1, st_k0, st_k1, st_k2;
#pragma unroll
    for (int d0 = 0; d0 < 12; ++d0) S.qr[d0] = ld8(cur.Q + (size_t)(wid * QBLK + r32) * QS + d0 * 16 + hi * 8);
    SLOAD_H(cur.K, cur.V, 0); VMW(); SWRITE_H(0);
    __syncthreads();
}
__device__ __forceinline__ void attn_block(const BlockRef& cur, const BlockRef& nxt, lptr lds, Seam& S) {
    const int tid = threadIdx.x, wid = __builtin_amdgcn_readfirstlane(tid >> 6), lane = tid & 63, r32 = lane & 31, hi = lane >> 5;
    const int NT = cur.P0 / KVBLK + QB / KVBLK;
    const int qlo = cur.P0 + wid * QBLK, qm = qlo + r32 - 4 * hi;
    lptr V_lds = lds; lptr K_lds = lds + 2 * SHM_V;
    LAS float* ws = (LAS float*)(lds + 2 * SHM_V + 2 * SHM_K) + wid * 64; LAS float* li_l = ws; LAS float* al_l = ws + 32;
    float m_reg = -1e30f, l_reg = 0; f32x16 o[4] = {};
    const int sr = tid >> 4, sc = (tid & 15) * 8, vst0 = v_st(sr, sc), vst1 = v_st(32 + sr, sc);
    const int krow = tid >> 3, kc8 = (tid & 7) * 8, kws = KSWZ(krow, (tid & 7) * 16);
    const int vb0 = (int)(unsigned)(uintptr_t)V_lds + v_rd_base(lane);
    const bf16_t* Kh = cur.K; const bf16_t* Vh = cur.V;
    bf16x8 st_v0, st_v1, st_k0, st_k1, st_k2;
#define RESC(a) do { if (__any((a) < 1.f)) { if (hi == 0) al_l[r32] = (a); asm volatile("s_waitcnt lgkmcnt(0)" ::: "memory");              \
                     _Pragma("unroll") for (int d_ = 0; d_ < 4; ++d_) _Pragma("unroll") for (int r = 0; r < 16; ++r) o[d_][r] *= al_l[crow(r, hi)]; } } while (0)
#define MASKT(P0_, P1_, t) do { const int kb_ = (t) * KVBLK; if (kb_ + KVBLK - 1 > qlo) mask_tile(P0_, P1_, qm - kb_); } while (0)
#define STEP(t, BF) do { f32x16 p0, p1; float mn, al; bf16x8 pa0, pa1, pa2, pa3;                                     \
        const bool lastt = (t) + 1 == NT;                                                                               \
        if (!lastt) { SLOAD_H(Kh, Vh, ((t) + 1) * KVBLK); } else { SLOAD_H(nxt.K, nxt.V, 0); }                          \
        SBAR(); qkt<BF>(p0, p1, K_lds, r32, hi, S.qr); SBAR();                                                         \
        if (lastt) { _Pragma("unroll") for (int d0 = 0; d0 < 12; ++d0) S.qr[d0] = ld8(nxt.Q + (size_t)(wid * QBLK + r32) * QS + d0 * 16 + hi * 8); SBAR(); } \
        MASKT(p0, p1, (t)); partialSM(p0, p1, m_reg, mn, al); RESC(al);                                                \
        finishSM(p0, p1, al, l_reg, pa0, pa1, pa2, pa3); SBAR();                                                       \
        pv_tile<BF>(o, vb0, pa0, pa1, pa2, pa3); SBAR();                                                               \
        if (lastt) { VMWN(12); SWRITE_H(0); } else { VMW(); SWRITE_H(1 - (BF)); }                                       \
        if (!lastt) __syncthreads(); } while (0)
    for (int t = 0; t < NT; t += 2) { STEP(t, 0); STEP(t + 1, 1); }
    if (hi == 0) li_l[r32] = l_reg; asm volatile("s_waitcnt lgkmcnt(0)" ::: "memory");
    float rli[16];
#pragma unroll
    for (int r = 0; r < 16; ++r) rli[r] = __builtin_amdgcn_rcpf(li_l[crow(r, hi)]);
    bf16_t* Ow = cur.O + (size_t)(wid * QBLK) * OS;
#pragma unroll
    for (int r = 0; r < 16; ++r) { const int orow = crow(r, hi);
#pragma unroll
        for (int d0 = 0; d0 < 4; ++d0) { const float v = o[d0][r] * rli[r];
            const float vn = __shfl_xor(v, 1);
            if ((r32 & 1) == 0) *(unsigned*)(Ow + (size_t)orow * OS + d0 * 32 + r32) = cvt_pk_bf16(v, vn); } }
    __syncthreads();
#undef RESC
#undef MASKT
#undef STEP
}
#undef VMW
#undef VMWN
#undef SLOAD_H
#undef SWRITE_H
#undef KSWZ
#undef SBAR
__device__ __forceinline__ BlockRef make_ref(int L, int pass, const bf16_t* Q, const bf16_t* K, const bf16_t* V, bf16_t* O) {
    const int bh = L >> 3, x = L & 7, qb = pass ? 15 - x : x, b = bh >> 4, h = bh & 15;
    BlockRef r; const size_t row0 = (size_t)b * SEQ;
    r.Q = Q + (row0 + (size_t)qb * QB) * QS + h * DQK; r.O = O + (row0 + (size_t)qb * QB) * OS + h * DV;
    r.K = K + row0 * KS + h * DQK; r.V = V + row0 * VS + h * DV; r.P0 = qb * QB;
    return r;
}
template <class Hook>
__device__ __forceinline__ void attn_phase(lptr lds, const bf16_t* Q, const bf16_t* K, const bf16_t* V, bf16_t* O, int vcu, int G, const Hook& hook) {
    constexpr int TOTAL = NBATCH * NH * 8;
    const int slot = (vcu >> 5) % 3;
    int L = vcu; if (L >= TOTAL) { hook(); return; }
    if (slot == 0) hook();
    int pass = 0, nblk = 0;
    BlockRef cur = make_ref(L, 0, Q, K, V, O);
    Seam S;
    attn_prime(cur, lds, S);
    for (;;) {
        const bool more_pass = pass == 0, more_item = L + G < TOTAL, last = !more_pass && !more_item;
        int passn = pass + 1, Ln = L;
        if (!more_pass) { passn = 0; Ln = more_item ? L + G : L; }
        const BlockRef nxt = last ? cur : make_ref(Ln, passn, Q, K, V, O);
        attn_block(cur, nxt, lds, S);
        ++nblk;
        if (nblk == 1 && slot == 1) hook();
        if (last) break;
        cur = nxt; pass = passn; L = Ln;
    }
    if (slot == 2 || (slot == 1 && nblk < 1)) hook();
}
}

struct KArgs { const float* in[25]; float* out; unsigned char* ws; int ph_lo, ph_hi; };
enum { I_X = 0, I_AWIN, I_AWGRP, I_ASCALE, I_AWOUT, I_KVWD, I_KVNORM, I_KVWUK, I_KVWUV, I_BWDQ, I_BQNORM, I_BWUQ, I_BWOUT, I_LN1G, I_LN1B, I_LN2G, I_LN2B,
       I_RW, I_RB, I_EWG, I_EWU, I_EWD, I_SWG, I_SWU, I_SWD };

__device__ __forceinline__ void tr_item(const float* W, int ldw, int k0, int n0, bf16_t* WT, int K, int drow0, const float* kscale, LAS float* scr, int lane) {
    const int c = lane & 7;
    f32x4 sa = {1.f, 1.f, 1.f, 1.f}, sb = sa;
    if (kscale) { sa = *(const f32x4*)(kscale + k0 + 8 * c); sb = *(const f32x4*)(kscale + k0 + 8 * c + 4); }
#pragma unroll 8
    for (int i = 0; i < 32; ++i) { const int kk = 2 * i + (lane >> 5); scr[kk * 33 + (lane & 31)] = W[(size_t)(k0 + kk) * ldw + n0 + (lane & 31)]; }
    LDS_WAIT(); asm volatile("" ::: "memory");
#pragma unroll
    for (int j = 0; j < 4; ++j) { const int n = (lane >> 3) + 8 * j; const LAS float* sp = scr + (8 * c) * 33 + n;
        u32x4 o; o.x = cvt_pk_bf16(sp[0 * 33] * sa[0], sp[1 * 33] * sa[1]); o.y = cvt_pk_bf16(sp[2 * 33] * sa[2], sp[3 * 33] * sa[3]); o.z = cvt_pk_bf16(sp[4 * 33] * sb[0], sp[5 * 33] * sb[1]); o.w = cvt_pk_bf16(sp[6 * 33] * sb[2], sp[7 * 33] * sb[3]);
        *(u32x4*)(WT + (size_t)(drow0 + n) * K + k0 + 8 * c) = o; }
    LDS_WAIT(); asm volatile("" ::: "memory");
}
struct TrItem { const float* src; bf16_t* dst; int ldw, Kd, k0, n0, gu, p; };
__device__ __forceinline__ void bg_decode(const KArgs& a, int kind  , int l, int it, TrItem& I) {
    unsigned char* ws = a.ws;
    if (kind == 0 || kind == 2) { const int e = it >> 9, q = it & 511, up = q >> 8, qq = q & 255;
        I.src = e < 64 ? a.in[up ? I_EWU : I_EWG] + (size_t)(l * 64 + e) * 2048 * 512 : a.in[up ? I_SWU : I_SWG] + (size_t)l * 2048 * 512;
        I.ldw = 512; I.k0 = (qq >> 3) * 64; I.n0 = (qq & 7) * 64; I.dst = (bf16_t*)(ws + WS_WGU + (size_t)l * 65 * 1024 * 2048 * 2 + (size_t)e * 1024 * 2048 * (kind == 2 ? 1 : 2)); I.Kd = 2048; I.gu = 1; I.p = up ? 128 : 0;
    } else { const int e = it >> 8, qq = it & 255;
        I.src = e < 64 ? a.in[I_EWD] + (size_t)(l * 64 + e) * 512 * 2048 : a.in[I_SWD] + (size_t)l * 512 * 2048;
        I.ldw = 2048; I.k0 = (qq >> 5) * 64; I.n0 = (qq & 31) * 64; I.dst = (bf16_t*)(ws + WS_WD + (size_t)l * 65 * 2048 * 512 * 2 + (size_t)e * 2048 * 512 * (kind == 3 ? 1 : 2)); I.Kd = 512; I.gu = 0; I.p = 0; }
}
__device__ __forceinline__ void bg_load(const TrItem& I, f32x4 (&v)[16], int lane) {
    const float* p = I.src + (size_t)(I.k0 + 16 * (lane >> 4)) * I.ldw + I.n0 + 4 * (lane & 15);
#pragma unroll
    for (int i = 0; i < 16; ++i) v[i] = __builtin_nontemporal_load((const f32x4*)(p + (size_t)i * I.ldw));
}
__device__ __forceinline__ void bg_emit(const TrItem& I, const f32x4 (&v)[16], LAS unsigned* scr, int lane) {
    const int n4 = lane & 15, kq = lane >> 4;
#pragma unroll
    for (int q = 0; q < 4; ++q)
#pragma unroll
        for (int h = 0; h < 2; ++h) { u32x4 o; o.x = cvt_pk_bf16(v[8 * h + 0][q], v[8 * h + 1][q]); o.y = cvt_pk_bf16(v[8 * h + 2][q], v[8 * h + 3][q]); o.z = cvt_pk_bf16(v[8 * h + 4][q], v[8 * h + 5][q]); o.w = cvt_pk_bf16(v[8 * h + 6][q], v[8 * h + 7][q]);
            *(LAS u32x4*)(scr + (4 * n4 + q) * 36 + 8 * kq + 4 * h) = o; }
    LDS_WAIT(); asm volatile("" ::: "memory");
    const int c = lane & 7;
#pragma unroll
    for (int jj = 0; jj < 8; ++jj) { const int r = (lane >> 3) + 8 * jj, n = I.n0 + r; const u32x4 o = *(const LAS u32x4*)(scr + r * 36 + 4 * c);
        const int drow = I.gu ? (n >> 7) * 256 + I.p + (n & 127) : n;
        *(u32x4*)(I.dst + (size_t)drow * I.Kd + I.k0 + 8 * c) = o; }
    LDS_WAIT(); asm volatile("" ::: "memory");
}
__device__ __forceinline__ void bg_emit8(const TrItem& I, const f32x4 (&v)[16], LAS unsigned* scr, int lane) {
    const int n4 = lane & 15, kq = lane >> 4;
#pragma unroll
    for (int q = 0; q < 4; ++q) { u32x4 o;
        o.x = pk4_fp8(v[0][q] * W8_SCALE, v[1][q] * W8_SCALE, v[2][q] * W8_SCALE, v[3][q] * W8_SCALE); o.y = pk4_fp8(v[4][q] * W8_SCALE, v[5][q] * W8_SCALE, v[6][q] * W8_SCALE, v[7][q] * W8_SCALE);
        o.z = pk4_fp8(v[8][q] * W8_SCALE, v[9][q] * W8_SCALE, v[10][q] * W8_SCALE, v[11][q] * W8_SCALE); o.w = pk4_fp8(v[12][q] * W8_SCALE, v[13][q] * W8_SCALE, v[14][q] * W8_SCALE, v[15][q] * W8_SCALE);
        *(LAS u32x4*)(scr + (4 * n4 + q) * 20 + 4 * kq) = o; }
    LDS_WAIT(); asm volatile("" ::: "memory");
    const int c = lane & 3;
#pragma unroll
    for (int jj = 0; jj < 4; ++jj) { const int r = (lane >> 2) + 16 * jj, n = I.n0 + r; const u32x4 o = *(const LAS u32x4*)(scr + r * 20 + 4 * c);
        const int drow = I.gu ? (n >> 7) * 256 + I.p + (n & 127) : n;
        *(u32x4*)((unsigned char*)I.dst + (size_t)drow * I.Kd + I.k0 + 16 * c) = o; }
    LDS_WAIT(); asm volatile("" ::: "memory");
}
__device__ __forceinline__ void bg_convert_range(const KArgs& a, LAS unsigned char* lds, int kind, int l, int lo, int hi, int wave, int lane, int scr_off = 0, int scr_stride = 16384) {
    LAS unsigned* scr = (LAS unsigned*)(lds + scr_off + wave * scr_stride);
    TrItem A, B; f32x4 va[16], vb[16];
    int it = lo + wave;
    if (it < hi) { bg_decode(a, kind, l, it, A); bg_load(A, va, lane); }
#pragma unroll 1
    while (it < hi) {
        const int i1 = it + 8, i2 = it + 16;
        if (i1 < hi) { bg_decode(a, kind, l, i1, B); bg_load(B, vb, lane); }
        if (kind >= 2) bg_emit8(A, va, scr, lane); else bg_emit(A, va, scr, lane);
        if (i1 >= hi) break;
        if (i2 < hi) { bg_decode(a, kind, l, i2, A); bg_load(A, va, lane); }
        if (kind >= 2) bg_emit8(B, vb, scr, lane); else bg_emit(B, vb, scr, lane);
        it = i2;
    }
    VM_WAIT(); __syncthreads();
}
__device__ __forceinline__ void bg_share(int first, int last, int c, int G, int n_extra, int U, int& lo, int& hi) {
    const int N = last - first; int n_lo = (N + n_extra * U + G - 1) / G, n_hi = n_lo - U;
    if (n_hi < 0) { n_hi = 0; n_lo = (N + (G - n_extra) - 1) / (G - n_extra); }
    lo = first + (c < n_extra ? c * n_hi : n_extra * n_hi + (c - n_extra) * n_lo); hi = lo + (c < n_extra ? n_hi : n_lo);
    if (lo > last) lo = last; if (hi > last) hi = last;
}
__device__ __forceinline__ void bg_convert(const KArgs& a, LAS unsigned char* lds, int kind, int l, int vcu, int G, int wave, int lane) {
    const int NIT = (kind == 0 || kind == 2) ? 65 * 512 : 65 * 256, per = (NIT + G - 1) / G; const int lo = vcu * per, hi = lo + per < NIT ? lo + per : NIT;
    bg_convert_range(a, lds, kind, l, lo < NIT ? lo : NIT, hi, wave, lane);
}
__device__ __forceinline__ void phase_prologue(const KArgs& a, LAS unsigned char* lds, int vcu, int G, int wave, int lane) {
    unsigned char* ws = a.ws;
    LAS float* scr = (LAS float*)(lds + wave * 16384);
    const int gw = vcu * 8 + wave, NGW = G * 8;
    constexpr int C_IN = 2048, C_GRP = 512, C_OUT = 2048, C_KVD = 576, C_DQ = 512, C_UK = 512, C_UV = 512, C_UQ = 768, C_BO = 2048;
    constexpr int C_SMALL = C_IN + C_GRP + C_OUT + C_KVD + C_DQ + C_UK + C_UV + C_UQ + C_BO;
    constexpr int NITEMS = C_SMALL;
    for (int it = gw; it < NITEMS; it += NGW) {
        int r = it;
        if (r < C_IN) { tr_item(a.in[I_AWIN], 2048, (r / 64) * 64, (r % 64) * 32, (bf16_t*)(ws + WS_WIN), 2048, (r % 64) * 32, nullptr, scr, lane); continue; } r -= C_IN;
        if (r < C_GRP) { const int g = r / 128, q = r % 128; tr_item(a.in[I_AWGRP] + (size_t)g * 512 * 512, 512, (q / 16) * 64, (q % 16) * 32, (bf16_t*)(ws + WS_WGRP), 512, g * 512 + (q % 16) * 32, nullptr, scr, lane); continue; } r -= C_GRP;
        if (r < C_OUT) { tr_item(a.in[I_AWOUT], 2048, (r / 64) * 64, (r % 64) * 32, (bf16_t*)(ws + WS_WOUT), 2048, (r % 64) * 32, nullptr, scr, lane); continue; } r -= C_OUT;
        if (r < C_KVD) { const int n0 = (r % 18) * 32; tr_item(a.in[I_KVWD], 576, (r / 18) * 64, n0, (bf16_t*)(ws + WS_WKVQ), 2048, n0 < 512 ? n0 : 1024 + (n0 - 512), nullptr, scr, lane); continue; } r -= C_KVD;
        if (r < C_DQ) { const int n0 = (r % 16) * 32; tr_item(a.in[I_BWDQ], 512, (r / 16) * 64, n0, (bf16_t*)(ws + WS_WKVQ), 2048, 512 + n0, nullptr, scr, lane); continue; } r -= C_DQ;
        if (r < C_UK) { const int n0 = (r % 64) * 32; tr_item(a.in[I_KVWUK], 2048, (r / 64) * 64, n0, (bf16_t*)(ws + WS_WUP), 512, n0, a.in[I_KVNORM], scr, lane); continue; } r -= C_UK;
        if (r < C_UV) { const int n0 = (r % 64) * 32; tr_item(a.in[I_KVWUV], 2048, (r / 64) * 64, n0, (bf16_t*)(ws + WS_WUP), 512, 2048 + n0, a.in[I_KVNORM], scr, lane); continue; } r -= C_UV;
        if (r < C_UQ) { const int n0 = (r % 96) * 32, h = n0 / 192, d0 = n0 % 192;
            const int drow = d0 < 128 ? 4096 + h * 128 + d0 : 6144 + (h >> 2) * 256 + (d0 >= 160 ? 128 : 0) + (h & 3) * 32;
            tr_item(a.in[I_BWUQ], 3072, (r / 96) * 64, n0, (bf16_t*)(ws + WS_WUP), 512, drow, a.in[I_BQNORM], scr, lane); continue; } r -= C_UQ;
        tr_item(a.in[I_BWOUT], 2048, (r / 64) * 64, (r % 64) * 32, (bf16_t*)(ws + WS_WBO), 2048, (r % 64) * 32, nullptr, scr, lane);
    }
    bg_convert(a, lds, L0F8 == 2 ? 2 : 0, 0, vcu, G, wave, lane);
    const int gtid = gw * 64 + lane, NGT = NGW * 64;
    for (int i = gtid; i < 192 * 2048 * 2 / 16; i += NGT) ((u32x4*)(ws + WS_WKVQ + (size_t)1088 * 2048 * 2))[i] = (u32x4){0u, 0u, 0u, 0u};
    for (int i = gtid; i < SEQ * 32; i += NGT) { const int s = i >> 5, j = i & 31;
        const float inv = 1.0f / powf(10000.0f, (float)(2 * j) / 64.0f); const float ang = (float)s * inv;
        double rev = (double)ang * 0.15915494309189535; rev -= floor(rev); const float fr = (float)rev;
        ((f32x2*)(ws + WS_ROPE))[i] = (f32x2){__builtin_amdgcn_cosf(fr), __builtin_amdgcn_sinf(fr)}; }
    for (int i = gtid; i < 2 * DM * 64; i += NGT) { const int l = i / (DM * 64), rem = i - l * (DM * 64), d = rem >> 6, e = rem & 63;
        const float w = a.in[I_RW][i] * a.in[I_LN1G][l * DM + d]; const unsigned h = cvt_pk_bf16(w, 0.f) & 0xffffu; const float wl = w - __uint_as_float(h << 16);
        ((bf16_t*)(ws + WS_RWHI))[((size_t)l * 64 + e) * DM + d] = (bf16_t)h; ((bf16_t*)(ws + WS_RWLO))[((size_t)l * 64 + e) * DM + d] = (bf16_t)(cvt_pk_bf16(wl, 0.f) & 0xffffu); }
    for (int i = gw; i < 2 * 64; i += NGW) { const int l = i / 64, e = i % 64; float c1 = 0.f, c2 = 0.f;
#pragma unroll 16
        for (int d = lane; d < DM; d += 64) { const float w = a.in[I_RW][((size_t)l * DM + d) * 64 + e]; c1 += a.in[I_LN1G][l * DM + d] * w; c2 += a.in[I_LN1B][l * DM + d] * w; }
        c1 = wave_sum(c1); c2 = wave_sum(c2);
        if (lane == 0) { ((float*)(ws + WS_RC))[l * 64 + e] = c1; ((float*)(ws + WS_RC))[128 + l * 64 + e] = c2; } }
    const float* x = a.in[I_X];
    for (int task = gtid; task < NCHUNK * 512; task += NGT) {
        const int c4 = task & 511, t0 = (task >> 9) * 32, s0 = t0 & (SEQ - 1);
        const float* xc = x + c4 * 4;
        f32x4 w[32];
#pragma unroll
        for (int j = 0; j < 16; ++j) w[j] = s0 > 0 ? *(const f32x4*)(xc + (size_t)(t0 - 16 + j) * DM) : (f32x4){0.f, 0.f, 0.f, 0.f};
        f32x4 S2 = w[14] + w[15], S4 = (w[12] + w[13]) + S2, S8 = ((w[8] + w[9]) + (w[10] + w[11])) + S4, S16 = (((w[0] + w[1]) + (w[2] + w[3])) + ((w[4] + w[5]) + (w[6] + w[7]))) + S8;
#pragma unroll 1
        for (int hb = 0; hb < 2; ++hb) { const int tb = t0 + 16 * hb, sb0 = s0 + 16 * hb;
#pragma unroll
            for (int j = 0; j < 16; ++j) w[16 + j] = *(const f32x4*)(xc + (size_t)(tb + j) * DM);
#pragma unroll
            for (int j = 0; j < 16; ++j) { const int sq = sb0 + j; const f32x4 v = w[16 + j];
                S2 += v - w[16 + j - 2]; S4 += v - w[16 + j - 4]; S8 += v - w[16 + j - 8]; S16 += v - w[j];
                const float n2 = 1.f / (float)(sq + 1 < 2 ? sq + 1 : 2), n4 = 1.f / (float)(sq + 1 < 4 ? sq + 1 : 4), n8 = 1.f / (float)(sq + 1 < 8 ? sq + 1 : 8), n16 = 1.f / (float)(sq + 1 < 16 ? sq + 1 : 16);
                const f32x4 o2 = S2 * n2 - v, o4 = S4 * n4 - v, o8 = S8 * n8 - v, o16 = S16 * n16 - v;
                bf16_t* xp = (bf16_t*)(ws + WS_XP) + (size_t)(tb + j) * DM + c4 * 4;
                *(u32x2*)(xp) = (u32x2){cvt_pk_bf16(o2[0], o2[1]), cvt_pk_bf16(o2[2], o2[3])};
                *(u32x2*)(xp + (size_t)T * DM) = (u32x2){cvt_pk_bf16(o4[0], o4[1]), cvt_pk_bf16(o4[2], o4[3])};
                *(u32x2*)(xp + (size_t)2 * T * DM) = (u32x2){cvt_pk_bf16(o8[0], o8[1]), cvt_pk_bf16(o8[2], o8[3])};
                *(u32x2*)(xp + (size_t)3 * T * DM) = (u32x2){cvt_pk_bf16(o16[0], o16[1]), cvt_pk_bf16(o16[2], o16[3])}; }
#pragma unroll
            for (int j = 0; j < 16; ++j) w[j] = w[16 + j]; }
    }
}

__device__ __forceinline__ void route_token(float score, float choice, int lane, bool& sel, float& gate) {
    int cnt = 0;
    const float hm = dpp_f<DPP_HM>(choice);
    const float ocs[7] = {dpp_f<DPP_X1>(choice), dpp_f<DPP_X2>(choice), dpp_f<DPP_X3>(choice), dpp_f<DPP_X3>(hm), dpp_f<DPP_X2>(hm), dpp_f<DPP_X1>(hm), hm};
#pragma unroll
    for (int o = 1; o < 8; ++o) { const float oc = ocs[o - 1]; const int j = lane ^ o; cnt += (oc > choice || (oc == choice && j < lane)) ? 1 : 0; }
    float gs = cnt < 2 ? choice : 0.f;
    gs += dpp_f<DPP_X1>(gs); gs += dpp_f<DPP_X2>(gs); gs += dpp_f<DPP_HM>(gs);
    int gcnt = 0;
#pragma unroll
    for (int o = 8; o < 64; o += 8) { const float og = __shfl_xor(gs, o); const int gj = (lane ^ o) >> 3; gcnt += (og > gs || (og == gs && gj < (lane >> 3))) ? 1 : 0; }
    const bool gsel = gcnt < 4;
    float cur = gsel ? choice : -__builtin_inff();
    unsigned long long selmask = 0ull;
#pragma unroll 1
    for (int it = 0; it < 8; ++it) { const float m = wave_max(cur);
        const unsigned long long b = __ballot(cur == m); const int w = __ffsll((long long)b) - 1;
        selmask |= 1ull << w; if (lane == w) cur = -__builtin_inff(); }
    sel = ((selmask >> lane) & 1ull) != 0ull;
    const float ssum = wave_sum(sel ? score : 0.f);
    gate = score / ssum * 2.5f;
}
__device__ __forceinline__ void phase_r1(const KArgs& a, LAS unsigned char* lds, int l, int G, int wave, int lane) {
    unsigned char* ws = a.ws;
    const bf16_t* z = (const bf16_t*)(ws + WS_Z);
    LAS float* P = (LAS float*)lds;
    LAS float* SX = (LAS float*)(lds + 65536);
    LAS unsigned long long* MK = (LAS unsigned long long*)(lds + 65536 + 2048);
    LAS float* ST = (LAS float*)(lds + 65536 + 2048 + 256);
    const int r32 = lane & 31, hi = lane >> 5;
    const float* c1 = (const float*)(ws + WS_RC) + l * 64; const float* c2 = (const float*)(ws + WS_RC) + 128 + l * 64;
    const float* rbias = a.in[I_RB] + l * 64;
    const float* g1 = a.in[I_LN1G] + l * DM; const float* b1 = a.in[I_LN1B] + l * DM;
    int* toke = (int*)(ws + WS_TOKE); float* tokg = (float*)(ws + WS_TOKG); int* cntp = (int*)(ws + WS_CNT);
    bf16_t* x1h = (bf16_t*)(ws + WS_X1F); bf16_t* x1b = (bf16_t*)(ws + WS_X1B);
    for (int ch = blockIdx.x; ch < NCHUNK; ch += G) {
        const int row0 = ch * 32;
        {
            f32x16 acc0 = {}, acc1 = {}; float s1 = 0.f, s2 = 0.f;
            const bf16_t* zr = z + (size_t)(row0 + r32) * DM + 256 * wave + 8 * hi;
            const bf16_t* bh = (const bf16_t*)(ws + WS_RWHI) + ((size_t)l * 64 + r32) * DM + 256 * wave + 8 * hi;
            const bf16_t* bl = (const bf16_t*)(ws + WS_RWLO) + ((size_t)l * 64 + r32) * DM + 256 * wave + 8 * hi;
#pragma unroll 4
            for (int kk = 0; kk < 16; ++kk) {
                const u32x4 zw = *(const u32x4*)(zr + 16 * kk);
                const f32x4 va = {bf_lo(zw.x), bf_hi(zw.x), bf_lo(zw.y), bf_hi(zw.y)}, vb = {bf_lo(zw.z), bf_hi(zw.z), bf_lo(zw.w), bf_hi(zw.w)};
                s1 += (va[0] + va[1]) + (va[2] + va[3]) + (vb[0] + vb[1]) + (vb[2] + vb[3]);
                s2 += (va[0] * va[0] + va[1] * va[1]) + (va[2] * va[2] + va[3] * va[3]) + (vb[0] * vb[0] + vb[1] * vb[1]) + (vb[2] * vb[2] + vb[3] * vb[3]);
                const bf16x8 ah = __builtin_bit_cast(bf16x8, zw);
                const bf16x8 bh0 = *(const bf16x8*)(bh + 16 * kk), bh1 = *(const bf16x8*)(bh + (size_t)32 * DM + 16 * kk);
                const bf16x8 bl0 = *(const bf16x8*)(bl + 16 * kk), bl1 = *(const bf16x8*)(bl + (size_t)32 * DM + 16 * kk);
                acc0 = __builtin_amdgcn_mfma_f32_32x32x16_bf16(ah, bh0, acc0, 0, 0, 0); acc0 = __builtin_amdgcn_mfma_f32_32x32x16_bf16(ah, bl0, acc0, 0, 0, 0);
                acc1 = __builtin_amdgcn_mfma_f32_32x32x16_bf16(ah, bh1, acc1, 0, 0, 0); acc1 = __builtin_amdgcn_mfma_f32_32x32x16_bf16(ah, bl1, acc1, 0, 0, 0);
            }
#pragma unroll
            for (int r = 0; r < 16; ++r) { const int tk = (r & 3) + 8 * (r >> 2) + 4 * hi; P[(wave * 32 + tk) * 64 + r32] = acc0[r]; P[(wave * 32 + tk) * 64 + 32 + r32] = acc1[r]; }
            s1 += __shfl_xor(s1, 32); s2 += __shfl_xor(s2, 32);
            if (hi == 0) { SX[(wave * 32 + r32) * 2] = s1; SX[(wave * 32 + r32) * 2 + 1] = s2; }
        }
        __syncthreads();
#pragma unroll 1
        for (int j = 0; j < 4; ++j) { const int i = 4 * wave + j, t = row0 + i;
            float dot = 0.f, S1 = 0.f, S2 = 0.f;
#pragma unroll
            for (int w = 0; w < 8; ++w) { dot += P[(w * 32 + i) * 64 + lane]; S1 += SX[(w * 32 + i) * 2]; S2 += SX[(w * 32 + i) * 2 + 1]; }
            const float mu = S1 * (1.f / DM), var = S2 * (1.f / DM) - mu * mu, rstd = 1.f / sqrtf(var + LN_EPS);
            const float logit = rstd * (dot - mu * c1[lane]) + c2[lane];
            const float score = 1.f / (1.f + __expf(-logit));
            const float choice = score + rbias[lane];
            bool sel; float gate; route_token(score, choice, lane, sel, gate);
            const unsigned long long mask = __ballot(sel);
            if (lane == 0) { MK[i] = mask; ST[2 * i] = mu; ST[2 * i + 1] = rstd; }
            if (sel) { const int rk8 = __popcll(mask & ((1ull << lane) - 1ull)); tokg[t * 8 + rk8] = gate; }
        }
        __syncthreads();
#pragma unroll 1
        for (int j = 0; j < 4; ++j) { const int i = 4 * wave + j, t = row0 + i; const unsigned long long mask = MK[i];
            int lr = 0; for (int q = 0; q < i; ++q) lr += (int)((MK[q] >> lane) & 1ull);
            if ((mask >> lane) & 1ull) { const int rk8 = __popcll(mask & ((1ull << lane) - 1ull)); toke[t * 8 + rk8] = (lane << 16) | lr; } }
        if (wave == 0) { int c = 0; for (int q = 0; q < 32; ++q) c += (int)((MK[q] >> lane) & 1ull); cntp[ch * 64 + lane] = c; }
#pragma unroll 1
        for (int j = 0; j < 4; ++j) { const int i = 4 * wave + j, t = row0 + i; const float mu = ST[2 * i], rstd = ST[2 * i + 1];
            f32x4 xo[8];
#pragma unroll
            for (int jj = 0; jj < 8; ++jj) { const int col = 4 * lane + 256 * jj; const u32x2 zw = *(const u32x2*)(z + (size_t)t * DM + col); const f32x4 zv = {bf_lo(zw.x), bf_hi(zw.x), bf_lo(zw.y), bf_hi(zw.y)}, g = *(const f32x4*)(g1 + col), b = *(const f32x4*)(b1 + col);
                xo[jj] = (zv - mu) * rstd * g + b; }
#pragma unroll
            for (int jj = 0; jj < 8; ++jj) { const int col = 4 * lane + 256 * jj;
                const u32x2 xb = {cvt_pk_bf16(xo[jj][0], xo[jj][1]), cvt_pk_bf16(xo[jj][2], xo[jj][3])};
                *(u32x2*)(x1h + (size_t)t * DM + col) = xb;
                if (l == 0 && L0F8 != 2) *(u32x2*)(x1b + (size_t)t * DM + col) = xb;
                if (l == 1 || L0F8 == 2) *(unsigned*)(ws + WS_X1Q + (size_t)t * DM + col) = pk4_fp8(xo[jj][0], xo[jj][1], xo[jj][2], xo[jj][3]); } }
        __syncthreads();
    }
}

__device__ __forceinline__ void phase_r2(const KArgs& a, LAS unsigned char* lds, int G, int tid, int wave, int lane) {
    unsigned char* ws = a.ws;
    LAS int* PA = (LAS int*)lds; LAS int* PB = PA + 512; LAS int* SB = PA + 1024; LAS int* TOT = PA + 1088; LAS int* TB = PA + 1152;
    const int* cntp = (const int*)(ws + WS_CNT); const int* toke = (const int*)(ws + WS_TOKE);
    int* toks = (int*)(ws + WS_TOKS); int* rowidx = (int*)(ws + WS_ROWIDX); int* mte = (int*)(ws + WS_MTE); int* nmtp = (int*)(ws + WS_NMT);
    for (int ch = blockIdx.x; ch < NCHUNK; ch += G) {
        { int sa = 0, sb = 0; for (int c = 32 * wave; c < 32 * wave + 32; ++c) { const int v = cntp[c * 64 + lane]; sa += v; if (c < ch) sb += v; } PA[wave * 64 + lane] = sa; PB[wave * 64 + lane] = sb; }
        __syncthreads();
        if (wave == 0) { int tot = 0, off = 0;
#pragma unroll
            for (int w = 0; w < 8; ++w) { tot += PA[w * 64 + lane]; off += PB[w * 64 + lane]; }
            const int nt = (tot + 255) >> 8; int incl = nt;
#pragma unroll
            for (int o = 1; o < 64; o <<= 1) { const int v = __shfl_up(incl, o); if (lane >= o) incl += v; }
            const int tb = incl - nt;
            SB[lane] = 8192 + 256 * tb + off; TOT[lane] = tot; TB[lane] = tb;
            if (ch == 0) { for (int q = 0; q < nt; ++q) mte[32 + tb + q] = lane; if (lane < 32) mte[lane] = 64; if (lane == 63) *nmtp = 32 + incl; } }
        __syncthreads();
        if (tid < 256) { const int t = ch * 32 + (tid >> 3), k = tid & 7; const int pk = toke[t * 8 + k]; const int e = pk >> 16, lr = pk & 0xffff; const int slot = SB[e] + lr; rowidx[slot] = t; toks[t * 8 + k] = slot; }
        else if (tid < 288) { const int t = ch * 32 + (tid - 256); rowidx[t] = t; }
        if (ch < 64 && tid < 256) { const int tot = TOT[ch], tb = TB[ch], nt = (tot + 255) >> 8; const int p = tot + tid; if (p < 256 * nt) rowidx[8192 + 256 * tb + p] = 0; }
        __syncthreads();
    }
}

__device__ __forceinline__ void phase_ln2(const KArgs& a, int l, int vcu, int G, int wave, int lane) {
    unsigned char* ws = a.ws;
    const bf16_t* x1h = (const bf16_t*)(ws + WS_X1F); const unsigned char* Y = ws + WS_Y;
    const int* toks = (const int*)(ws + WS_TOKS); const float* tokg = (const float*)(ws + WS_TOKG);
    const float* g2 = a.in[I_LN2G] + l * DM; const float* b2 = a.in[I_LN2B] + l * DM;
    float* outf = a.out; bf16_t* outb = (bf16_t*)(ws + WS_X2B);
    const int gw = vcu * 8 + wave, NGW = G * 8;
    for (int t = gw; t < T; t += NGW) {
        const int slot_l = lane < 8 ? toks[t * 8 + lane] : 0; const float g_l = lane < 8 ? tokg[t * 8 + lane] * (1.f / Y8_SCALE) : 0.f;
        float v[4][8];
#define LN2_ADD(j, g, yoff) do { const u32x2 yw = __builtin_nontemporal_load((const u32x2*)(Y + (yoff))); \
            const f32x2 a0 = __builtin_amdgcn_cvt_pk_f32_fp8((int)yw.x, false), a1 = __builtin_amdgcn_cvt_pk_f32_fp8((int)yw.x, true), a2 = __builtin_amdgcn_cvt_pk_f32_fp8((int)yw.y, false), a3 = __builtin_amdgcn_cvt_pk_f32_fp8((int)yw.y, true); \
            v[j][0] += (g) * a0[0]; v[j][1] += (g) * a0[1]; v[j][2] += (g) * a1[0]; v[j][3] += (g) * a1[1]; v[j][4] += (g) * a2[0]; v[j][5] += (g) * a2[1]; v[j][6] += (g) * a3[0]; v[j][7] += (g) * a3[1]; } while (0)
#pragma unroll
        for (int j = 0; j < 4; ++j) { const int col = 8 * lane + 512 * j; const u32x4 xw = *(const u32x4*)(x1h + (size_t)t * DM + col);
            v[j][0] = ALPHA * bf_lo(xw.x); v[j][1] = ALPHA * bf_hi(xw.x); v[j][2] = ALPHA * bf_lo(xw.y); v[j][3] = ALPHA * bf_hi(xw.y);
            v[j][4] = ALPHA * bf_lo(xw.z); v[j][5] = ALPHA * bf_hi(xw.z); v[j][6] = ALPHA * bf_lo(xw.w); v[j][7] = ALPHA * bf_hi(xw.w);
            LN2_ADD(j, (1.f / Y8_SCALE), (size_t)t * DM + col); }
#pragma unroll
        for (int k = 0; k < 8; ++k) { const int slot = __builtin_amdgcn_readlane(slot_l, k); const float g = __uint_as_float((unsigned)__builtin_amdgcn_readlane((int)__float_as_uint(g_l), k));
#pragma unroll
            for (int j = 0; j < 4; ++j) LN2_ADD(j, g, (size_t)slot * DM + 8 * lane + 512 * j); }
#undef LN2_ADD
        float s = 0.f;
#pragma unroll
        for (int j = 0; j < 4; ++j)
#pragma unroll
            for (int q = 0; q < 8; ++q) s += v[j][q];
        const float mean = wave_sum_x(s) * (1.f / DM); float s2 = 0.f;
#pragma unroll
        for (int j = 0; j < 4; ++j)
#pragma unroll
            for (int q = 0; q < 8; ++q) { v[j][q] -= mean; s2 += v[j][q] * v[j][q]; }
        const float rstd = 1.f / sqrtf(wave_sum_x(s2) * (1.f / DM) + LN_EPS);
#pragma unroll
        for (int j = 0; j < 4; ++j) { const int col = 8 * lane + 512 * j; const f32x4 ga = *(const f32x4*)(g2 + col), gb = *(const f32x4*)(g2 + col + 4), ba = *(const f32x4*)(b2 + col), bb = *(const f32x4*)(b2 + col + 4);
#pragma unroll
            for (int q = 0; q < 4; ++q) { v[j][q] = v[j][q] * rstd * ga[q] + ba[q]; v[j][4 + q] = v[j][4 + q] * rstd * gb[q] + bb[q]; } }
#pragma unroll
        for (int j = 0; j < 4; ++j) { const int col = 8 * lane + 512 * j;
            if (l == 1) { *(f32x4*)(outf + (size_t)t * DM + col) = (f32x4){v[j][0], v[j][1], v[j][2], v[j][3]}; *(f32x4*)(outf + (size_t)t * DM + col + 4) = (f32x4){v[j][4], v[j][5], v[j][6], v[j][7]}; }
            if (l == 0) *(u32x4*)(outb + (size_t)t * DM + col) = (u32x4){cvt_pk_bf16(v[j][0], v[j][1]), cvt_pk_bf16(v[j][2], v[j][3]), cvt_pk_bf16(v[j][4], v[j][5]), cvt_pk_bf16(v[j][6], v[j][7])}; }
    }
}

__device__ __forceinline__ void phase_stats(const KArgs& a, int vcu, int G, int wave, int lane) {
    unsigned char* ws = a.ws;
    const bf16_t* ckq = (const bf16_t*)(ws + WS_CKQ); float* rstat = (float*)(ws + WS_RSTAT); bf16_t* Kb = (bf16_t*)(ws + WS_K); const f32x2* rope = (const f32x2*)(ws + WS_ROPE);
    const int gw = vcu * 8 + wave, NGW = G * 8;
    for (int t = gw; t < T; t += NGW) { const bf16_t* row = ckq + (size_t)t * NCKQ;
        const u32x4 c = *(const u32x4*)(row + 8 * lane), q = *(const u32x4*)(row + 512 + 8 * lane);
        float sc = bf_lo(c.x) * bf_lo(c.x) + bf_hi(c.x) * bf_hi(c.x) + bf_lo(c.y) * bf_lo(c.y) + bf_hi(c.y) * bf_hi(c.y) + bf_lo(c.z) * bf_lo(c.z) + bf_hi(c.z) * bf_hi(c.z) + bf_lo(c.w) * bf_lo(c.w) + bf_hi(c.w) * bf_hi(c.w);
        float sq = bf_lo(q.x) * bf_lo(q.x) + bf_hi(q.x) * bf_hi(q.x) + bf_lo(q.y) * bf_lo(q.y) + bf_hi(q.y) * bf_hi(q.y) + bf_lo(q.z) * bf_lo(q.z) + bf_hi(q.z) * bf_hi(q.z) + bf_lo(q.w) * bf_lo(q.w) + bf_hi(q.w) * bf_hi(q.w);
        sc = wave_sum(sc); sq = wave_sum(sq);
        if (lane == 0) { rstat[t] = 1.f / sqrtf(sc * (1.f / 512.f) + RMS_EPS); rstat[T + t] = 1.f / sqrtf(sq * (1.f / 512.f) + RMS_EPS); }
        const int i = lane & 31, s = t & (SEQ - 1);
        const float x1 = __uint_as_float((unsigned)row[1024 + i] << 16), x2 = __uint_as_float((unsigned)row[1056 + i] << 16);
        const f32x2 cs = rope[s * 32 + i];
        const float o = lane < 32 ? x1 * cs[0] - x2 * cs[1] : x2 * cs[0] + x1 * cs[1];
        const bf16_t ob = (bf16_t)(cvt_pk_bf16(o, 0.f) & 0xffffu);
        bf16_t* kr = Kb + (size_t)t * (NH * DQK) + 128 + lane;
#pragma unroll
        for (int h = 0; h < NH; ++h) kr[h * DQK] = ob;
    }
}

struct AttHook { const KArgs* a; LAS unsigned char* lds; int vcu, G, wave, lane;
    __device__ __forceinline__ void operator()() const { const int NIT = 65 * 512, per = (NIT + G - 1) / G, lo = vcu * per, hi = lo + per;
        __syncthreads(); bg_convert_range(*a, lds, 2, 1, lo < NIT ? lo : NIT, hi < NIT ? hi : NIT, wave, lane, 90112, 5120); } };
constexpr int N_PHASES = 19;
__global__ void __launch_bounds__(512, 2) fwd_kernel(KArgs a) {
    extern __shared__ __attribute__((aligned(16))) unsigned char lds_raw[];
    LAS unsigned char* lds = (LAS unsigned char*)lds_raw;
    volatile LAS unsigned* MISC = (volatile LAS unsigned*)(lds + MISC_OFF);
    const int tid = threadIdx.x, lane = tid & 63, wave = __builtin_amdgcn_readfirstlane(tid >> 6);
    const int G = gridDim.x; int bx = blockIdx.x; int vcu = (G % 8 == 0) ? (bx % 8) * (G / 8) + bx / 8 : bx;
    unsigned char* ws = a.ws;
    if (tid < 32) MISC[tid] = 0u;
    __syncthreads();
    XcdBarrier bar; bar.bar = (unsigned*)(ws + WS_CTL) + CW_BAR; bar.x = 0; bar.st = nullptr;
    if (MK_N_LAUNCHES == 1) bar = xcd_barrier_post((unsigned*)(ws + WS_CTL) + CW_BAR, MISC + 8);
    const int lo = a.ph_lo, hi = a.ph_hi;
#ifndef PHMASK
#define PHMASK 0xFFFFFFu
#endif
#define PH(k) ((((PHMASK) >> (k)) & 1u) && lo <= (k) && (k) < hi)
#define SEAM(k) do { if (PH(k) && PH((k) + 1)) xcd_barrier(bar); } while (0)

constexpr int G6_ITEMS = 96 * 60;
#ifndef HWIDS
#define HWIDS 1
#endif
#ifndef EXPER
#define EXPER 0
#endif
#ifndef REPMASK
#define REPMASK 0x0u
#endif
#define RUN(k, BODY) do { if (PH(k)) { BODY; if ((REPMASK >> (k)) & 1u) { __syncthreads(); BODY; } } } while (0)
#define P_G1 do { DenseSched S; S.ord.init(32, 8, G, bx); S.A = (const char*)(ws + WS_XP); S.B = (const char*)(ws + WS_WIN); S.lda_b = DM * 2; S.K = DM; S.mode = 1; S.agrp = (size_t)T * DM * 2; \
        EpiBf16 E{(bf16_t*)(ws + WS_POOLED), DM, nullptr, 0, 1.f}; pg8::gemm_phase(lds, DM * 2, DM, S, E); } while (0)
#define P_G2 do { DenseSched S; S.ord.init(32, 8, G, bx); S.A = (const char*)(ws + WS_POOLED); S.B = (const char*)(ws + WS_WGRP); S.lda_b = DM * 2; S.K = 512; S.mode = 1; S.agrp = 1024; \
        EpiBf16 E{(bf16_t*)(ws + WS_MIXED), DM, a.in[I_ASCALE], 0, 1.f}; pg8::gemm_phase(lds, DM * 2, 512, S, E); } while (0)
#define P_G3 do { DenseSched S; S.ord.init(32, 8, G, bx); S.A = (const char*)(ws + WS_MIXED); S.B = (const char*)(ws + WS_WOUT); S.lda_b = DM * 2; S.K = DM; S.mode = 0; S.agrp = 0; \
        EpiZ E{a.in[I_X], nullptr, (bf16_t*)(ws + WS_Z)}; pg8::gemm_phase(lds, DM * 2, DM, S, E); } while (0)
#define P_G4(l, BGK, BGL, NR, BGF, BGT) do { const int nmt = __builtin_amdgcn_readfirstlane(*(const int*)(ws + WS_NMT)); const int isp = (BGK) >= 0 ? (vcu >> 5) % (NR) : 1 << 20; \
        MoeSched S{(const int*)(ws + WS_MTE), (const int*)(ws + WS_ROWIDX), (const char*)(ws + WS_X1B), (const char*)(ws + WS_WGU) + (size_t)(l) * 65 * 1024 * 2048 * 2, nmt * 4, 4, G, vcu, 1, \
                   (size_t)1024 * 2048 * 2, (size_t)256 * 2048 * 2, 0, 0, isp}; \
        EpiSwiGLU E{(bf16_t*)(ws + WS_H), 1.f, 0}; pg8::gemm_phase(lds, DM * 2, DM, S, E); \
        if ((BGK) >= 0) { int blo, bhi; bg_share((BGF), (BGT), vcu, G, S.nunits % G, 55, blo, bhi); bg_convert_range(a, lds, (BGK), (BGL), blo, bhi, wave, lane); S.i0 = isp; S.i1 = 1 << 20; pg8::gemm_phase(lds, DM * 2, DM, S, E); } } while (0)
#define P_G4H(l, BGK, BGL, NR, BGF, BGT) do { const int nmt = __builtin_amdgcn_readfirstlane(*(const int*)(ws + WS_NMT)); const int isp = (BGK) >= 0 ? (vcu >> 5) % (NR) : 1 << 20; \
        MoeSched S{(const int*)(ws + WS_MTE), (const int*)(ws + WS_ROWIDX), (const char*)(ws + WS_X1B), (const char*)(ws + WS_WGU) + (size_t)(l) * 65 * 1024 * 2048 * 2, nmt * 4, 4, G, vcu, 1, \
                   (size_t)1024 * 2048 * 2, (size_t)256 * 2048 * 2, 0, 0, isp}; \
        EpiSwiGLU E{(bf16_t*)(ws + WS_H), 1.f, 1}; pg8::gemm_phase(lds, DM * 2, DM, S, E); \
        if ((BGK) >= 0) { int blo, bhi; bg_share((BGF), (BGT), vcu, G, S.nunits % G, 55, blo, bhi); bg_convert_range(a, lds, (BGK), (BGL), blo, bhi, wave, lane); S.i0 = isp; S.i1 = 1 << 20; pg8::gemm_phase(lds, DM * 2, DM, S, E); } } while (0)
#define P_G4F(l, BGK, BGL, NR, BGF, BGT) do { const int nmt = __builtin_amdgcn_readfirstlane(*(const int*)(ws + WS_NMT)); const int isp = (BGK) >= 0 ? (vcu >> 5) % (NR) : 1 << 20; \
        MoeSchedT<true> S{(const int*)(ws + WS_MTE), (const int*)(ws + WS_ROWIDX), (const char*)(ws + WS_X1Q), (const char*)(ws + WS_WGU) + (size_t)(l) * 65 * 1024 * 2048 * 2, nmt * 4, 4, G, vcu, 1, \
                   (size_t)1024 * 2048, (size_t)256 * 2048, 0, 0, isp}; \
        EpiSwiGLU E{(bf16_t*)(ws + WS_H), 1.f / W8_SCALE, 1}; pg8::gemm_phase(lds, DM, DM / 2, S, E); \
        if ((BGK) >= 0) { int blo, bhi; bg_share((BGF), (BGT), vcu, G, S.nunits % G, 30, blo, bhi); bg_convert_range(a, lds, (BGK), (BGL), blo, bhi, wave, lane); S.i0 = isp; S.i1 = 1 << 20; pg8::gemm_phase(lds, DM, DM / 2, S, E); } } while (0)
#define P_G5(l, BGK, BGL, NR, BGF, BGT) do { const int nmt = __builtin_amdgcn_readfirstlane(*(const int*)(ws + WS_NMT)); const int isp = (BGK) >= 0 ? (vcu >> 5) % (NR) : 1 << 20; \
        MoeSched S{(const int*)(ws + WS_MTE), (const int*)(ws + WS_ROWIDX), (const char*)(ws + WS_H), (const char*)(ws + WS_WD) + (size_t)(l) * 65 * 2048 * 512 * 2, nmt * 8, 8, G, vcu, 0, \
                   (size_t)2048 * 512 * 2, (size_t)256 * 512 * 2, (size_t)256 * 1024, 0, isp}; \
        EpiBf16 E{(bf16_t*)(ws + WS_Y), DM, nullptr, 1, 1.f}; pg8::gemm_phase(lds, ED * 2, ED, S, E); \
        if ((BGK) >= 0) { int blo, bhi; bg_share((BGF), (BGT), vcu, G, S.nunits % G, 20, blo, bhi); bg_convert_range(a, lds, (BGK), (BGL), blo, bhi, wave, lane); S.i0 = isp; S.i1 = 1 << 20; pg8::gemm_phase(lds, ED * 2, ED, S, E); } } while (0)
#define P_G5F(l, BGK, BGL, NR, BGF, BGT) do { const int nmt = __builtin_amdgcn_readfirstlane(*(const int*)(ws + WS_NMT)); const int isp = (BGK) >= 0 ? (vcu >> 5) % (NR) : 1 << 20; \
        MoeSchedT<true> S{(const int*)(ws + WS_MTE), (const int*)(ws + WS_ROWIDX), (const char*)(ws + WS_H), (const char*)(ws + WS_WD) + (size_t)(l) * 65 * 2048 * 512 * 2, nmt * 8, 8, G, vcu, 0, \
                   (size_t)2048 * 512, (size_t)256 * 512, (size_t)256 * 512, 0, isp}; \
        EpiY8 E{ws + WS_Y, Y8_SCALE / W8_SCALE}; pg8::gemm_phase(lds, ED, ED / 2, S, E); \
        if ((BGK) >= 0) { int blo, bhi; bg_share((BGF), (BGT), vcu, G, S.nunits % G, 12, blo, bhi); bg_convert_range(a, lds, (BGK), (BGL), blo, bhi, wave, lane); S.i0 = isp; S.i1 = 1 << 20; pg8::gemm_phase(lds, ED, ED / 2, S, E); } } while (0)
#define P_G6 do { if (G > 160 && bx >= 160) { const int per = (G6_ITEMS + (G - 160) - 1) / (G - 160), blo = (bx - 160) * per, bhi = blo + per; bg_convert_range(a, lds, 3, 1, blo < G6_ITEMS ? blo : G6_ITEMS, bhi < G6_ITEMS ? bhi : G6_ITEMS, wave, lane); } \
        DenseSched S; S.ord.init(32, 5, G, bx); S.A = (const char*)(ws + WS_X2B); S.B = (const char*)(ws + WS_WKVQ); S.lda_b = DM * 2; S.K = DM; S.mode = 0; S.agrp = 0; \
        EpiBf16 E{(bf16_t*)(ws + WS_CKQ), NCKQ, nullptr, 0, 1.f}; pg8::gemm_phase(lds, DM * 2, DM, S, E); } while (0)
#define P_G7 do { DenseSched S; S.ord.init(32, 28, G, bx); S.A = (const char*)(ws + WS_CKQ); S.B = (const char*)(ws + WS_WUP); S.lda_b = NCKQ * 2; S.K = 512; S.mode = 2; S.agrp = 0; \
        EpiUp E{(bf16_t*)(ws + WS_Q), (bf16_t*)(ws + WS_K), (bf16_t*)(ws + WS_V), (const float*)(ws + WS_RSTAT), (const f32x2*)(ws + WS_ROPE)}; pg8::gemm_phase(lds, NCKQ * 2, 512, S, E); } while (0)
#define P_ATT do { AttHook H{&a, lds, vcu, G, wave, lane}; att::attn_phase((att::lptr)lds, (const bf16_t*)(ws + WS_Q), (const bf16_t*)(ws + WS_K), (const bf16_t*)(ws + WS_V), (bf16_t*)(ws + WS_ATT), vcu, G, H); } while (0)
#define P_G8 do { DenseSched S; S.ord.init(32, 8, G, bx); S.A = (const char*)(ws + WS_ATT); S.B = (const char*)(ws + WS_WBO); S.lda_b = DM * 2; S.K = DM; S.mode = 0; S.agrp = 0; \
        EpiZ E{nullptr, (const bf16_t*)(ws + WS_X2B), (bf16_t*)(ws + WS_Z)}; pg8::gemm_phase(lds, DM * 2, DM, S, E); } while (0)
#define MOE_PHASES(l, pb, K4, L4, F4, T4, K5, L5, F5, T5, G4M, G5M) do { \
        RUN(pb, phase_r1(a, lds, l, G, wave, lane)); SEAM(pb); \
        RUN((pb) + 1, phase_r2(a, lds, G, tid, wave, lane)); \
        if (EXPER && (l) == 0 && PH((pb) + 1)) { __syncthreads(); if (EXPER == 1 ? vcu < 32 : EXPER == 2 ? (vcu & 7) == 0 : EXPER == 3 ? true : EXPER == 4 ? vcu < 64 : (vcu & 3) == 0) bg_convert(a, lds, 1, 1, vcu, G, wave, lane); } \
        SEAM((pb) + 1); \
        RUN((pb) + 2, G4M(l, K4, L4, 5, F4, T4)); SEAM((pb) + 2); \
        RUN((pb) + 3, G5M(l, K5, L5, 10, F5, T5)); SEAM((pb) + 3); \
        RUN((pb) + 4, phase_ln2(a, l, vcu, G, wave, lane)); } while (0)

    RUN(0, phase_prologue(a, lds, vcu, G, wave, lane)); SEAM(0);
    if (MK_N_LAUNCHES == 1 && HWIDS && PH(0) && PH(1) && G % 8 == 0) {
        const unsigned* cen = (const unsigned*)(ws + WS_CTL) + CW_BAR; bool ok = true;
#pragma unroll
        for (int j = 0; j < 16; ++j) { const unsigned c = __hip_atomic_load(cen + XB_XCNT(j), __ATOMIC_RELAXED, __HIP_MEMORY_SCOPE_AGENT); ok = ok && (c == (j < 8 ? (unsigned)(G / 8) : 0u)); }
        const int rank = (int)MISC[16], xcc = (int)MISC[17];
        if (ok && xcc < 8 && rank < G / 8) { vcu = xcc * (G / 8) + rank; bx = rank * 8 + xcc; }
    }
    RUN(1, P_G1); SEAM(1);
    RUN(2, P_G2); SEAM(2);
    RUN(3, P_G3); SEAM(3);
    MOE_PHASES(0, 4, L0F8 ? 3 : 1, 0, 0, 65 * 256, -1, 1, 0, 0, P_G4SEL, P_G5SEL); SEAM(8);
    RUN(9, P_G6); SEAM(9);
    RUN(10, phase_stats(a, vcu, G, wave, lane)); SEAM(10);
    RUN(11, P_G7); SEAM(11);
    RUN(12, P_ATT); SEAM(12);
    RUN(13, P_G8); SEAM(13);
    MOE_PHASES(1, 14, 3, 1, (G > 160 ? G6_ITEMS : 0), 65 * 256, -1, 0, 0, 0, P_G4F, P_G5F);
#undef MOE_PHASES
#undef RUN
#undef PH
#undef SEAM
}

extern "C" void kernel_launch(void* const* d_in, const int* in_sizes, int n_in, void* d_out, int out_size, void* d_ws, size_t ws_size, hipStream_t stream) {
    static int grid = 0;
    if (grid == 0) {
        if (n_in != 25 || out_size != T * DM || ws_size < WS_END) { fprintf(stderr, "kernel_launch: unexpected shapes (n_in %d, out %d, ws %zu)\n", n_in, out_size, ws_size); grid = -1; return; }
        int dev = 0, cus = 0;
        if (hipGetDevice(&dev) != hipSuccess || hipDeviceGetAttribute(&cus, hipDeviceAttributeMultiprocessorCount, dev) != hipSuccess) { grid = -1; return; }
        if (hipFuncSetAttribute((const void*)fwd_kernel, hipFuncAttributeMaxDynamicSharedMemorySize, LDS_BYTES) != hipSuccess) { fprintf(stderr, "kernel_launch: hipFuncSetAttribute failed\n"); grid = -1; return; }
        int per_cu = 0;
        if (hipOccupancyMaxActiveBlocksPerMultiprocessor(&per_cu, (const void*)fwd_kernel, 512, LDS_BYTES) != hipSuccess || per_cu < 1) fprintf(stderr, "kernel_launch: occupancy query reports %d blocks per CU\n", per_cu);
        (void)hipGetLastError();
        grid = cus;
    }
    if (grid < 0) return;
    (void)hipMemsetAsync((char*)d_ws + WS_CTL, 0, CTL_ZERO_BYTES, stream);
    KArgs a{};
    for (int i = 0; i < 25; ++i) a.in[i] = (const float*)d_in[i];
    a.out = (float*)d_out; a.ws = (unsigned char*)d_ws;
#if MK_N_LAUNCHES == 1
    a.ph_lo = 0; a.ph_hi = N_PHASES;
    hipLaunchKernelGGL(fwd_kernel, dim3(grid), dim3(512), LDS_BYTES, stream, a);
#else
    for (int k = 0; k < N_PHASES; ++k) { a.ph_lo = k; a.ph_hi = k + 1; hipLaunchKernelGGL(fwd_kernel, dim3(grid), dim3(512), LDS_BYTES, stream, a); }
#endif
}
```

```cpp
#include <hip/hip_runtime.h>
#include <cstdio>
#include <cstdint>

#ifndef GU0_P0
#define GU0_P0 0
#define GU0_P1 14000
#define GU0_P2 19000
#endif
#ifndef MK_N_LAUNCHES
#define MK_N_LAUNCHES 1
#endif

#ifndef L0F8
#define L0F8 2
#endif
#if L0F8 == 2
#define P_G4SEL P_G4F
#define P_G5SEL P_G5F
#elif L0F8 == 1
#define P_G4SEL P_G4H
#define P_G5SEL P_G5F
#else
#define P_G4SEL P_G4
#define P_G5SEL P_G5
#endif
#define LAS __attribute__((address_space(3)))
#define GAS __attribute__((address_space(1)))
typedef unsigned short bf16_t;
typedef short bf16x8 __attribute__((ext_vector_type(8)));
typedef short s16x4 __attribute__((ext_vector_type(4)));
typedef float f32x2 __attribute__((ext_vector_type(2)));
typedef float f32x4 __attribute__((ext_vector_type(4)));
typedef float f32x16 __attribute__((ext_vector_type(16)));
typedef unsigned u32x2 __attribute__((ext_vector_type(2)));
typedef unsigned u32x4 __attribute__((ext_vector_type(4)));

constexpr int T = 8192, DM = 2048, SEQ = 4096, NBATCH = 2, NH = 16, NE = 64, TOPK = 8, ED = 512;
constexpr int DQK = 192, DV = 128, NCKQ = 1280;
constexpr float ALPHA = 1.4142135623730951f;
constexpr float LN_EPS = 1e-5f, RMS_EPS = 1e-6f;
constexpr int NSLOT_ROWS = 8192 + 65536 + 64 * 256;
constexpr int NCHUNK = T / 32;

constexpr size_t MiB = 1u << 20, KiB = 1u << 10;
constexpr size_t WS_CTL = 0, CTL_ZERO_BYTES = 1 * MiB;
constexpr size_t WS_ROPE = 1 * MiB;
constexpr size_t WS_RWHI = 2 * MiB;
constexpr size_t WS_RWLO = 2 * MiB + 512 * KiB;
constexpr size_t WS_RC = 3 * MiB;
constexpr size_t WS_CNT = 3 * MiB + 64 * KiB;
constexpr size_t WS_TOKE = 3 * MiB + 256 * KiB;
constexpr size_t WS_TOKG = 3 * MiB + 512 * KiB;
constexpr size_t WS_TOKS = 3 * MiB + 768 * KiB;
constexpr size_t WS_ROWIDX = 4 * MiB;
constexpr size_t WS_MTE = 4 * MiB + 512 * KiB;
constexpr size_t WS_NMT = 4 * MiB + 516 * KiB;
constexpr size_t WS_RSTAT = 5 * MiB;
constexpr size_t WS_WIN = 8 * MiB, WS_WGRP = 16 * MiB, WS_WOUT = 18 * MiB, WS_WKVQ = 26 * MiB, WS_WUP = 31 * MiB, WS_WBO = 38 * MiB;
constexpr size_t WS_WGU = 48 * MiB;
constexpr size_t WS_WD = 568 * MiB;
constexpr size_t WS_XP = 828 * MiB;
constexpr size_t WS_Q = 828 * MiB, WS_K = 876 * MiB, WS_V = 924 * MiB;
constexpr size_t WS_POOLED = 956 * MiB;
constexpr size_t WS_ATT = 956 * MiB;
constexpr size_t WS_X1Q = 956 * MiB;
constexpr size_t WS_MIXED = 988 * MiB;
constexpr size_t WS_CKQ = 988 * MiB;
constexpr size_t WS_Z = 1020 * MiB;
constexpr size_t WS_X1F = 1084 * MiB, WS_X1B = 1148 * MiB;
constexpr size_t WS_X2F = 1180 * MiB, WS_X2B = 1244 * MiB;
constexpr size_t WS_H = 1276 * MiB;
constexpr size_t WS_Y = 1364 * MiB;
constexpr size_t WS_END = 1716 * MiB;

constexpr int CW_BAR = 4096;

constexpr int RING_BYTES = 131072;
constexpr int MISC_OFF = RING_BYTES + 320;
constexpr int LDS_BYTES = 147456;

#define LDS_WAIT() asm volatile("s_waitcnt lgkmcnt(0)" ::: "memory")
#define VM_WAIT() asm volatile("s_waitcnt vmcnt(0)" ::: "memory")
__device__ __forceinline__ unsigned cvt_pk_bf16(float lo, float hi) { unsigned r; asm volatile("v_cvt_pk_bf16_f32 %0, %1, %2" : "=v"(r) : "v"(lo), "v"(hi)); return r; }
__device__ __forceinline__ float bf_lo(unsigned w) { return __uint_as_float(w << 16); }
__device__ __forceinline__ float bf_hi(unsigned w) { return __uint_as_float(w & 0xffff0000u); }
template <int CTRL> __device__ __forceinline__ float dpp_f(float v) { return __uint_as_float((unsigned)__builtin_amdgcn_update_dpp(0, (int)__float_as_uint(v), CTRL, 0xf, 0xf, false)); }
constexpr int DPP_X1 = 0xB1, DPP_X2 = 0x4E, DPP_X3 = 0x1B, DPP_HM = 0x141, DPP_RM = 0x140;
__device__ __forceinline__ float wave_sum(float v) {
    v += dpp_f<DPP_X1>(v); v += dpp_f<DPP_X2>(v); v += dpp_f<DPP_HM>(v); v += dpp_f<DPP_RM>(v);
    { const auto r = __builtin_amdgcn_permlane16_swap(__float_as_uint(v), __float_as_uint(v), false, false); v = __uint_as_float(r[0]) + __uint_as_float(r[1]); }
    { const auto r = __builtin_amdgcn_permlane32_swap(__float_as_uint(v), __float_as_uint(v), false, false); v = __uint_as_float(r[0]) + __uint_as_float(r[1]); }
    return v;
}
__device__ __forceinline__ float wave_sum_x(float v) {
#pragma unroll
    for (int o = 1; o < 64; o <<= 1) v += __shfl_xor(v, o);
    return v;
}
__device__ __forceinline__ float wave_max(float v) {
    v = fmaxf(v, dpp_f<DPP_X1>(v)); v = fmaxf(v, dpp_f<DPP_X2>(v)); v = fmaxf(v, dpp_f<DPP_HM>(v)); v = fmaxf(v, dpp_f<DPP_RM>(v));
    { const auto r = __builtin_amdgcn_permlane16_swap(__float_as_uint(v), __float_as_uint(v), false, false); v = fmaxf(__uint_as_float(r[0]), __uint_as_float(r[1])); }
    { const auto r = __builtin_amdgcn_permlane32_swap(__float_as_uint(v), __float_as_uint(v), false, false); v = fmaxf(__uint_as_float(r[0]), __uint_as_float(r[1])); }
    return v;
}

#define XB_TMO      128
#define XB_XCNT(j)  (256  + 64 * (j))
#define XB_XSUB(j)  (1280 + 64 * (j))
#define XB_XGEN(j)  (2304 + 64 * (j))
#define XB_TOP      3328
#define XB_TOPGEN   3392
#define XCD_BAR_WORDS 3456
#define XB_SPIN_CAP (1u << 18)
__device__ __forceinline__ unsigned xb_ld(unsigned* p)              { return __hip_atomic_load(p, __ATOMIC_RELAXED, __HIP_MEMORY_SCOPE_AGENT); }
__device__ __forceinline__ unsigned xb_add(unsigned* p, unsigned v) { return __hip_atomic_fetch_add(p, v, __ATOMIC_RELAXED, __HIP_MEMORY_SCOPE_AGENT); }
__device__ __forceinline__ unsigned xb_xcc_id() { return (unsigned)__builtin_amdgcn_s_getreg((3 << 11) | 20) & 0xFu; }
#define XB_SPIN(cond, bar) do { unsigned _sp = 0; while (cond) { __builtin_amdgcn_s_sleep(1); \
    if ((++_sp & 255u) == 0u) { if (xb_ld(&(bar)[XB_TMO])) break; if (_sp > XB_SPIN_CAP) { atomicAdd(&(bar)[XB_TMO], 1u); break; } } } } while (0)
struct XcdBarrier { unsigned* bar; unsigned x; volatile LAS unsigned* st; };
__device__ __forceinline__ XcdBarrier xcd_barrier_post(unsigned* bar, volatile LAS unsigned* st) {
    XcdBarrier b; b.bar = bar; b.x = xb_xcc_id(); b.st = st;
    if (threadIdx.x == 0) { const unsigned rank = xb_add(&bar[XB_XCNT(b.x)], 1u); st[8] = rank; st[9] = b.x; }
    return b;
}
__device__ __forceinline__ void xcd_barrier_complete(unsigned* bar, unsigned x, unsigned& nloc, unsigned& nx) {
    const unsigned G = gridDim.x * gridDim.y * gridDim.z;
    unsigned sum, cnt, mine, sp = 0u;
    for (;;) {
        sum = 0u; cnt = 0u; mine = 0u;
#pragma unroll
        for (unsigned j = 0; j < 16; ++j) { const unsigned c = xb_ld(&bar[XB_XCNT(j)]); sum += c; cnt += (c > 0u) ? 1u : 0u; mine = (j == x) ? c : mine; }
        if (sum == G) break;
        __builtin_amdgcn_s_sleep(1);
        if ((++sp & 255u) == 0u) { if (xb_ld(&bar[XB_TMO])) break; if (sp > XB_SPIN_CAP) { atomicAdd(&bar[XB_TMO], 1u); break; } }
    }
    nloc = mine > 0u ? mine : 1u; nx = cnt > 0u ? cnt : 1u;
}
__device__ __forceinline__ void xcd_barrier(const XcdBarrier& b) {
    asm volatile("s_waitcnt vmcnt(0)" ::: "memory");
    __syncthreads();
    if (threadIdx.x == 0) {
        unsigned* bar = b.bar;
        __builtin_amdgcn_s_waitcnt(0);
        unsigned nloc = b.st[0], nx = b.st[1];
        if (nloc == 0u) { xcd_barrier_complete(bar, b.x, nloc, nx); b.st[0] = nloc; b.st[1] = nx; }
        asm volatile("buffer_inv sc1" ::: "memory");
        const unsigned old = xb_add(&bar[XB_XSUB(b.x)], 1u);
        const unsigned gen = old / nloc;
        if (old + 1u == (gen + 1u) * nloc) {
            __builtin_amdgcn_fence(__ATOMIC_RELEASE, "agent");
            asm volatile("s_waitcnt vmcnt(0)" ::: "memory");
            const unsigned og = xb_add(&bar[XB_TOP], 1u);
            const unsigned tg = og / nx;
            if (og + 1u == (tg + 1u) * nx) xb_add(&bar[XB_TOPGEN], 1u);
            else XB_SPIN(xb_ld(&bar[XB_TOPGEN]) == tg, bar);
            xb_add(&bar[XB_XGEN(b.x)], 1u);
            asm volatile("s_waitcnt vmcnt(0)" ::: "memory");
        } else {
            XB_SPIN(xb_ld(&bar[XB_XGEN(b.x)]) == gen, bar);
            asm volatile("s_waitcnt vmcnt(0)" ::: "memory");
        }
    }
    __syncthreads();
}

namespace pg8 {
constexpr int BM = 256, BK = 64, HALF = 128, HTB = HALF * BK * 2, STAGE_BYTES = 8 * HTB, NXCD = 8, WGM = 8;
__host__ __device__ __forceinline__ int lds_byte(int r, int c) { const int st = (r >> 4) * 2 + (c >> 5), rr = r & 15, cc = c & 31, ob = rr * 64 + cc * 2; return st * 1024 + (ob ^ (((ob >> 9) & 1) << 5)); }
__host__ __device__ __forceinline__ void stage_rc(int b, int& R, int& C) { const int st = b / 1024, sb = b % 1024, swz = sb ^ (((sb >> 9) & 1) << 5); R = (st >> 1) * 16 + swz / 64; C = (st & 1) * 32 + (swz % 64) / 2; }
__host__ __device__ __forceinline__ int perm32(int rho) { const int n = rho >> 4, i = rho & 15; return 8 * (i >> 2) + 4 * n + (i & 3); }

typedef int v8i32 __attribute__((ext_vector_type(8)));
typedef int v4i32 __attribute__((ext_vector_type(4)));
template <bool F8> struct FragT { typedef bf16x8 type; };
template <> struct FragT<true> { typedef v8i32 type; };
__device__ __forceinline__ void ldfrag(bf16x8& d, const LAS unsigned char* p) { d = *(const LAS bf16x8*)p; }
__device__ __forceinline__ void ldfrag(v8i32& d, const LAS unsigned char* p) { const v4i32 x = *(const LAS v4i32*)p, y = *(const LAS v4i32*)(p + 16); d = __builtin_shufflevector(x, y, 0, 1, 2, 3, 4, 5, 6, 7); }
__device__ __forceinline__ f32x4 mma(v8i32 b, v8i32 a, f32x4 c, int sc) {
    asm volatile("v_mfma_scale_f32_16x16x128_f8f6f4 %0, %1, %2, %0, %3, %3 op_sel_hi:[0,0,0]" : "+v"(c) : "v"(b), "v"(a), "v"(sc)); return c; }
__device__ __forceinline__ f32x4 mma(bf16x8 b, bf16x8 a, f32x4 c, int) { return __builtin_amdgcn_mfma_f32_16x16x32_bf16(b, a, c, 0, 0, 0); }
struct Unit { const char* A; const char* B; const int* rows; int m0, pn, aux; };

struct TileOrder {
    int nM, nN, nwg, G, c;
    __device__ __forceinline__ void init(int nM_, int nN_, int G_, int c_) { nM = nM_; nN = nN_; nwg = nM * nN; G = G_; c = c_; }
    __device__ __forceinline__ bool next(int i, int& pm, int& pn) const {
        const long L = (long)i * G + c; if (L >= nwg) return false;
        int wgid = (int)L; { const int q = nwg / NXCD, r = nwg % NXCD, xcd = wgid % NXCD, off = wgid / NXCD; wgid = (xcd < r ? xcd * (q + 1) : r * (q + 1) + (xcd - r) * q) + off; }
        const int nig = WGM * nN, gid = wgid / nig, fm = gid * WGM, gsz = (nM - fm) < WGM ? (nM - fm) : WGM;
        pm = fm + ((wgid % nig) % gsz); pn = (wgid % nig) / gsz; return true;
    }
};

template <class Epi, class Sched>
__device__ __forceinline__ void gemm_phase(LAS unsigned char* lds, const int lda_b, const int K, const Sched& S, const Epi& E) {
    const int tid = threadIdx.x, wid = __builtin_amdgcn_readfirstlane(tid >> 6), lane = tid & 63, wr = wid >> 2, wc = wid & 3, fr = lane & 15, fq = lane >> 4;
    const int nt = K / BK;
    int Rs[2]; unsigned Cb[2], voffB[2];
#pragma unroll
    for (int i = 0; i < 2; ++i) { int R, C; stage_rc(tid * 16 + i * 8192, R, C); const int Rb = Epi::PERM ? ((R & ~31) + perm32(R & 31)) : R;
        Rs[i] = R; Cb[i] = (unsigned)C * 2u; voffB[i] = (unsigned)(Rb * K + C) * 2u; }
    const size_t kstep = (size_t)(BK * 2);
    const size_t hstepB = (size_t)HALF * K * 2;
    const unsigned ldsw = (unsigned)wid * 1024u;
    int sc1 = 0x7f7f7f7f; asm volatile("" : "+v"(sc1));
    constexpr bool F8 = Sched::FP8;
    const int aoff = lds_byte(wr * 64 + fr, fq * (F8 ? 16 : 8)), boff = lds_byte(wc * 32 + fr, fq * (F8 ? 16 : 8));
#define PG8_SA(b, h) (((b) * 2 + (h)) * HTB)
#define PG8_SB(b, h) ((4 + (b) * 2 + (h)) * HTB)
#define PG8_STAGE(bufoff, gbase, voff) do { _Pragma("unroll") for (int _i = 0; _i < 2; ++_i) \
        __builtin_amdgcn_global_load_lds((const unsigned*)((const char*)(gbase) + (voff)[_i]), (LAS unsigned*)(lds + (bufoff) + ldsw + _i * 8192), 16, 0, 0); } while (0)
#define PG8_LDA(dst, b, h) do { _Pragma("unroll") for (int m = 0; m < 4; ++m) _Pragma("unroll") for (int k = 0; k < NK; ++k) pg8::ldfrag(dst[m][k], lds + PG8_SA(b, h) + aoff + m * 2048 + k * 1024); } while (0)
#define PG8_LDB(dst, b, h) do { _Pragma("unroll") for (int n = 0; n < 2; ++n) _Pragma("unroll") for (int k = 0; k < NK; ++k) pg8::ldfrag(dst[n][k], lds + PG8_SB(b, h) + boff + n * 2048 + k * 1024); } while (0)
#define PG8_MMA(ai, bj, At, Bt) do { __builtin_amdgcn_s_setprio(1); _Pragma("unroll") for (int m = 0; m < 4; ++m) _Pragma("unroll") for (int n = 0; n < 2; ++n) _Pragma("unroll") for (int k = 0; k < NK; ++k) \
        acc[ai][bj][m][n] = pg8::mma(Bt[n][k], At[m][k], acc[ai][bj][m][n], sc1); __builtin_amdgcn_s_setprio(0); } while (0)
#define PG8_WAIT_V(n) asm volatile("s_waitcnt vmcnt(" #n ")" ::: "memory")
#define PG8_WAIT_L(n) asm volatile("s_waitcnt lgkmcnt(" #n ")" ::: "memory")
#define PG8_BAR __builtin_amdgcn_s_barrier()
#define PG8_SCHED __builtin_amdgcn_sched_barrier(0)
#define PG8_MKOFF(u, vo) do { _Pragma("unroll") for (int _h = 0; _h < 2; ++_h) _Pragma("unroll") for (int _i = 0; _i < 2; ++_i) { const int _R = _h * HALF + Rs[_i]; \
        const int _row = (u).rows ? (u).rows[_R] : _R; vo[_h][_i] = (unsigned)_row * (unsigned)lda_b + Cb[_i]; } } while (0)
    Unit cur, nxt; int ui = 0;
    if (!S.next(0, cur)) return;
    f32x4 acc[2][2][4][2];
#pragma unroll
    for (int a = 0; a < 2; ++a)
#pragma unroll
        for (int b = 0; b < 2; ++b)
#pragma unroll
            for (int m = 0; m < 4; ++m)
#pragma unroll
                for (int n = 0; n < 2; ++n) acc[a][b][m][n] = (f32x4){0.f, 0.f, 0.f, 0.f};
    typedef typename pg8::FragT<F8>::type frag_t; constexpr int NK = F8 ? 1 : 2;
    frag_t At[4][NK], B0[2][NK], B1[2][NK];
    unsigned voC[2][2], voN[2][2];
    PG8_MKOFF(cur, voC);
    const char* cA = cur.A; const char* cB = cur.B;
    PG8_STAGE(PG8_SB(0, 0), cB, voffB); PG8_STAGE(PG8_SA(0, 0), cA, voC[0]); PG8_STAGE(PG8_SB(0, 1), cB + hstepB, voffB); PG8_STAGE(PG8_SA(0, 1), cA, voC[1]);
    if (wr == 1) PG8_BAR;
    PG8_WAIT_V(4); PG8_BAR;
    PG8_STAGE(PG8_SB(1, 0), cB + kstep, voffB); PG8_STAGE(PG8_SA(1, 0), cA + kstep, voC[0]); PG8_STAGE(PG8_SB(1, 1), cB + hstepB + kstep, voffB);
    PG8_WAIT_V(6); PG8_BAR;
    for (;;) {
        const bool has_next = S.next(ui + 1, nxt);
        const char* nA = has_next ? nxt.A : cA; const char* nB = has_next ? nxt.B : cB;
        if (has_next) { PG8_MKOFF(nxt, voN); }
        else {
#pragma unroll
            for (int h = 0; h < 2; ++h)
#pragma unroll
                for (int i = 0; i < 2; ++i) voN[h][i] = voC[h][i]; }
        for (int t = 0; t < nt; t += 2) {
            const bool last = (t == nt - 2);
            const char* a1 = cA + (size_t)(t + 1) * kstep;
            const char* a2 = last ? nA : cA + (size_t)(t + 2) * kstep; const char* b2 = last ? nB : cB + (size_t)(t + 2) * kstep;
            const char* a3 = a2 + kstep; const char* b3 = b2 + kstep;
            unsigned v2[2][2];
#pragma unroll
            for (int h = 0; h < 2; ++h)
#pragma unroll
                for (int i = 0; i < 2; ++i) v2[h][i] = last ? voN[h][i] : voC[h][i];
            PG8_LDB(B0, 0, 0); PG8_SCHED; PG8_LDA(At, 0, 0); PG8_STAGE(PG8_SA(1, 1), a1, voC[1]);
            PG8_WAIT_L(8); PG8_BAR; PG8_WAIT_L(0); PG8_MMA(0, 0, At, B0); PG8_BAR; PG8_SCHED;
            PG8_LDB(B1, 0, 1); PG8_STAGE(PG8_SB(0, 0), b2, voffB);
            PG8_BAR; PG8_WAIT_L(0); PG8_MMA(0, 1, At, B1); PG8_BAR;
            PG8_LDA(At, 0, 1); PG8_STAGE(PG8_SA(0, 0), a2, v2[0]);
            PG8_BAR; PG8_WAIT_L(0); PG8_MMA(1, 0, At, B0); PG8_BAR; PG8_SCHED;
            PG8_STAGE(PG8_SB(0, 1), b2 + hstepB, voffB);
            PG8_WAIT_V(6); PG8_BAR; PG8_MMA(1, 1, At, B1); PG8_BAR;
            PG8_LDB(B0, 1, 0); PG8_SCHED; PG8_LDA(At, 1, 0); PG8_STAGE(PG8_SA(0, 1), a2, v2[1]);
            PG8_WAIT_L(8); PG8_BAR; PG8_WAIT_L(0); PG8_MMA(0, 0, At, B0); PG8_BAR; PG8_SCHED;
            PG8_LDB(B1, 1, 1); PG8_STAGE(PG8_SB(1, 0), b3, voffB);
            PG8_BAR; PG8_WAIT_L(0); PG8_MMA(0, 1, At, B1); PG8_BAR;
            PG8_LDA(At, 1, 1); PG8_STAGE(PG8_SA(1, 0), a3, v2[0]);
            PG8_BAR; PG8_WAIT_L(0); PG8_MMA(1, 0, At, B0); PG8_BAR; PG8_SCHED;
            PG8_STAGE(PG8_SB(1, 1), b3 + hstepB, voffB);
            PG8_WAIT_V(6); PG8_BAR; PG8_MMA(1, 1, At, B1); PG8_BAR;
        }
        if constexpr (F8) asm volatile("s_nop 15\n\ts_nop 15\n\ts_nop 7" ::: "memory");
        E(acc, cur, wr, wc, fr, fq);
        if (!has_next) break;
#pragma unroll
        for (int a = 0; a < 2; ++a)
#pragma unroll
            for (int b = 0; b < 2; ++b)
#pragma unroll
                for (int m = 0; m < 4; ++m)
#pragma unroll
                    for (int n = 0; n < 2; ++n) acc[a][b][m][n] = (f32x4){0.f, 0.f, 0.f, 0.f};
        cur = nxt; cA = nA; cB = nB; ++ui;
#pragma unroll
        for (int h = 0; h < 2; ++h)
#pragma unroll
            for (int i = 0; i < 2; ++i) voC[h][i] = voN[h][i];
    }
    PG8_WAIT_V(0);
    if (wr == 0) PG8_BAR;
    PG8_BAR;
#undef PG8_SA
#undef PG8_SB
#undef PG8_STAGE
#undef PG8_LDA
#undef PG8_LDB
#undef PG8_MMA
#undef PG8_WAIT_V
#undef PG8_WAIT_L
#undef PG8_BAR
#undef PG8_SCHED
#undef PG8_MKOFF
}
}

__device__ __forceinline__ unsigned pk4_fp8(float a, float b, float c, float d) { int w = 0; w = __builtin_amdgcn_cvt_pk_fp8_f32(a, b, w, false); w = __builtin_amdgcn_cvt_pk_fp8_f32(c, d, w, true); return (unsigned)w; }
constexpr float W8_SCALE = 32.f;
struct EpiBf16 {
    static constexpr bool PERM = true;
    bf16_t* O; int ldc; const float* colscale; int nt; float sc;
    __device__ __forceinline__ void operator()(const f32x4 (&acc)[2][2][4][2], const pg8::Unit& u, int wr, int wc, int fr, int fq) const {
        const int col0 = u.pn * 256 + wc * 32 + 8 * fq;
        f32x4 scv[2][2];
#pragma unroll
        for (int bj = 0; bj < 2; ++bj) { scv[bj][0] = colscale ? *(const f32x4*)(colscale + col0 + bj * 128) : (f32x4){1.f, 1.f, 1.f, 1.f}; scv[bj][1] = colscale ? *(const f32x4*)(colscale + col0 + bj * 128 + 4) : (f32x4){1.f, 1.f, 1.f, 1.f}; scv[bj][0] *= sc; scv[bj][1] *= sc; }
#pragma unroll
        for (int ai = 0; ai < 2; ++ai)
#pragma unroll
            for (int m = 0; m < 4; ++m) { bf16_t* rowp = O + (size_t)(u.m0 + ai * 128 + wr * 64 + m * 16 + fr) * ldc + col0;
#pragma unroll
                for (int bj = 0; bj < 2; ++bj) { const f32x4 v0 = acc[ai][bj][m][0] * scv[bj][0], v1 = acc[ai][bj][m][1] * scv[bj][1];
                    u32x4 w; w.x = cvt_pk_bf16(v0[0], v0[1]); w.y = cvt_pk_bf16(v0[2], v0[3]); w.z = cvt_pk_bf16(v1[0], v1[1]); w.w = cvt_pk_bf16(v1[2], v1[3]);
                    if (nt) __builtin_nontemporal_store(w, (u32x4*)(rowp + bj * 128)); else *(u32x4*)(rowp + bj * 128) = w; } }
    }
};
constexpr float Y8_SCALE = 16.f;
static_assert(L0F8 >= 1, "the combine (LN2) reads e4m3 Y rows: both layers' down projections must run on the fp8 path");
struct EpiY8 {
    static constexpr bool PERM = true;
    unsigned char* O; float sc;
    __device__ __forceinline__ void operator()(const f32x4 (&acc)[2][2][4][2], const pg8::Unit& u, int wr, int wc, int fr, int fq) const {
        const int odd = fq & 1, colb = u.pn * 256 + wc * 32 + 8 * (fq - odd) + odd * 128;
#pragma unroll
        for (int ai = 0; ai < 2; ++ai)
#pragma unroll
            for (int m = 0; m < 4; ++m) { unsigned char* rowp = O + (size_t)(u.m0 + ai * 128 + wr * 64 + m * 16 + fr) * DM + colb;
                const f32x4 x0 = acc[ai][0][m][0] * sc, x1 = acc[ai][0][m][1] * sc, z0 = acc[ai][1][m][0] * sc, z1 = acc[ai][1][m][1] * sc;
                const unsigned xa = pk4_fp8(x0[0], x0[1], x0[2], x0[3]), xb = pk4_fp8(x1[0], x1[1], x1[2], x1[3]), za = pk4_fp8(z0[0], z0[1], z0[2], z0[3]), zb = pk4_fp8(z1[0], z1[1], z1[2], z1[3]);
                const auto r0 = __builtin_amdgcn_permlane16_swap(xa, za, false, false), r1 = __builtin_amdgcn_permlane16_swap(xb, zb, false, false);
                const u32x4 w = {r0[0], r1[0], r0[1], r1[1]};
                __builtin_nontemporal_store(w, (u32x4*)rowp); }
    }
};
struct EpiZ {
    static constexpr bool PERM = true;
    const float* resf; const bf16_t* resb; bf16_t* out;
    __device__ __forceinline__ void operator()(const f32x4 (&acc)[2][2][4][2], const pg8::Unit& u, int wr, int wc, int fr, int fq) const {
        const int col0 = u.pn * 256 + wc * 32 + 8 * fq;
#pragma unroll
        for (int ai = 0; ai < 2; ++ai)
#pragma unroll
            for (int mp = 0; mp < 2; ++mp) { f32x4 r[2][2][2];
#pragma unroll
                for (int mm = 0; mm < 2; ++mm) { const size_t off = (size_t)(u.m0 + ai * 128 + wr * 64 + (mp * 2 + mm) * 16 + fr) * DM + col0;
#pragma unroll
                    for (int bj = 0; bj < 2; ++bj) {
                        if (resf) { r[mm][bj][0] = *(const f32x4*)(resf + off + bj * 128); r[mm][bj][1] = *(const f32x4*)(resf + off + bj * 128 + 4); }
                        else { const u32x4 w = *(const u32x4*)(resb + off + bj * 128); r[mm][bj][0] = (f32x4){bf_lo(w.x), bf_hi(w.x), bf_lo(w.y), bf_hi(w.y)}; r[mm][bj][1] = (f32x4){bf_lo(w.z), bf_hi(w.z), bf_lo(w.w), bf_hi(w.w)}; } } }
#pragma unroll
                for (int mm = 0; mm < 2; ++mm) { const size_t off = (size_t)(u.m0 + ai * 128 + wr * 64 + (mp * 2 + mm) * 16 + fr) * DM + col0;
#pragma unroll
                    for (int bj = 0; bj < 2; ++bj) { const f32x4 z0 = r[mm][bj][0] * ALPHA + acc[ai][bj][mp * 2 + mm][0], z1 = r[mm][bj][1] * ALPHA + acc[ai][bj][mp * 2 + mm][1];
                        *(u32x4*)(out + off + bj * 128) = (u32x4){cvt_pk_bf16(z0[0], z0[1]), cvt_pk_bf16(z0[2], z0[3]), cvt_pk_bf16(z1[0], z1[1]), cvt_pk_bf16(z1[2], z1[3])}; } }
                asm volatile("" ::: "memory"); }
    }
};
struct EpiSwiGLU {
    static constexpr bool PERM = true;
    bf16_t* H; float sc; int f8;
    __device__ __forceinline__ void operator()(const f32x4 (&acc)[2][2][4][2], const pg8::Unit& u, int wr, int wc, int fr, int fq) const {
        const int col0 = u.pn * 128 + wc * 32 + 8 * fq;
#pragma unroll
        for (int ai = 0; ai < 2; ++ai)
#pragma unroll
            for (int m = 0; m < 4; ++m) { bf16_t* rowp = H + (size_t)(u.m0 + ai * 128 + wr * 64 + m * 16 + fr) * ED + col0;
                float h[8];
#pragma unroll
                for (int n = 0; n < 2; ++n)
#pragma unroll
                    for (int j = 0; j < 4; ++j) { const float g = acc[ai][0][m][n][j] * sc, up = acc[ai][1][m][n][j] * sc;
                        h[n * 4 + j] = g * __builtin_amdgcn_rcpf(1.f + __expf(-g)) * up; }
                if (f8) { *(u32x2*)((unsigned char*)H + (size_t)(u.m0 + ai * 128 + wr * 64 + m * 16 + fr) * ED + col0) = (u32x2){pk4_fp8(h[0], h[1], h[2], h[3]), pk4_fp8(h[4], h[5], h[6], h[7])}; }
                else { u32x4 w; w.x = cvt_pk_bf16(h[0], h[1]); w.y = cvt_pk_bf16(h[2], h[3]); w.z = cvt_pk_bf16(h[4], h[5]); w.w = cvt_pk_bf16(h[6], h[7]);
                *(u32x4*)rowp = w; } }
    }
};
struct EpiUp {
    static constexpr bool PERM = true;
    bf16_t* Q; bf16_t* Kb; bf16_t* V; const float* rstat; const f32x2* rope;
    __device__ __forceinline__ void operator()(const f32x4 (&acc)[2][2][4][2], const pg8::Unit& u, int wr, int wc, int fr, int fq) const {
        const int pn = u.pn;
        const float* rs = rstat + (pn < 16 ? 0 : T);
        float rsc[2][4];
#pragma unroll
        for (int ai = 0; ai < 2; ++ai)
#pragma unroll
            for (int m = 0; m < 4; ++m) rsc[ai][m] = rs[u.m0 + ai * 128 + wr * 64 + m * 16 + fr];
#pragma unroll
        for (int ai = 0; ai < 2; ++ai)
#pragma unroll
            for (int m = 0; m < 4; ++m) { const int row = u.m0 + ai * 128 + wr * 64 + m * 16 + fr; const float r = rsc[ai][m];
                if (pn < 24) {
#pragma unroll
                    for (int bj = 0; bj < 2; ++bj) { const f32x4 v0 = acc[ai][bj][m][0] * r, v1 = acc[ai][bj][m][1] * r;
                        u32x4 w; w.x = cvt_pk_bf16(v0[0], v0[1]); w.y = cvt_pk_bf16(v0[2], v0[3]); w.z = cvt_pk_bf16(v1[0], v1[1]); w.w = cvt_pk_bf16(v1[2], v1[3]);
                        const int d = wc * 32 + 8 * fq;
                        bf16_t* p;
                        if (pn < 8) p = Kb + (size_t)row * (NH * DQK) + (2 * pn + bj) * DQK + d;
                        else if (pn < 16) p = V + (size_t)row * DM + (pn - 8) * 256 + bj * 128 + d;
                        else p = Q + (size_t)row * (NH * DQK) + (2 * (pn - 16) + bj) * DQK + d;
                        *(u32x4*)p = w; }
                } else {
                    const int head = 4 * (pn - 24) + wc, i0 = 8 * fq, s = row & (SEQ - 1);
                    const f32x4* cs = (const f32x4*)(rope + (size_t)s * 32 + i0);
                    float o1[8], o2[8];
#pragma unroll
                    for (int q = 0; q < 4; ++q) { const f32x4 c2 = cs[q];
                        const int n = q >> 1, j = (q & 1) * 2;
                        const float x1a = acc[ai][0][m][n][j] * r, x2a = acc[ai][1][m][n][j] * r, x1b = acc[ai][0][m][n][j + 1] * r, x2b = acc[ai][1][m][n][j + 1] * r;
                        o1[2 * q] = x1a * c2[0] - x2a * c2[1]; o2[2 * q] = x2a * c2[0] + x1a * c2[1];
                        o1[2 * q + 1] = x1b * c2[2] - x2b * c2[3]; o2[2 * q + 1] = x2b * c2[2] + x1b * c2[3]; }
                    bf16_t* p = Q + (size_t)row * (NH * DQK) + head * DQK + 128 + i0;
                    u32x4 w; w.x = cvt_pk_bf16(o1[0], o1[1]); w.y = cvt_pk_bf16(o1[2], o1[3]); w.z = cvt_pk_bf16(o1[4], o1[5]); w.w = cvt_pk_bf16(o1[6], o1[7]);
                    *(u32x4*)p = w;
                    w.x = cvt_pk_bf16(o2[0], o2[1]); w.y = cvt_pk_bf16(o2[2], o2[3]); w.z = cvt_pk_bf16(o2[4], o2[5]); w.w = cvt_pk_bf16(o2[6], o2[7]);
                    *(u32x4*)(p + 32) = w;
                } }
    }
};

struct DenseSched {
    static constexpr bool FP8 = false;
    pg8::TileOrder ord; const char* A; const char* B; int lda_b, K; int mode;
    size_t agrp;
    __device__ __forceinline__ bool next(int i, pg8::Unit& u) const {
        int pm, pn; if (!ord.next(i, pm, pn)) return false;
        size_t ao = 0;
        if (mode == 1) ao = (size_t)(pn >> 1) * agrp; else if (mode == 2) ao = pn >= 16 ? 1024 : 0;
        u.A = A + ao + (size_t)pm * 256 * lda_b; u.B = B + (size_t)pn * 256 * K * 2; u.rows = nullptr; u.m0 = pm * 256; u.pn = pn; u.aux = 0;
        return true;
    }
};
template <bool F8_> struct MoeSchedT {
    static constexpr bool FP8 = F8_;
    const int* mte; const int* rowidx; const char* A; const char* W; int nunits, npn, G, c, gather; size_t wexp, wtile, atile; int i0, i1;
    __device__ __forceinline__ bool next(int i, pg8::Unit& u) const {
        if (i + i0 >= i1) return false;
        const int L = (i + i0) * G + c; if (L >= nunits) return false;
        const int mt = L / npn, pn = L - mt * npn; const int e = __builtin_amdgcn_readfirstlane(mte[mt]);
        u.A = gather ? A : A + (size_t)mt * atile; u.rows = gather ? rowidx + mt * 256 : nullptr;
        u.B = W + (size_t)e * wexp + (size_t)pn * wtile; u.m0 = mt * 256; u.pn = pn; u.aux = e;
        return true;
    }
};

typedef MoeSchedT<false> MoeSched;

namespace att {
constexpr int NW = 8, QBLK = 32, KVBLK = 64, QB = NW * QBLK;
constexpr int QS = NH * DQK, KS = NH * DQK, VS = DM, OS = DM;
constexpr int SHM_V = KVBLK * DV * 2, SHM_K = KVBLK * DQK * 2;
constexpr int ATT_LDS = 2 * SHM_V + 2 * SHM_K + NW * 64 * 4;
constexpr float SCALE = 0.07216878364870322f;
constexpr float THR = 8.f;
typedef LAS char* lptr;
#define KSWZ(row, colB) ((row) * 384 + ((colB) ^ ((((row) >> 1) & 7) << 4)))
#define SBAR() __builtin_amdgcn_sched_barrier(0)
__device__ __forceinline__ int v_st(int k, int c) { const int kk = (k & ~0xC) | ((k & 4) << 1) | ((k & 8) >> 1); return ((kk >> 3) * 4 + (c >> 5)) * 512 + ((kk & 7) * 32 + (c & 31)) * 2; }
__device__ __forceinline__ int v_rd_base(int lane) { return ((lane & 3) << 3) | (((lane >> 2) & 3) << 6) | (((lane >> 4) & 1) << 5) | (((lane >> 5) & 1) << 8); }
constexpr int v_rd_off(int d0, int ks, int half) { return d0 * 512 + ks * 4096 + half * 2048; }
__device__ __forceinline__ int crow(int r, int hi) { return (r & 3) + 8 * (r >> 2) + 4 * hi; }
__device__ __forceinline__ bf16x8 ld8(const bf16_t* p) { return *reinterpret_cast<const bf16x8*>(p); }
__device__ __forceinline__ void mask_tile(f32x16& p0, f32x16& p1, int dq) {
    const float NEG = -__builtin_inff();
#pragma unroll
    for (int r = 0; r < 16; ++r) {
        const int c = (r & 3) + 8 * (r >> 2);
        if (dq - c < 0) p0[r] = NEG;
        if (dq - c - 32 < 0) p1[r] = NEG;
    }
}
__device__ __forceinline__ void partialSM(f32x16& p0, f32x16& p1, float& m_reg, float& mn, float& alpha) {
    float pmax = p0[0];
#pragma unroll
    for (int r = 1; r < 16; ++r) pmax = fmaxf(pmax, p0[r]);
#pragma unroll
    for (int r = 0; r < 16; ++r) pmax = fmaxf(pmax, p1[r]);
    { auto rr = __builtin_amdgcn_permlane32_swap(__float_as_uint(pmax), __float_as_uint(pmax), false, false);
      pmax = fmaxf(__uint_as_float(rr[0]), __uint_as_float(rr[1])); }
    constexpr float C2 = 1.4426950408889634f * SCALE;
    if (__builtin_expect(__all((pmax - m_reg) * SCALE <= THR), 1)) { mn = m_reg; alpha = 1.f; }
    else { mn = fmaxf(m_reg, pmax); alpha = __builtin_amdgcn_exp2f((m_reg - mn) * C2); m_reg = mn; }
    const float mnL = -mn * C2;
#pragma unroll
    for (int r = 0; r < 16; ++r) p0[r] = fmaf(p0[r], C2, mnL);
#pragma unroll
    for (int r = 0; r < 16; ++r) p1[r] = fmaf(p1[r], C2, mnL);
#pragma unroll
    for (int r = 0; r < 16; ++r) p0[r] = __builtin_amdgcn_exp2f(p0[r]);
}
__device__ __forceinline__ void finishSM(f32x16& p0, f32x16& p1, float alpha, float& l_reg, bf16x8& pa0, bf16x8& pa1, bf16x8& pa2, bf16x8& pa3) {
#pragma unroll
    for (int r = 0; r < 16; ++r) p1[r] = __builtin_amdgcn_exp2f(p1[r]);
    float ps = 0;
#pragma unroll
    for (int r = 0; r < 16; ++r) ps += p0[r];
#pragma unroll
    for (int r = 0; r < 16; ++r) ps += p1[r];
    { auto rr = __builtin_amdgcn_permlane32_swap(__float_as_uint(ps), __float_as_uint(ps), false, false);
      ps = __uint_as_float(rr[0]) + __uint_as_float(rr[1]); }
    l_reg = l_reg * alpha + ps;
#define PK4(P, B_, OUT) do { unsigned a0 = cvt_pk_bf16(P[B_+0], P[B_+1]), a1 = cvt_pk_bf16(P[B_+2], P[B_+3]);                          \
        unsigned b0 = cvt_pk_bf16(P[B_+4], P[B_+5]), b1 = cvt_pk_bf16(P[B_+6], P[B_+7]);                                             \
        auto r0 = __builtin_amdgcn_permlane32_swap(a0, b0, false, false); auto r1 = __builtin_amdgcn_permlane32_swap(a1, b1, false, false); \
        u32x4 w = {r0[0], r1[0], r0[1], r1[1]}; OUT = *reinterpret_cast<bf16x8*>(&w); } while (0)
    PK4(p0, 0, pa0); PK4(p0, 8, pa1); PK4(p1, 0, pa2); PK4(p1, 8, pa3);
#undef PK4
}
template <int KB>
__device__ __forceinline__ void qkt(f32x16& p0, f32x16& p1, lptr K_lds, int r32, int hi, const bf16x8* qr) {
    p0 = f32x16{}; p1 = f32x16{};
    lptr kb[4];
#pragma unroll
    for (int dd = 0; dd < 4; ++dd) kb[dd] = K_lds + KB * SHM_K + KSWZ(r32, (dd * 16 + hi * 8) * 2);
#pragma unroll
    for (int d0 = 0; d0 < 12; ++d0) { lptr a = kb[d0 & 3] + (d0 >> 2) * 128;
        bf16x8 b0 = *reinterpret_cast<const LAS bf16x8*>(a);
        bf16x8 b1 = *reinterpret_cast<const LAS bf16x8*>(a + 32 * 384);
        p0 = __builtin_amdgcn_mfma_f32_32x32x16_bf16(b0, qr[d0], p0, 0, 0, 0);
        p1 = __builtin_amdgcn_mfma_f32_32x32x16_bf16(b1, qr[d0], p1, 0, 0, 0); }
}
template <int VB>
__device__ __forceinline__ void pv_tile(f32x16* o, int vb0, bf16x8 pa0, bf16x8 pa1, bf16x8 pa2, bf16x8 pa3) {
#define TRRD(dst, off) asm volatile("ds_read_b64_tr_b16 %0, %1 offset:%2" : "=&v"(dst) : "v"(vb0), "i"(off) : "memory")
#define PV_D0(d0) do { s16x4 l0, l1, l2, l3, h0, h1, h2, h3; constexpr int b_ = VB * SHM_V + v_rd_off(d0, 0, 0); \
        TRRD(l0, b_); TRRD(h0, b_ + 2048); TRRD(l1, b_ + 4096); TRRD(h1, b_ + 6144); TRRD(l2, b_ + 8192); TRRD(h2, b_ + 10240); TRRD(l3, b_ + 12288); TRRD(h3, b_ + 14336); \
        asm volatile("s_waitcnt lgkmcnt(0)" ::: "memory"); SBAR();   \
        o[d0] = __builtin_amdgcn_mfma_f32_32x32x16_bf16(pa0, (bf16x8){l0[0], l0[1], l0[2], l0[3], h0[0], h0[1], h0[2], h0[3]}, o[d0], 0, 0, 0);   \
        o[d0] = __builtin_amdgcn_mfma_f32_32x32x16_bf16(pa1, (bf16x8){l1[0], l1[1], l1[2], l1[3], h1[0], h1[1], h1[2], h1[3]}, o[d0], 0, 0, 0);   \
        o[d0] = __builtin_amdgcn_mfma_f32_32x32x16_bf16(pa2, (bf16x8){l2[0], l2[1], l2[2], l2[3], h2[0], h2[1], h2[2], h2[3]}, o[d0], 0, 0, 0);   \
        o[d0] = __builtin_amdgcn_mfma_f32_32x32x16_bf16(pa3, (bf16x8){l3[0], l3[1], l3[2], l3[3], h3[0], h3[1], h3[2], h3[3]}, o[d0], 0, 0, 0); } while (0)
    PV_D0(0); PV_D0(1); PV_D0(2); PV_D0(3);
#undef PV_D0
#undef TRRD
}
struct BlockRef { const bf16_t* Q; const bf16_t* K; const bf16_t* V; bf16_t* O; int P0; };
struct Seam { bf16x8 qr[12]; };
#define VMW() asm volatile("s_waitcnt vmcnt(0)" ::: "memory")
#define VMWN(n) asm volatile("s_waitcnt vmcnt(%0)" :: "i"(n) : "memory")
#define SLOAD_H(Kp, Vp, k0) do { st_v0 = ld8((Vp) + (size_t)((k0) + sr) * VS + sc); st_v1 = ld8((Vp) + (size_t)((k0) + 32 + sr) * VS + sc); \
        const bf16_t* kp_ = (Kp) + (size_t)((k0) + krow) * KS + kc8; st_k0 = ld8(kp_); st_k1 = ld8(kp_ + 64); st_k2 = ld8(kp_ + 128); } while (0)
#define SWRITE_H(bf) do { lptr kd_ = K_lds + (bf) * SHM_K + kws; *(LAS bf16x8*)kd_ = st_k0; *(LAS bf16x8*)(kd_ + 128) = st_k1; *(LAS bf16x8*)(kd_ + 256) = st_k2; \
        *(LAS bf16x8*)(V_lds + (bf) * SHM_V + vst0) = st_v0; *(LAS bf16x8*)(V_lds + (bf) * SHM_V + vst1) = st_v1; } while (0)
__device__ __forceinline__ void attn_prime(const BlockRef& cur, lptr lds, Seam& S) {
    const int tid = threadIdx.x, wid = __builtin_amdgcn_readfirstlane(tid >> 6), lane = tid & 63, r32 = lane & 31, hi = lane >> 5;
    const int sr = tid >> 4, sc = (tid & 15) * 8, vst0 = v_st(sr, sc), vst1 = v_st(32 + sr, sc), krow = tid >> 3, kc8 = (tid & 7) * 8, kws = KSWZ(krow, (tid & 7) * 16);
    lptr V_lds = lds; lptr K_lds = lds + 2 * SHM_V;
    bf16x8 st_v0, st_v1, st_k0, st_k1, st_k2;
#pragma unroll
    for (int d0 = 0; d0 < 12; ++d0) S.qr[d0] = ld8(cur.Q + (size_t)(wid * QBLK + r32) * QS + d0 * 16 + hi * 8);
    SLOAD_H(cur.K, cur.V, 0); VMW(); SWRITE_H(0);
    __syncthreads();
}
__device__ __forceinline__ void attn_block(const BlockRef& cur, const BlockRef& nxt, lptr lds, Seam& S) {
    const int tid = threadIdx.x, wid = __builtin_amdgcn_readfirstlane(tid >> 6), lane = tid & 63, r32 = lane & 31, hi = lane >> 5;
    const int NT = cur.P0 / KVBLK + QB / KVBLK;
    const int qlo = cur.P0 + wid * QBLK, qm = qlo + r32 - 4 * hi;
    lptr V_lds = lds; lptr K_lds = lds + 2 * SHM_V;
    LAS float* ws = (LAS float*)(lds + 2 * SHM_V + 2 * SHM_K) + wid * 64; LAS float* li_l = ws; LAS float* al_l = ws + 32;
    float m_reg = -1e30f, l_reg = 0; f32x16 o[4] = {};
    const int sr = tid >> 4, sc = (tid & 15) * 8, vst0 = v_st(sr, sc), vst1 = v_st(32 + sr, sc);
    const int krow = tid >> 3, kc8 = (tid & 7) * 8, kws = KSWZ(krow, (tid & 7) * 16);
    const int vb0 = (int)(unsigned)(uintptr_t)V_lds + v_rd_base(lane);
    const bf16_t* Kh = cur.K; const bf16_t* Vh = cur.V;
    bf16x8 st_v0, st_v1, st_k0, st_k1, st_k2;
#define RESC(a) do { if (__any((a) < 1.f)) { if (hi == 0) al_l[r32] = (a); asm volatile("s_waitcnt lgkmcnt(0)" ::: "memory");              \
                     _Pragma("unroll") for (int d_ = 0; d_ < 4; ++d_) _Pragma("unroll") for (int r = 0; r < 16; ++r) o[d_][r] *= al_l[crow(r, hi)]; } } while (0)
#define MASKT(P0_, P1_, t) do { const int kb_ = (t) * KVBLK; if (kb_ + KVBLK - 1 > qlo) mask_tile(P0_, P1_, qm - kb_); } while (0)
#define STEP(t, BF) do { f32x16 p0, p1; float mn, al; bf16x8 pa0, pa1, pa2, pa3;                                     \
        const bool lastt = (t) + 1 == NT;                                                                               \
        if (!lastt) { SLOAD_H(Kh, Vh, ((t) + 1) * KVBLK); } else { SLOAD_H(nxt.K, nxt.V, 0); }                          \
        SBAR(); qkt<BF>(p0, p1, K_lds, r32, hi, S.qr); SBAR();                                                         \
        if (lastt) { _Pragma("unroll") for (int d0 = 0; d0 < 12; ++d0) S.qr[d0] = ld8(nxt.Q + (size_t)(wid * QBLK + r32) * QS + d0 * 16 + hi * 8); SBAR(); } \
        MASKT(p0, p1, (t)); partialSM(p0, p1, m_reg, mn, al); RESC(al);                                                \
        finishSM(p0, p1, al, l_reg, pa0, pa1, pa2, pa3); SBAR();                                                       \
        pv_tile<BF>(o, vb0, pa0, pa1, pa2, pa3); SBAR();                                                               \
        if (lastt) { VMWN(12); SWRITE_H(0); } else { VMW(); SWRITE_H(1 - (BF)); }                                       \
        if (!lastt) __syncthreads(); } while (0)
    for (int t = 0; t < NT; t += 2) { STEP(t, 0); STEP(t + 1, 1); }
    if (hi == 0) li_l[r32] = l_reg; asm volatile("s_waitcnt lgkmcnt(0)" ::: "memory");
    float rli[16];
#pragma unroll
    for (int r = 0; r < 16; ++r) rli[r] = __builtin_amdgcn_rcpf(li_l[crow(r, hi)]);
    bf16_t* Ow = cur.O + (size_t)(wid * QBLK) * OS;
#pragma unroll
    for (int r = 0; r < 16; ++r) { const int orow = crow(r, hi);
#pragma unroll
        for (int d0 = 0; d0 < 4; ++d0) { const float v = o[d0][r] * rli[r];
            const float vn = __shfl_xor(v, 1);
            if ((r32 & 1) == 0) *(unsigned*)(Ow + (size_t)orow * OS + d0 * 32 + r32) = cvt_pk_bf16(v, vn); } }
    __syncthreads();
#undef RESC
#undef MASKT
#undef STEP
}
#undef VMW
#undef VMWN
#undef SLOAD_H
#undef SWRITE_H
#undef KSWZ
#undef SBAR
__device__ __forceinline__ BlockRef make_ref(int L, int pass, const bf16_t* Q, const bf16_t* K, const bf16_t* V, bf16_t* O) {
    const int bh = L >> 3, x = L & 7, qb = pass ? 15 - x : x, b = bh >> 4, h = bh & 15;
    BlockRef r; const size_t row0 = (size_t)b * SEQ;
    r.Q = Q + (row0 + (size_t)qb * QB) * QS + h * DQK; r.O = O + (row0 + (size_t)qb * QB) * OS + h * DV;
    r.K = K + row0 * KS + h * DQK; r.V = V + row0 * VS + h * DV; r.P0 = qb * QB;
    return r;
}
template <class Hook>
__device__ __forceinline__ void attn_phase(lptr lds, const bf16_t* Q, const bf16_t* K, const bf16_t* V, bf16_t* O, int vcu, int G, const Hook& hook) {
    constexpr int TOTAL = NBATCH * NH * 8;
    const int slot = (vcu >> 5) % 3;
    int L = vcu; if (L >= TOTAL) { hook(); return; }
    if (slot == 0) hook();
    int pass = 0, nblk = 0;
    BlockRef cur = make_ref(L, 0, Q, K, V, O);
    Seam S;
    attn_prime(cur, lds, S);
    for (;;) {
        const bool more_pass = pass == 0, more_item = L + G < TOTAL, last = !more_pass && !more_item;
        int passn = pass + 1, Ln = L;
        if (!more_pass) { passn = 0; Ln = more_item ? L + G : L; }
        const BlockRef nxt = last ? cur : make_ref(Ln, passn, Q, K, V, O);
        attn_block(cur, nxt, lds, S);
        ++nblk;
        if (nblk == 1 && slot == 1) hook();
        if (last) break;
        cur = nxt; pass = passn; L = Ln;
    }
    if (slot == 2 || (slot == 1 && nblk < 1)) hook();
}
}

struct KArgs { const float* in[25]; float* out; unsigned char* ws; int ph_lo, ph_hi; };
enum { I_X = 0, I_AWIN, I_AWGRP, I_ASCALE, I_AWOUT, I_KVWD, I_KVNORM, I_KVWUK, I_KVWUV, I_BWDQ, I_BQNORM, I_BWUQ, I_BWOUT, I_LN1G, I_LN1B, I_LN2G, I_LN2B,
       I_RW, I_RB, I_EWG, I_EWU, I_EWD, I_SWG, I_SWU, I_SWD };

__device__ __forceinline__ void tr_item(const float* W, int ldw, int k0, int n0, bf16_t* WT, int K, int drow0, const float* kscale, LAS float* scr, int lane) {
    const int c = lane & 7;
    f32x4 sa = {1.f, 1.f, 1.f, 1.f}, sb = sa;
    if (kscale) { sa = *(const f32x4*)(kscale + k0 + 8 * c); sb = *(const f32x4*)(kscale + k0 + 8 * c + 4); }
#pragma unroll 8
    for (int i = 0; i < 32; ++i) { const int kk = 2 * i + (lane >> 5); scr[kk * 33 + (lane & 31)] = W[(size_t)(k0 + kk) * ldw + n0 + (lane & 31)]; }
    LDS_WAIT(); asm volatile("" ::: "memory");
#pragma unroll
    for (int j = 0; j < 4; ++j) { const int n = (lane >> 3) + 8 * j; const LAS float* sp = scr + (8 * c) * 33 + n;
        u32x4 o; o.x = cvt_pk_bf16(sp[0 * 33] * sa[0], sp[1 * 33] * sa[1]); o.y = cvt_pk_bf16(sp[2 * 33] * sa[2], sp[3 * 33] * sa[3]); o.z = cvt_pk_bf16(sp[4 * 33] * sb[0], sp[5 * 33] * sb[1]); o.w = cvt_pk_bf16(sp[6 * 33] * sb[2], sp[7 * 33] * sb[3]);
        *(u32x4*)(WT + (size_t)(drow0 + n) * K + k0 + 8 * c) = o; }
    LDS_WAIT(); asm volatile("" ::: "memory");
}
struct TrItem { const float* src; bf16_t* dst; int ldw, Kd, k0, n0, gu, p; };
__device__ __forceinline__ void bg_decode(const KArgs& a, int kind  , int l, int it, TrItem& I) {
    unsigned char* ws = a.ws;
    if (kind == 0 || kind == 2) { const int e = it >> 9, q = it & 511, up = q >> 8, qq = q & 255;
        I.src = e < 64 ? a.in[up ? I_EWU : I_EWG] + (size_t)(l * 64 + e) * 2048 * 512 : a.in[up ? I_SWU : I_SWG] + (size_t)l * 2048 * 512;
        I.ldw = 512; I.k0 = (qq >> 3) * 64; I.n0 = (qq & 7) * 64; I.dst = (bf16_t*)(ws + WS_WGU + (size_t)l * 65 * 1024 * 2048 * 2 + (size_t)e * 1024 * 2048 * (kind == 2 ? 1 : 2)); I.Kd = 2048; I.gu = 1; I.p = up ? 128 : 0;
    } else { const int e = it >> 8, qq = it & 255;
        I.src = e < 64 ? a.in[I_EWD] + (size_t)(l * 64 + e) * 512 * 2048 : a.in[I_SWD] + (size_t)l * 512 * 2048;
        I.ldw = 2048; I.k0 = (qq >> 5) * 64; I.n0 = (qq & 31) * 64; I.dst = (bf16_t*)(ws + WS_WD + (size_t)l * 65 * 2048 * 512 * 2 + (size_t)e * 2048 * 512 * (kind == 3 ? 1 : 2)); I.Kd = 512; I.gu = 0; I.p = 0; }
}
__device__ __forceinline__ void bg_load(const TrItem& I, f32x4 (&v)[16], int lane) {
    const float* p = I.src + (size_t)(I.k0 + 16 * (lane >> 4)) * I.ldw + I.n0 + 4 * (lane & 15);
#pragma unroll
    for (int i = 0; i < 16; ++i) v[i] = __builtin_nontemporal_load((const f32x4*)(p + (size_t)i * I.ldw));
}
__device__ __forceinline__ void bg_emit(const TrItem& I, const f32x4 (&v)[16], LAS unsigned* scr, int lane) {
    const int n4 = lane & 15, kq = lane >> 4;
#pragma unroll
    for (int q = 0; q < 4; ++q)
#pragma unroll
        for (int h = 0; h < 2; ++h) { u32x4 o; o.x = cvt_pk_bf16(v[8 * h + 0][q], v[8 * h + 1][q]); o.y = cvt_pk_bf16(v[8 * h + 2][q], v[8 * h + 3][q]); o.z = cvt_pk_bf16(v[8 * h + 4][q], v[8 * h + 5][q]); o.w = cvt_pk_bf16(v[8 * h + 6][q], v[8 * h + 7][q]);
            *(LAS u32x4*)(scr + (4 * n4 + q) * 36 + 8 * kq + 4 * h) = o; }
    LDS_WAIT(); asm volatile("" ::: "memory");
    const int c = lane & 7;
#pragma unroll
    for (int jj = 0; jj < 8; ++jj) { const int r = (lane >> 3) + 8 * jj, n = I.n0 + r; const u32x4 o = *(const LAS u32x4*)(scr + r * 36 + 4 * c);
        const int drow = I.gu ? (n >> 7) * 256 + I.p + (n & 127) : n;
        *(u32x4*)(I.dst + (size_t)drow * I.Kd + I.k0 + 8 * c) = o; }
    LDS_WAIT(); asm volatile("" ::: "memory");
}
__device__ __forceinline__ void bg_emit8(const TrItem& I, const f32x4 (&v)[16], LAS unsigned* scr, int lane) {
    const int n4 = lane & 15, kq = lane >> 4;
#pragma unroll
    for (int q = 0; q < 4; ++q) { u32x4 o;
        o.x = pk4_fp8(v[0][q] * W8_SCALE, v[1][q] * W8_SCALE, v[2][q] * W8_SCALE, v[3][q] * W8_SCALE); o.y = pk4_fp8(v[4][q] * W8_SCALE, v[5][q] * W8_SCALE, v[6][q] * W8_SCALE, v[7][q] * W8_SCALE);
        o.z = pk4_fp8(v[8][q] * W8_SCALE, v[9][q] * W8_SCALE, v[10][q] * W8_SCALE, v[11][q] * W8_SCALE); o.w = pk4_fp8(v[12][q] * W8_SCALE, v[13][q] * W8_SCALE, v[14][q] * W8_SCALE, v[15][q] * W8_SCALE);
        *(LAS u32x4*)(scr + (4 * n4 + q) * 20 + 4 * kq) = o; }
    LDS_WAIT(); asm volatile("" ::: "memory");
    const int c = lane & 3;
#pragma unroll
    for (int jj = 0; jj < 4; ++jj) { const int r = (lane >> 2) + 16 * jj, n = I.n0 + r; const u32x4 o = *(const LAS u32x4*)(scr + r * 20 + 4 * c);
        const int drow = I.gu ? (n >> 7) * 256 + I.p + (n & 127) : n;
        *(u32x4*)((unsigned char*)I.dst + (size_t)drow * I.Kd + I.k0 + 16 * c) = o; }
    LDS_WAIT(); asm volatile("" ::: "memory");
}
__device__ __forceinline__ void bg_convert_range(const KArgs& a, LAS unsigned char* lds, int kind, int l, int lo, int hi, int wave, int lane, int scr_off = 0, int scr_stride = 16384) {
    LAS unsigned* scr = (LAS unsigned*)(lds + scr_off + wave * scr_stride);
    TrItem A, B; f32x4 va[16], vb[16];
    int it = lo + wave;
    if (it < hi) { bg_decode(a, kind, l, it, A); bg_load(A, va, lane); }
#pragma unroll 1
    while (it < hi) {
        const int i1 = it + 8, i2 = it + 16;
        if (i1 < hi) { bg_decode(a, kind, l, i1, B); bg_load(B, vb, lane); }
        if (kind >= 2) bg_emit8(A, va, scr, lane); else bg_emit(A, va, scr, lane);
        if (i1 >= hi) break;
        if (i2 < hi) { bg_decode(a, kind, l, i2, A); bg_load(A, va, lane); }
        if (kind >= 2) bg_emit8(B, vb, scr, lane); else bg_emit(B, vb, scr, lane);
        it = i2;
    }
    VM_WAIT(); __syncthreads();
}
__device__ __forceinline__ void bg_share(int first, int last, int c, int G, int n_extra, int U, int& lo, int& hi) {
    const int N = last - first; int n_lo = (N + n_extra * U + G - 1) / G, n_hi = n_lo - U;
    if (n_hi < 0) { n_hi = 0; n_lo = (N + (G - n_extra) - 1) / (G - n_extra); }
    lo = first + (c < n_extra ? c * n_hi : n_extra * n_hi + (c - n_extra) * n_lo); hi = lo + (c < n_extra ? n_hi : n_lo);
    if (lo > last) lo = last; if (hi > last) hi = last;
}
__device__ __forceinline__ void bg_convert(const KArgs& a, LAS unsigned char* lds, int kind, int l, int vcu, int G, int wave, int lane) {
    const int NIT = (kind == 0 || kind == 2) ? 65 * 512 : 65 * 256, per = (NIT + G - 1) / G; const int lo = vcu * per, hi = lo + per < NIT ? lo + per : NIT;
    bg_convert_range(a, lds, kind, l, lo < NIT ? lo : NIT, hi, wave, lane);
}
__device__ __forceinline__ void phase_prologue(const KArgs& a, LAS unsigned char* lds, int vcu, int G, int wave, int lane) {
    unsigned char* ws = a.ws;
    LAS float* scr = (LAS float*)(lds + wave * 16384);
    const int gw = vcu * 8 + wave, NGW = G * 8;
    constexpr int C_IN = 2048, C_GRP = 512, C_OUT = 2048, C_KVD = 576, C_DQ = 512, C_UK = 512, C_UV = 512, C_UQ = 768, C_BO = 2048;
    constexpr int C_SMALL = C_IN + C_GRP + C_OUT + C_KVD + C_DQ + C_UK + C_UV + C_UQ + C_BO;
    constexpr int NITEMS = C_SMALL;
    for (int it = gw; it < NITEMS; it += NGW) {
        int r = it;
        if (r < C_IN) { tr_item(a.in[I_AWIN], 2048, (r / 64) * 64, (r % 64) * 32, (bf16_t*)(ws + WS_WIN), 2048, (r % 64) * 32, nullptr, scr, lane); continue; } r -= C_IN;
        if (r < C_GRP) { const int g = r / 128, q = r % 128; tr_item(a.in[I_AWGRP] + (size_t)g * 512 * 512, 512, (q / 16) * 64, (q % 16) * 32, (bf16_t*)(ws + WS_WGRP), 512, g * 512 + (q % 16) * 32, nullptr, scr, lane); continue; } r -= C_GRP;
        if (r < C_OUT) { tr_item(a.in[I_AWOUT], 2048, (r / 64) * 64, (r % 64) * 32, (bf16_t*)(ws + WS_WOUT), 2048, (r % 64) * 32, nullptr, scr, lane); continue; } r -= C_OUT;
        if (r < C_KVD) { const int n0 = (r % 18) * 32; tr_item(a.in[I_KVWD], 576, (r / 18) * 64, n0, (bf16_t*)(ws + WS_WKVQ), 2048, n0 < 512 ? n0 : 1024 + (n0 - 512), nullptr, scr, lane); continue; } r -= C_KVD;
        if (r < C_DQ) { const int n0 = (r % 16) * 32; tr_item(a.in[I_BWDQ], 512, (r / 16) * 64, n0, (bf16_t*)(ws + WS_WKVQ), 2048, 512 + n0, nullptr, scr, lane); continue; } r -= C_DQ;
        if (r < C_UK) { const int n0 = (r % 64) * 32; tr_item(a.in[I_KVWUK], 2048, (r / 64) * 64, n0, (bf16_t*)(ws + WS_WUP), 512, n0, a.in[I_KVNORM], scr, lane); continue; } r -= C_UK;
        if (r < C_UV) { const int n0 = (r % 64) * 32; tr_item(a.in[I_KVWUV], 2048, (r / 64) * 64, n0, (bf16_t*)(ws + WS_WUP), 512, 2048 + n0, a.in[I_KVNORM], scr, lane); continue; } r -= C_UV;
        if (r < C_UQ) { const int n0 = (r % 96) * 32, h = n0 / 192, d0 = n0 % 192;
            const int drow = d0 < 128 ? 4096 + h * 128 + d0 : 6144 + (h >> 2) * 256 + (d0 >= 160 ? 128 : 0) + (h & 3) * 32;
            tr_item(a.in[I_BWUQ], 3072, (r / 96) * 64, n0, (bf16_t*)(ws + WS_WUP), 512, drow, a.in[I_BQNORM], scr, lane); continue; } r -= C_UQ;
        tr_item(a.in[I_BWOUT], 2048, (r / 64) * 64, (r % 64) * 32, (bf16_t*)(ws + WS_WBO), 2048, (r % 64) * 32, nullptr, scr, lane);
    }
    { const int per = (GU0_P0 + G - 1) / G, lo = vcu * per, hi = lo + per; bg_convert_range(a, lds, L0F8 == 2 ? 2 : 0, 0, lo < GU0_P0 ? lo : GU0_P0, hi < GU0_P0 ? hi : GU0_P0, wave, lane); }
    const int gtid = gw * 64 + lane, NGT = NGW * 64;
    for (int i = gtid; i < 192 * 2048 * 2 / 16; i += NGT) ((u32x4*)(ws + WS_WKVQ + (size_t)1088 * 2048 * 2))[i] = (u32x4){0u, 0u, 0u, 0u};
    for (int i = gtid; i < SEQ * 32; i += NGT) { const int s = i >> 5, j = i & 31;
        const float inv = 1.0f / powf(10000.0f, (float)(2 * j) / 64.0f); const float ang = (float)s * inv;
        double rev = (double)ang * 0.15915494309189535; rev -= floor(rev); const float fr = (float)rev;
        ((f32x2*)(ws + WS_ROPE))[i] = (f32x2){__builtin_amdgcn_cosf(fr), __builtin_amdgcn_sinf(fr)}; }
    for (int i = gtid; i < 2 * DM * 64; i += NGT) { const int l = i / (DM * 64), rem = i - l * (DM * 64), d = rem >> 6, e = rem & 63;
        const float w = a.in[I_RW][i] * a.in[I_LN1G][l * DM + d]; const unsigned h = cvt_pk_bf16(w, 0.f) & 0xffffu; const float wl = w - __uint_as_float(h << 16);
        ((bf16_t*)(ws + WS_RWHI))[((size_t)l * 64 + e) * DM + d] = (bf16_t)h; ((bf16_t*)(ws + WS_RWLO))[((size_t)l * 64 + e) * DM + d] = (bf16_t)(cvt_pk_bf16(wl, 0.f) & 0xffffu); }
    for (int i = gw; i < 2 * 64; i += NGW) { const int l = i / 64, e = i % 64; float c1 = 0.f, c2 = 0.f;
#pragma unroll 16
        for (int d = lane; d < DM; d += 64) { const float w = a.in[I_RW][((size_t)l * DM + d) * 64 + e]; c1 += a.in[I_LN1G][l * DM + d] * w; c2 += a.in[I_LN1B][l * DM + d] * w; }
        c1 = wave_sum(c1); c2 = wave_sum(c2);
        if (lane == 0) { ((float*)(ws + WS_RC))[l * 64 + e] = c1; ((float*)(ws + WS_RC))[128 + l * 64 + e] = c2; } }
    const float* x = a.in[I_X];
    for (int task = gtid; task < NCHUNK * 512; task += NGT) {
        const int c4 = task & 511, t0 = (task >> 9) * 32, s0 = t0 & (SEQ - 1);
        const float* xc = x + c4 * 4;
        f32x4 w[32];
#pragma unroll
        for (int j = 0; j < 16; ++j) w[j] = s0 > 0 ? *(const f32x4*)(xc + (size_t)(t0 - 16 + j) * DM) : (f32x4){0.f, 0.f, 0.f, 0.f};
        f32x4 S2 = w[14] + w[15], S4 = (w[12] + w[13]) + S2, S8 = ((w[8] + w[9]) + (w[10] + w[11])) + S4, S16 = (((w[0] + w[1]) + (w[2] + w[3])) + ((w[4] + w[5]) + (w[6] + w[7]))) + S8;
#pragma unroll 1
        for (int hb = 0; hb < 2; ++hb) { const int tb = t0 + 16 * hb, sb0 = s0 + 16 * hb;
#pragma unroll
            for (int j = 0; j < 16; ++j) w[16 + j] = *(const f32x4*)(xc + (size_t)(tb + j) * DM);
#pragma unroll
            for (int j = 0; j < 16; ++j) { const int sq = sb0 + j; const f32x4 v = w[16 + j];
                S2 += v - w[16 + j - 2]; S4 += v - w[16 + j - 4]; S8 += v - w[16 + j - 8]; S16 += v - w[j];
                const float n2 = 1.f / (float)(sq + 1 < 2 ? sq + 1 : 2), n4 = 1.f / (float)(sq + 1 < 4 ? sq + 1 : 4), n8 = 1.f / (float)(sq + 1 < 8 ? sq + 1 : 8), n16 = 1.f / (float)(sq + 1 < 16 ? sq + 1 : 16);
                const f32x4 o2 = S2 * n2 - v, o4 = S4 * n4 - v, o8 = S8 * n8 - v, o16 = S16 * n16 - v;
                bf16_t* xp = (bf16_t*)(ws + WS_XP) + (size_t)(tb + j) * DM + c4 * 4;
                *(u32x2*)(xp) = (u32x2){cvt_pk_bf16(o2[0], o2[1]), cvt_pk_bf16(o2[2], o2[3])};
                *(u32x2*)(xp + (size_t)T * DM) = (u32x2){cvt_pk_bf16(o4[0], o4[1]), cvt_pk_bf16(o4[2], o4[3])};
                *(u32x2*)(xp + (size_t)2 * T * DM) = (u32x2){cvt_pk_bf16(o8[0], o8[1]), cvt_pk_bf16(o8[2], o8[3])};
                *(u32x2*)(xp + (size_t)3 * T * DM) = (u32x2){cvt_pk_bf16(o16[0], o16[1]), cvt_pk_bf16(o16[2], o16[3])}; }
#pragma unroll
            for (int j = 0; j < 16; ++j) w[j] = w[16 + j]; }
    }
}

__device__ __forceinline__ void route_token(float score, float choice, int lane, bool& sel, float& gate) {
    int cnt = 0;
    const float hm = dpp_f<DPP_HM>(choice);
    const float ocs[7] = {dpp_f<DPP_X1>(choice), dpp_f<DPP_X2>(choice), dpp_f<DPP_X3>(choice), dpp_f<DPP_X3>(hm), dpp_f<DPP_X2>(hm), dpp_f<DPP_X1>(hm), hm};
#pragma unroll
    for (int o = 1; o < 8; ++o) { const float oc = ocs[o - 1]; const int j = lane ^ o; cnt += (oc > choice || (oc == choice && j < lane)) ? 1 : 0; }
    float gs = cnt < 2 ? choice : 0.f;
    gs += dpp_f<DPP_X1>(gs); gs += dpp_f<DPP_X2>(gs); gs += dpp_f<DPP_HM>(gs);
    int gcnt = 0;
#pragma unroll
    for (int o = 8; o < 64; o += 8) { const float og = __shfl_xor(gs, o); const int gj = (lane ^ o) >> 3; gcnt += (og > gs || (og == gs && gj < (lane >> 3))) ? 1 : 0; }
    const bool gsel = gcnt < 4;
    float cur = gsel ? choice : -__builtin_inff();
    unsigned long long selmask = 0ull;
#pragma unroll 1
    for (int it = 0; it < 8; ++it) { const float m = wave_max(cur);
        const unsigned long long b = __ballot(cur == m); const int w = __ffsll((long long)b) - 1;
        selmask |= 1ull << w; if (lane == w) cur = -__builtin_inff(); }
    sel = ((selmask >> lane) & 1ull) != 0ull;
    const float ssum = wave_sum(sel ? score : 0.f);
    gate = score / ssum * 2.5f;
}
__device__ __forceinline__ void phase_r1(const KArgs& a, LAS unsigned char* lds, int l, int G, int wave, int lane) {
    unsigned char* ws = a.ws;
    const bf16_t* z = (const bf16_t*)(ws + WS_Z);
    LAS float* P = (LAS float*)lds;
    LAS float* SX = (LAS float*)(lds + 65536);
    LAS unsigned long long* MK = (LAS unsigned long long*)(lds + 65536 + 2048);
    LAS float* ST = (LAS float*)(lds + 65536 + 2048 + 256);
    const int r32 = lane & 31, hi = lane >> 5;
    const float* c1 = (const float*)(ws + WS_RC) + l * 64; const float* c2 = (const float*)(ws + WS_RC) + 128 + l * 64;
    const float* rbias = a.in[I_RB] + l * 64;
    const float* g1 = a.in[I_LN1G] + l * DM; const float* b1 = a.in[I_LN1B] + l * DM;
    int* toke = (int*)(ws + WS_TOKE); float* tokg = (float*)(ws + WS_TOKG); int* cntp = (int*)(ws + WS_CNT);
    bf16_t* x1h = (bf16_t*)(ws + WS_X1F); bf16_t* x1b = (bf16_t*)(ws + WS_X1B);
    for (int ch = blockIdx.x; ch < NCHUNK; ch += G) {
        const int row0 = ch * 32;
        {
            f32x16 acc0 = {}, acc1 = {}; float s1 = 0.f, s2 = 0.f;
            const bf16_t* zr = z + (size_t)(row0 + r32) * DM + 256 * wave + 8 * hi;
            const bf16_t* bh = (const bf16_t*)(ws + WS_RWHI) + ((size_t)l * 64 + r32) * DM + 256 * wave + 8 * hi;
            const bf16_t* bl = (const bf16_t*)(ws + WS_RWLO) + ((size_t)l * 64 + r32) * DM + 256 * wave + 8 * hi;
#pragma unroll 4
            for (int kk = 0; kk < 16; ++kk) {
                const u32x4 zw = *(const u32x4*)(zr + 16 * kk);
                const f32x4 va = {bf_lo(zw.x), bf_hi(zw.x), bf_lo(zw.y), bf_hi(zw.y)}, vb = {bf_lo(zw.z), bf_hi(zw.z), bf_lo(zw.w), bf_hi(zw.w)};
                s1 += (va[0] + va[1]) + (va[2] + va[3]) + (vb[0] + vb[1]) + (vb[2] + vb[3]);
                s2 += (va[0] * va[0] + va[1] * va[1]) + (va[2] * va[2] + va[3] * va[3]) + (vb[0] * vb[0] + vb[1] * vb[1]) + (vb[2] * vb[2] + vb[3] * vb[3]);
                const bf16x8 ah = __builtin_bit_cast(bf16x8, zw);
                const bf16x8 bh0 = *(const bf16x8*)(bh + 16 * kk), bh1 = *(const bf16x8*)(bh + (size_t)32 * DM + 16 * kk);
                const bf16x8 bl0 = *(const bf16x8*)(bl + 16 * kk), bl1 = *(const bf16x8*)(bl + (size_t)32 * DM + 16 * kk);
                acc0 = __builtin_amdgcn_mfma_f32_32x32x16_bf16(ah, bh0, acc0, 0, 0, 0); acc0 = __builtin_amdgcn_mfma_f32_32x32x16_bf16(ah, bl0, acc0, 0, 0, 0);
                acc1 = __builtin_amdgcn_mfma_f32_32x32x16_bf16(ah, bh1, acc1, 0, 0, 0); acc1 = __builtin_amdgcn_mfma_f32_32x32x16_bf16(ah, bl1, acc1, 0, 0, 0);
            }
#pragma unroll
            for (int r = 0; r < 16; ++r) { const int tk = (r & 3) + 8 * (r >> 2) + 4 * hi; P[(wave * 32 + tk) * 64 + r32] = acc0[r]; P[(wave * 32 + tk) * 64 + 32 + r32] = acc1[r]; }
            s1 += __shfl_xor(s1, 32); s2 += __shfl_xor(s2, 32);
            if (hi == 0) { SX[(wave * 32 + r32) * 2] = s1; SX[(wave * 32 + r32) * 2 + 1] = s2; }
        }
        __syncthreads();
#pragma unroll 1
        for (int j = 0; j < 4; ++j) { const int i = 4 * wave + j, t = row0 + i;
            float dot = 0.f, S1 = 0.f, S2 = 0.f;
#pragma unroll
            for (int w = 0; w < 8; ++w) { dot += P[(w * 32 + i) * 64 + lane]; S1 += SX[(w * 32 + i) * 2]; S2 += SX[(w * 32 + i) * 2 + 1]; }
            const float mu = S1 * (1.f / DM), var = S2 * (1.f / DM) - mu * mu, rstd = 1.f / sqrtf(var + LN_EPS);
            const float logit = rstd * (dot - mu * c1[lane]) + c2[lane];
            const float score = 1.f / (1.f + __expf(-logit));
            const float choice = score + rbias[lane];
            bool sel; float gate; route_token(score, choice, lane, sel, gate);
            const unsigned long long mask = __ballot(sel);
            if (lane == 0) { MK[i] = mask; ST[2 * i] = mu; ST[2 * i + 1] = rstd; }
            if (sel) { const int rk8 = __popcll(mask & ((1ull << lane) - 1ull)); tokg[t * 8 + rk8] = gate; }
        }
        __syncthreads();
#pragma unroll 1
        for (int j = 0; j < 4; ++j) { const int i = 4 * wave + j, t = row0 + i; const unsigned long long mask = MK[i];
            int lr = 0; for (int q = 0; q < i; ++q) lr += (int)((MK[q] >> lane) & 1ull);
            if ((mask >> lane) & 1ull) { const int rk8 = __popcll(mask & ((1ull << lane) - 1ull)); toke[t * 8 + rk8] = (lane << 16) | lr; } }
        if (wave == 0) { int c = 0; for (int q = 0; q < 32; ++q) c += (int)((MK[q] >> lane) & 1ull); cntp[ch * 64 + lane] = c; }
#pragma unroll 1
        for (int j = 0; j < 4; ++j) { const int i = 4 * wave + j, t = row0 + i; const float mu = ST[2 * i], rstd = ST[2 * i + 1];
            f32x4 xo[8];
#pragma unroll
            for (int jj = 0; jj < 8; ++jj) { const int col = 4 * lane + 256 * jj; const u32x2 zw = *(const u32x2*)(z + (size_t)t * DM + col); const f32x4 zv = {bf_lo(zw.x), bf_hi(zw.x), bf_lo(zw.y), bf_hi(zw.y)}, g = *(const f32x4*)(g1 + col), b = *(const f32x4*)(b1 + col);
                xo[jj] = (zv - mu) * rstd * g + b; }
#pragma unroll
            for (int jj = 0; jj < 8; ++jj) { const int col = 4 * lane + 256 * jj;
                const u32x2 xb = {cvt_pk_bf16(xo[jj][0], xo[jj][1]), cvt_pk_bf16(xo[jj][2], xo[jj][3])};
                *(u32x2*)(x1h + (size_t)t * DM + col) = xb;
                if (l == 0 && L0F8 != 2) *(u32x2*)(x1b + (size_t)t * DM + col) = xb;
                if (l == 1 || L0F8 == 2) *(unsigned*)(ws + WS_X1Q + (size_t)t * DM + col) = pk4_fp8(xo[jj][0], xo[jj][1], xo[jj][2], xo[jj][3]); } }
        __syncthreads();
    }
}

__device__ __forceinline__ void phase_r2(const KArgs& a, LAS unsigned char* lds, int G, int tid, int wave, int lane) {
    unsigned char* ws = a.ws;
    LAS int* PA = (LAS int*)lds; LAS int* PB = PA + 512; LAS int* SB = PA + 1024; LAS int* TOT = PA + 1088; LAS int* TB = PA + 1152;
    const int* cntp = (const int*)(ws + WS_CNT); const int* toke = (const int*)(ws + WS_TOKE);
    int* toks = (int*)(ws + WS_TOKS); int* rowidx = (int*)(ws + WS_ROWIDX); int* mte = (int*)(ws + WS_MTE); int* nmtp = (int*)(ws + WS_NMT);
    for (int ch = blockIdx.x; ch < NCHUNK; ch += G) {
        { int sa = 0, sb = 0; for (int c = 32 * wave; c < 32 * wave + 32; ++c) { const int v = cntp[c * 64 + lane]; sa += v; if (c < ch) sb += v; } PA[wave * 64 + lane] = sa; PB[wave * 64 + lane] = sb; }
        __syncthreads();
        if (wave == 0) { int tot = 0, off = 0;
#pragma unroll
            for (int w = 0; w < 8; ++w) { tot += PA[w * 64 + lane]; off += PB[w * 64 + lane]; }
            const int nt = (tot + 255) >> 8; int incl = nt;
#pragma unroll
            for (int o = 1; o < 64; o <<= 1) { const int v = __shfl_up(incl, o); if (lane >= o) incl += v; }
            const int tb = incl - nt;
            SB[lane] = 8192 + 256 * tb + off; TOT[lane] = tot; TB[lane] = tb;
            if (ch == 0) { for (int q = 0; q < nt; ++q) mte[32 + tb + q] = lane; if (lane < 32) mte[lane] = 64; if (lane == 63) *nmtp = 32 + incl; } }
        __syncthreads();
        if (tid < 256) { const int t = ch * 32 + (tid >> 3), k = tid & 7; const int pk = toke[t * 8 + k]; const int e = pk >> 16, lr = pk & 0xffff; const int slot = SB[e] + lr; rowidx[slot] = t; toks[t * 8 + k] = slot; }
        else if (tid < 288) { const int t = ch * 32 + (tid - 256); rowidx[t] = t; }
        if (ch < 64 && tid < 256) { const int tot = TOT[ch], tb = TB[ch], nt = (tot + 255) >> 8; const int p = tot + tid; if (p < 256 * nt) rowidx[8192 + 256 * tb + p] = 0; }
        __syncthreads();
    }
}

__device__ __forceinline__ void phase_ln2(const KArgs& a, int l, int vcu, int G, int wave, int lane) {
    unsigned char* ws = a.ws;
    const bf16_t* x1h = (const bf16_t*)(ws + WS_X1F); const unsigned char* Y = ws + WS_Y;
    const int* toks = (const int*)(ws + WS_TOKS); const float* tokg = (const float*)(ws + WS_TOKG);
    const float* g2 = a.in[I_LN2G] + l * DM; const float* b2 = a.in[I_LN2B] + l * DM;
    float* outf = a.out; bf16_t* outb = (bf16_t*)(ws + WS_X2B);
    const int gw = vcu * 8 + wave, NGW = G * 8;
    for (int t = gw; t < T; t += NGW) {
        const int slot_l = lane < 8 ? toks[t * 8 + lane] : 0; const float g_l = lane < 8 ? tokg[t * 8 + lane] * (1.f / Y8_SCALE) : 0.f;
        float v[4][8];
#define LN2_ADD(j, g, yoff) do { const u32x2 yw = __builtin_nontemporal_load((const u32x2*)(Y + (yoff))); \
            const f32x2 a0 = __builtin_amdgcn_cvt_pk_f32_fp8((int)yw.x, false), a1 = __builtin_amdgcn_cvt_pk_f32_fp8((int)yw.x, true), a2 = __builtin_amdgcn_cvt_pk_f32_fp8((int)yw.y, false), a3 = __builtin_amdgcn_cvt_pk_f32_fp8((int)yw.y, true); \
            v[j][0] += (g) * a0[0]; v[j][1] += (g) * a0[1]; v[j][2] += (g) * a1[0]; v[j][3] += (g) * a1[1]; v[j][4] += (g) * a2[0]; v[j][5] += (g) * a2[1]; v[j][6] += (g) * a3[0]; v[j][7] += (g) * a3[1]; } while (0)
#pragma unroll
        for (int j = 0; j < 4; ++j) { const int col = 8 * lane + 512 * j; const u32x4 xw = *(const u32x4*)(x1h + (size_t)t * DM + col);
            v[j][0] = ALPHA * bf_lo(xw.x); v[j][1] = ALPHA * bf_hi(xw.x); v[j][2] = ALPHA * bf_lo(xw.y); v[j][3] = ALPHA * bf_hi(xw.y);
            v[j][4] = ALPHA * bf_lo(xw.z); v[j][5] = ALPHA * bf_hi(xw.z); v[j][6] = ALPHA * bf_lo(xw.w); v[j][7] = ALPHA * bf_hi(xw.w);
            LN2_ADD(j, (1.f / Y8_SCALE), (size_t)t * DM + col); }
#pragma unroll
        for (int k = 0; k < 8; ++k) { const int slot = __builtin_amdgcn_readlane(slot_l, k); const float g = __uint_as_float((unsigned)__builtin_amdgcn_readlane((int)__float_as_uint(g_l), k));
#pragma unroll
            for (int j = 0; j < 4; ++j) LN2_ADD(j, g, (size_t)slot * DM + 8 * lane + 512 * j); }
#undef LN2_ADD
        float s = 0.f;
#pragma unroll
        for (int j = 0; j < 4; ++j)
#pragma unroll
            for (int q = 0; q < 8; ++q) s += v[j][q];
        const float mean = wave_sum_x(s) * (1.f / DM); float s2 = 0.f;
#pragma unroll
        for (int j = 0; j < 4; ++j)
#pragma unroll
            for (int q = 0; q < 8; ++q) { v[j][q] -= mean; s2 += v[j][q] * v[j][q]; }
        const float rstd = 1.f / sqrtf(wave_sum_x(s2) * (1.f / DM) + LN_EPS);
#pragma unroll
        for (int j = 0; j < 4; ++j) { const int col = 8 * lane + 512 * j; const f32x4 ga = *(const f32x4*)(g2 + col), gb = *(const f32x4*)(g2 + col + 4), ba = *(const f32x4*)(b2 + col), bb = *(const f32x4*)(b2 + col + 4);
#pragma unroll
            for (int q = 0; q < 4; ++q) { v[j][q] = v[j][q] * rstd * ga[q] + ba[q]; v[j][4 + q] = v[j][4 + q] * rstd * gb[q] + bb[q]; } }
#pragma unroll
        for (int j = 0; j < 4; ++j) { const int col = 8 * lane + 512 * j;
            if (l == 1) { *(f32x4*)(outf + (size_t)t * DM + col) = (f32x4){v[j][0], v[j][1], v[j][2], v[j][3]}; *(f32x4*)(outf + (size_t)t * DM + col + 4) = (f32x4){v[j][4], v[j][5], v[j][6], v[j][7]}; }
            if (l == 0) *(u32x4*)(outb + (size_t)t * DM + col) = (u32x4){cvt_pk_bf16(v[j][0], v[j][1]), cvt_pk_bf16(v[j][2], v[j][3]), cvt_pk_bf16(v[j][4], v[j][5]), cvt_pk_bf16(v[j][6], v[j][7])}; }
    }
}

__device__ __forceinline__ void phase_stats(const KArgs& a, int vcu, int G, int wave, int lane) {
    unsigned char* ws = a.ws;
    const bf16_t* ckq = (const bf16_t*)(ws + WS_CKQ); float* rstat = (float*)(ws + WS_RSTAT); bf16_t* Kb = (bf16_t*)(ws + WS_K); const f32x2* rope = (const f32x2*)(ws + WS_ROPE);
    const int gw = vcu * 8 + wave, NGW = G * 8;
    for (int t = gw; t < T; t += NGW) { const bf16_t* row = ckq + (size_t)t * NCKQ;
        const u32x4 c = *(const u32x4*)(row + 8 * lane), q = *(const u32x4*)(row + 512 + 8 * lane);
        float sc = bf_lo(c.x) * bf_lo(c.x) + bf_hi(c.x) * bf_hi(c.x) + bf_lo(c.y) * bf_lo(c.y) + bf_hi(c.y) * bf_hi(c.y) + bf_lo(c.z) * bf_lo(c.z) + bf_hi(c.z) * bf_hi(c.z) + bf_lo(c.w) * bf_lo(c.w) + bf_hi(c.w) * bf_hi(c.w);
        float sq = bf_lo(q.x) * bf_lo(q.x) + bf_hi(q.x) * bf_hi(q.x) + bf_lo(q.y) * bf_lo(q.y) + bf_hi(q.y) * bf_hi(q.y) + bf_lo(q.z) * bf_lo(q.z) + bf_hi(q.z) * bf_hi(q.z) + bf_lo(q.w) * bf_lo(q.w) + bf_hi(q.w) * bf_hi(q.w);
        sc = wave_sum(sc); sq = wave_sum(sq);
        if (lane == 0) { rstat[t] = 1.f / sqrtf(sc * (1.f / 512.f) + RMS_EPS); rstat[T + t] = 1.f / sqrtf(sq * (1.f / 512.f) + RMS_EPS); }
        const int i = lane & 31, s = t & (SEQ - 1);
        const float x1 = __uint_as_float((unsigned)row[1024 + i] << 16), x2 = __uint_as_float((unsigned)row[1056 + i] << 16);
        const f32x2 cs = rope[s * 32 + i];
        const float o = lane < 32 ? x1 * cs[0] - x2 * cs[1] : x2 * cs[0] + x1 * cs[1];
        const bf16_t ob = (bf16_t)(cvt_pk_bf16(o, 0.f) & 0xffffu);
        bf16_t* kr = Kb + (size_t)t * (NH * DQK) + 128 + lane;
#pragma unroll
        for (int h = 0; h < NH; ++h) kr[h * DQK] = ob;
    }
}

struct AttHook { const KArgs* a; LAS unsigned char* lds; int vcu, G, wave, lane;
    __device__ __forceinline__ void operator()() const { const int NIT = 65 * 512, per = (NIT + G - 1) / G, lo = vcu * per, hi = lo + per;
        __syncthreads(); bg_convert_range(*a, lds, 2, 1, lo < NIT ? lo : NIT, hi < NIT ? hi : NIT, wave, lane, 90112, 5120); } };
constexpr int N_PHASES = 19;
__global__ void __launch_bounds__(512, 2) fwd_kernel(KArgs a) {
    extern __shared__ __attribute__((aligned(16))) unsigned char lds_raw[];
    LAS unsigned char* lds = (LAS unsigned char*)lds_raw;
    volatile LAS unsigned* MISC = (volatile LAS unsigned*)(lds + MISC_OFF);
    const int tid = threadIdx.x, lane = tid & 63, wave = __builtin_amdgcn_readfirstlane(tid >> 6);
    const int G = gridDim.x; int bx = blockIdx.x; int vcu = (G % 8 == 0) ? (bx % 8) * (G / 8) + bx / 8 : bx;
    unsigned char* ws = a.ws;
    if (tid < 32) MISC[tid] = 0u;
    __syncthreads();
    XcdBarrier bar; bar.bar = (unsigned*)(ws + WS_CTL) + CW_BAR; bar.x = 0; bar.st = nullptr;
    if (MK_N_LAUNCHES == 1) bar = xcd_barrier_post((unsigned*)(ws + WS_CTL) + CW_BAR, MISC + 8);
    const int lo = a.ph_lo, hi = a.ph_hi;
#ifndef PHMASK
#define PHMASK 0xFFFFFFu
#endif
#define PH(k) ((((PHMASK) >> (k)) & 1u) && lo <= (k) && (k) < hi)
#define SEAM(k) do { if (PH(k) && PH((k) + 1)) xcd_barrier(bar); } while (0)

constexpr int G6_ITEMS = 96 * 60;
#ifndef HWIDS
#define HWIDS 1
#endif
#ifndef EXPER
#define EXPER 0
#endif
#ifndef REPMASK
#define REPMASK 0x0u
#endif
#define RUN(k, BODY) do { if (PH(k)) { BODY; if ((REPMASK >> (k)) & 1u) { __syncthreads(); BODY; } } } while (0)
#define BG_DENSE(first, last) do { const int n_ = (last) - (first), per_ = (n_ + G - 1) / G, lo_ = (first) + vcu * per_, hi_ = lo_ + per_; \
        bg_convert_range(a, lds, L0F8 == 2 ? 2 : 0, 0, lo_ < (last) ? lo_ : (last), hi_ < (last) ? hi_ : (last), wave, lane); } while (0)
#define P_G1 do { DenseSched S; S.ord.init(32, 8, G, bx); S.A = (const char*)(ws + WS_XP); S.B = (const char*)(ws + WS_WIN); S.lda_b = DM * 2; S.K = DM; S.mode = 1; S.agrp = (size_t)T * DM * 2; \
        EpiBf16 E{(bf16_t*)(ws + WS_POOLED), DM, nullptr, 0, 1.f}; const bool early_ = ((vcu >> 5) & 1) != 0; if (early_) BG_DENSE(GU0_P0, GU0_P1); pg8::gemm_phase(lds, DM * 2, DM, S, E); if (!early_) BG_DENSE(GU0_P0, GU0_P1); } while (0)
#define P_G2 do { DenseSched S; S.ord.init(32, 8, G, bx); S.A = (const char*)(ws + WS_POOLED); S.B = (const char*)(ws + WS_WGRP); S.lda_b = DM * 2; S.K = 512; S.mode = 1; S.agrp = 1024; \
        EpiBf16 E{(bf16_t*)(ws + WS_MIXED), DM, a.in[I_ASCALE], 0, 1.f}; const bool early_ = ((vcu >> 5) & 1) != 0; if (early_) BG_DENSE(GU0_P1, GU0_P2); pg8::gemm_phase(lds, DM * 2, 512, S, E); if (!early_) BG_DENSE(GU0_P1, GU0_P2); } while (0)
#define P_G3 do { DenseSched S; S.ord.init(32, 8, G, bx); S.A = (const char*)(ws + WS_MIXED); S.B = (const char*)(ws + WS_WOUT); S.lda_b = DM * 2; S.K = DM; S.mode = 0; S.agrp = 0; \
        EpiZ E{a.in[I_X], nullptr, (bf16_t*)(ws + WS_Z)}; const bool early_ = ((vcu >> 5) & 1) != 0; if (early_) BG_DENSE(GU0_P2, 65 * 512); pg8::gemm_phase(lds, DM * 2, DM, S, E); if (!early_) BG_DENSE(GU0_P2, 65 * 512); } while (0)
#define P_G4(l, BGK, BGL, NR, BGF, BGT) do { const int nmt = __builtin_amdgcn_readfirstlane(*(const int*)(ws + WS_NMT)); const int isp = (BGK) >= 0 ? (vcu >> 5) % (NR) : 1 << 20; \
        MoeSched S{(const int*)(ws + WS_MTE), (const int*)(ws + WS_ROWIDX), (const char*)(ws + WS_X1B), (const char*)(ws + WS_WGU) + (size_t)(l) * 65 * 1024 * 2048 * 2, nmt * 4, 4, G, vcu, 1, \
                   (size_t)1024 * 2048 * 2, (size_t)256 * 2048 * 2, 0, 0, isp}; \
        EpiSwiGLU E{(bf16_t*)(ws + WS_H), 1.f, 0}; pg8::gemm_phase(lds, DM * 2, DM, S, E); \
        if ((BGK) >= 0) { int blo, bhi; bg_share((BGF), (BGT), vcu, G, S.nunits % G, 55, blo, bhi); bg_convert_range(a, lds, (BGK), (BGL), blo, bhi, wave, lane); S.i0 = isp; S.i1 = 1 << 20; pg8::gemm_phase(lds, DM * 2, DM, S, E); } } while (0)
#define P_G4H(l, BGK, BGL, NR, BGF, BGT) do { const int nmt = __builtin_amdgcn_readfirstlane(*(const int*)(ws + WS_NMT)); const int isp = (BGK) >= 0 ? (vcu >> 5) % (NR) : 1 << 20; \
        MoeSched S{(const int*)(ws + WS_MTE), (const int*)(ws + WS_ROWIDX), (const char*)(ws + WS_X1B), (const char*)(ws + WS_WGU) + (size_t)(l) * 65 * 1024 * 2048 * 2, nmt * 4, 4, G, vcu, 1, \
                   (size_t)1024 * 2048 * 2, (size_t)256 * 2048 * 2, 0, 0, isp}; \
        EpiSwiGLU E{(bf16_t*)(ws + WS_H), 1.f, 1}; pg8::gemm_phase(lds, DM * 2, DM, S, E); \
        if ((BGK) >= 0) { int blo, bhi; bg_share((BGF), (BGT), vcu, G, S.nunits % G, 55, blo, bhi); bg_convert_range(a, lds, (BGK), (BGL), blo, bhi, wave, lane); S.i0 = isp; S.i1 = 1 << 20; pg8::gemm_phase(lds, DM * 2, DM, S, E); } } while (0)
#define P_G4F(l, BGK, BGL, NR, BGF, BGT) do { const int nmt = __builtin_amdgcn_readfirstlane(*(const int*)(ws + WS_NMT)); const int isp = (BGK) >= 0 ? (vcu >> 5) % (NR) : 1 << 20; \
        MoeSchedT<true> S{(const int*)(ws + WS_MTE), (const int*)(ws + WS_ROWIDX), (const char*)(ws + WS_X1Q), (const char*)(ws + WS_WGU) + (size_t)(l) * 65 * 1024 * 2048 * 2, nmt * 4, 4, G, vcu, 1, \
                   (size_t)1024 * 2048, (size_t)256 * 2048, 0, 0, isp}; \
        EpiSwiGLU E{(bf16_t*)(ws + WS_H), 1.f / W8_SCALE, 1}; pg8::gemm_phase(lds, DM, DM / 2, S, E); \
        if ((BGK) >= 0) { int blo, bhi; bg_share((BGF), (BGT), vcu, G, S.nunits % G, 30, blo, bhi); bg_convert_range(a, lds, (BGK), (BGL), blo, bhi, wave, lane); S.i0 = isp; S.i1 = 1 << 20; pg8::gemm_phase(lds, DM, DM / 2, S, E); } } while (0)
#define P_G5(l, BGK, BGL, NR, BGF, BGT) do { const int nmt = __builtin_amdgcn_readfirstlane(*(const int*)(ws + WS_NMT)); const int isp = (BGK) >= 0 ? (vcu >> 5) % (NR) : 1 << 20; \
        MoeSched S{(const int*)(ws + WS_MTE), (const int*)(ws + WS_ROWIDX), (const char*)(ws + WS_H), (const char*)(ws + WS_WD) + (size_t)(l) * 65 * 2048 * 512 * 2, nmt * 8, 8, G, vcu, 0, \
                   (size_t)2048 * 512 * 2, (size_t)256 * 512 * 2, (size_t)256 * 1024, 0, isp}; \
        EpiBf16 E{(bf16_t*)(ws + WS_Y), DM, nullptr, 1, 1.f}; pg8::gemm_phase(lds, ED * 2, ED, S, E); \
        if ((BGK) >= 0) { int blo, bhi; bg_share((BGF), (BGT), vcu, G, S.nunits % G, 20, blo, bhi); bg_convert_range(a, lds, (BGK), (BGL), blo, bhi, wave, lane); S.i0 = isp; S.i1 = 1 << 20; pg8::gemm_phase(lds, ED * 2, ED, S, E); } } while (0)
#define P_G5F(l, BGK, BGL, NR, BGF, BGT) do { const int nmt = __builtin_amdgcn_readfirstlane(*(const int*)(ws + WS_NMT)); const int isp = (BGK) >= 0 ? (vcu >> 5) % (NR) : 1 << 20; \
        MoeSchedT<true> S{(const int*)(ws + WS_MTE), (const int*)(ws + WS_ROWIDX), (const char*)(ws + WS_H), (const char*)(ws + WS_WD) + (size_t)(l) * 65 * 2048 * 512 * 2, nmt * 8, 8, G, vcu, 0, \
                   (size_t)2048 * 512, (size_t)256 * 512, (size_t)256 * 512, 0, isp}; \
        EpiY8 E{ws + WS_Y, Y8_SCALE / W8_SCALE}; pg8::gemm_phase(lds, ED, ED / 2, S, E); \
        if ((BGK) >= 0) { int blo, bhi; bg_share((BGF), (BGT), vcu, G, S.nunits % G, 12, blo, bhi); bg_convert_range(a, lds, (BGK), (BGL), blo, bhi, wave, lane); S.i0 = isp; S.i1 = 1 << 20; pg8::gemm_phase(lds, ED, ED / 2, S, E); } } while (0)
#define P_G6 do { if (G > 160 && bx >= 160) { const int per = (G6_ITEMS + (G - 160) - 1) / (G - 160), blo = (bx - 160) * per, bhi = blo + per; bg_convert_range(a, lds, 3, 1, blo < G6_ITEMS ? blo : G6_ITEMS, bhi < G6_ITEMS ? bhi : G6_ITEMS, wave, lane); } \
        DenseSched S; S.ord.init(32, 5, G, bx); S.A = (const char*)(ws + WS_X2B); S.B = (const char*)(ws + WS_WKVQ); S.lda_b = DM * 2; S.K = DM; S.mode = 0; S.agrp = 0; \
        EpiBf16 E{(bf16_t*)(ws + WS_CKQ), NCKQ, nullptr, 0, 1.f}; pg8::gemm_phase(lds, DM * 2, DM, S, E); } while (0)
#define P_G7 do { DenseSched S; S.ord.init(32, 28, G, bx); S.A = (const char*)(ws + WS_CKQ); S.B = (const char*)(ws + WS_WUP); S.lda_b = NCKQ * 2; S.K = 512; S.mode = 2; S.agrp = 0; \
        EpiUp E{(bf16_t*)(ws + WS_Q), (bf16_t*)(ws + WS_K), (bf16_t*)(ws + WS_V), (const float*)(ws + WS_RSTAT), (const f32x2*)(ws + WS_ROPE)}; pg8::gemm_phase(lds, NCKQ * 2, 512, S, E); } while (0)
#define P_ATT do { AttHook H{&a, lds, vcu, G, wave, lane}; att::attn_phase((att::lptr)lds, (const bf16_t*)(ws + WS_Q), (const bf16_t*)(ws + WS_K), (const bf16_t*)(ws + WS_V), (bf16_t*)(ws + WS_ATT), vcu, G, H); } while (0)
#define P_G8 do { DenseSched S; S.ord.init(32, 8, G, bx); S.A = (const char*)(ws + WS_ATT); S.B = (const char*)(ws + WS_WBO); S.lda_b = DM * 2; S.K = DM; S.mode = 0; S.agrp = 0; \
        EpiZ E{nullptr, (const bf16_t*)(ws + WS_X2B), (bf16_t*)(ws + WS_Z)}; pg8::gemm_phase(lds, DM * 2, DM, S, E); } while (0)
#define MOE_PHASES(l, pb, K4, L4, F4, T4, K5, L5, F5, T5, G4M, G5M) do { \
        RUN(pb, phase_r1(a, lds, l, G, wave, lane)); SEAM(pb); \
        RUN((pb) + 1, phase_r2(a, lds, G, tid, wave, lane)); \
        if (EXPER && (l) == 0 && PH((pb) + 1)) { __syncthreads(); if (EXPER == 1 ? vcu < 32 : EXPER == 2 ? (vcu & 7) == 0 : EXPER == 3 ? true : EXPER == 4 ? vcu < 64 : (vcu & 3) == 0) bg_convert(a, lds, 1, 1, vcu, G, wave, lane); } \
        SEAM((pb) + 1); \
        RUN((pb) + 2, G4M(l, K4, L4, 5, F4, T4)); SEAM((pb) + 2); \
        RUN((pb) + 3, G5M(l, K5, L5, 10, F5, T5)); SEAM((pb) + 3); \
        RUN((pb) + 4, phase_ln2(a, l, vcu, G, wave, lane)); } while (0)

    RUN(0, phase_prologue(a, lds, vcu, G, wave, lane)); SEAM(0);
    if (MK_N_LAUNCHES == 1 && HWIDS && PH(0) && PH(1) && G % 8 == 0) {
        const unsigned* cen = (const unsigned*)(ws + WS_CTL) + CW_BAR; bool ok = true;
#pragma unroll
        for (int j = 0; j < 16; ++j) { const unsigned c = __hip_atomic_load(cen + XB_XCNT(j), __ATOMIC_RELAXED, __HIP_MEMORY_SCOPE_AGENT); ok = ok && (c == (j < 8 ? (unsigned)(G / 8) : 0u)); }
        const int rank = (int)MISC[16], xcc = (int)MISC[17];
        if (ok && xcc < 8 && rank < G / 8) { vcu = xcc * (G / 8) + rank; bx = rank * 8 + xcc; }
    }
    RUN(1, P_G1); SEAM(1);
    RUN(2, P_G2); SEAM(2);
    RUN(3, P_G3); SEAM(3);
    MOE_PHASES(0, 4, L0F8 ? 3 : 1, 0, 0, 65 * 256, -1, 1, 0, 0, P_G4SEL, P_G5SEL); SEAM(8);
    RUN(9, P_G6); SEAM(9);
    RUN(10, phase_stats(a, vcu, G, wave, lane)); SEAM(10);
    RUN(11, P_G7); SEAM(11);
    RUN(12, P_ATT); SEAM(12);
    RUN(13, P_G8); SEAM(13);
    MOE_PHASES(1, 14, 3, 1, (G > 160 ? G6_ITEMS : 0), 65 * 256, -1, 0, 0, 0, P_G4F, P_G5F);
#undef MOE_PHASES
#undef RUN
#undef PH
#undef SEAM
}

extern "C" void kernel_launch(void* const* d_in, const int* in_sizes, int n_in, void* d_out, int out_size, void* d_ws, size_t ws_size, hipStream_t stream) {
    static int grid = 0;
    if (grid == 0) {
        if (n_in != 25 || out_size != T * DM || ws_size < WS_END) { fprintf(stderr, "kernel_launch: unexpected shapes (n_in %d, out %d, ws %zu)\n", n_in, out_size, ws_size); grid = -1; return; }
        int dev = 0, cus = 0;
        if (hipGetDevice(&dev) != hipSuccess || hipDeviceGetAttribute(&cus, hipDeviceAttributeMultiprocessorCount, dev) != hipSuccess) { grid = -1; return; }
        if (hipFuncSetAttribute((const void*)fwd_kernel, hipFuncAttributeMaxDynamicSharedMemorySize, LDS_BYTES) != hipSuccess) { fprintf(stderr, "kernel_launch: hipFuncSetAttribute failed\n"); grid = -1; return; }
        int per_cu = 0;
        if (hipOccupancyMaxActiveBlocksPerMultiprocessor(&per_cu, (const void*)fwd_kernel, 512, LDS_BYTES) != hipSuccess || per_cu < 1) fprintf(stderr, "kernel_launch: occupancy query reports %d blocks per CU\n", per_cu);
        (void)hipGetLastError();
        grid = cus;
    }
    if (grid < 0) return;
    (void)hipMemsetAsync((char*)d_ws + WS_CTL, 0, CTL_ZERO_BYTES, stream);
    KArgs a{};
    for (int i = 0; i < 25; ++i) a.in[i] = (const float*)d_in[i];
    a.out = (float*)d_out; a.ws = (unsigned char*)d_ws;
#if MK_N_LAUNCHES == 1
    a.ph_lo = 0; a.ph_hi = N_PHASES;
    hipLaunchKernelGGL(fwd_kernel, dim3(grid), dim3(512), LDS_BYTES, stream, a);
#else
    for (int k = 0; k < N_PHASES; ++k) { a.ph_lo = k; a.ph_hi = k + 1; hipLaunchKernelGGL(fwd_kernel, dim3(grid), dim3(512), LDS_BYTES, stream, a); }
#endif
}
```
